# Optimizing an MI355X kernel written in HIP

```python
import jax, jax.numpy as jnp
from jax import lax
import numpy as np

D_MODEL = 2048
BATCH = 2
SEQ = 8192
DEPTH = 1

GRID_W = 64
CTX_LEN = 256
MIX_WIDTH = D_MODEL
RET_WIDTH = MIX_WIDTH // 2
RET_HEADS = 8
RET_HEAD_DIM = RET_WIDTH // RET_HEADS
CONV_CH = MIX_WIDTH - RET_WIDTH
CONV_TAPS = 3
IN_WIDTH = 4 * RET_WIDTH + 3 * CONV_CH
D_FF = ((8 * D_MODEL // 3 + 255) // 256) * 256
CHUNK = 128
ROPE_THETA = 10000.0
EPS = 1e-6
N_MOD = 6

kernel_name = 'hybrid_retention_shortconv_flow_block'


def rms_norm(x, gain):
    xf = x.astype(jnp.float32)
    y = xf * lax.rsqrt(jnp.mean(xf * xf, axis=-1, keepdims=True) + EPS)
    return (y * gain.astype(jnp.float32)).astype(x.dtype)


def modulate(h, shift, scale):
    return h * (1 + scale) + shift


def split_heads(t):
    b, n, _ = t.shape
    return t.reshape(b, n, RET_HEADS, RET_HEAD_DIM).transpose(0, 2, 1, 3)


def merge_heads(t):
    b, h, n, d = t.shape
    return t.transpose(0, 2, 1, 3).reshape(b, n, h * d)


def head_rms_norm(o):
    of = o.astype(jnp.float32)
    return (of * lax.rsqrt(jnp.mean(of * of, axis=-1, keepdims=True) + EPS)).astype(o.dtype)


def rope1d(x, pos):
    d = x.shape[-1]
    half = d // 2
    freqs = ROPE_THETA ** (-jnp.arange(0, d, 2, dtype=jnp.float32) / d)
    ang = pos[:, None] * freqs[None, :]
    cos = jnp.cos(ang).astype(x.dtype)
    sin = jnp.sin(ang).astype(x.dtype)
    x1, x2 = x[..., :half], x[..., half:]
    return jnp.concatenate([x1 * cos - x2 * sin, x1 * sin + x2 * cos], axis=-1)


def rope2d(x, row, col):
    half = x.shape[-1] // 2
    return jnp.concatenate([rope1d(x[..., :half], row), rope1d(x[..., half:], col)], axis=-1)


def conv3_along(x, w, axis):
    n = x.shape[axis]
    pad = [(0, 0)] * x.ndim
    pad[axis] = (1, 1)
    xp = jnp.pad(x, pad)
    taps = [lax.slice_in_dim(xp, i, i + n, axis=axis) for i in range(CONV_TAPS)]
    return taps[0] * w[0] + taps[1] * w[1] + taps[2] * w[2]


def dwconv3(x, w, rows, vertical):
    if rows is None:
        return conv3_along(x, w, 1)
    b, n, ch = x.shape
    xg = x.reshape(b, rows, GRID_W, ch)
    return conv3_along(xg, w, 1 if vertical else 2).reshape(b, n, ch)


def retention_dir(q, k, v, log_gamma, s0, strict):
    b, h, n, dk = q.shape
    dv = v.shape[-1]
    nc = n // CHUNK
    dt = q.dtype
    qc = q.reshape(b, h, nc, CHUNK, dk)
    kc = k.reshape(b, h, nc, CHUNK, dk)
    vc = v.reshape(b, h, nc, CHUNK, dv)
    idx = jnp.arange(CHUNK, dtype=jnp.float32)
    rel = idx[:, None] - idx[None, :]
    mask = (rel > 0) if strict else (rel >= 0)
    lg = log_gamma[:, None, None]
    dmat = jnp.where(mask[None], jnp.exp(lg * jnp.maximum(rel, 0.0)[None]), 0.0).astype(dt)
    scores = jnp.einsum('bhnid,bhnjd->bhnij', qc, kc) * dmat[None, :, None]
    inner = jnp.einsum('bhnij,bhnje->bhnie', scores, vc)
    k_decay = jnp.exp(log_gamma[:, None] * (CHUNK - 1.0 - idx)[None]).astype(dt)
    kv = jnp.einsum('bhnjd,hj,bhnje->nbhde', kc, k_decay, vc)
    chunk_decay = jnp.exp(log_gamma * CHUNK).astype(dt)[None, :, None, None]

    def step(s, kv_n):
        return chunk_decay * s + kv_n, s

    s_final, s_prev = lax.scan(step, s0, kv)
    q_decay = jnp.exp(log_gamma[:, None] * (idx + 1.0)[None]).astype(dt)
    cross = jnp.einsum('bhnid,nbhde->bhnie', qc, s_prev) * q_decay[None, :, None, :, None]
    return (inner + cross).reshape(b, h, n, dv), s_final


def context_final_state(k, v, log_gamma, reverse):
    l = k.shape[2]
    t = jnp.arange(l, dtype=jnp.float32)
    expo = t if reverse else (l - 1.0 - t)
    w = jnp.exp(log_gamma[:, None] * expo[None]).astype(k.dtype)
    return jnp.einsum('bhtd,ht,bhte->bhde', k, w, v)


def token_mixers(p, s0_f, s0_b, log_gf, log_gb, conv_w, w_out, rows, grid_pos):
    r, cc = RET_WIDTH, CONV_CH
    q = split_heads(p[..., 0:r])
    k = split_heads(p[..., r:2 * r])
    v = split_heads(p[..., 2 * r:3 * r])
    g = p[..., 3 * r:4 * r]
    bg = p[..., 4 * r:4 * r + cc]
    cg = p[..., 4 * r + cc:4 * r + 2 * cc]
    hv = p[..., 4 * r + 2 * cc:4 * r + 3 * cc]
    if grid_pos is not None:
        q = rope2d(q, grid_pos[0], grid_pos[1])
        k = rope2d(k, grid_pos[0], grid_pos[1])
    k = k * (RET_HEAD_DIM ** -0.5)
    o_f, s_f = retention_dir(q, k, v, log_gf, s0_f, False)
    o_b_rev, s_b = retention_dir(jnp.flip(q, 2), jnp.flip(k, 2), jnp.flip(v, 2), log_gb, s0_b, True)
    o = head_rms_norm(o_f + jnp.flip(o_b_rev, 2))
    ret = merge_heads(o) * jax.nn.silu(g)
    conv = bg * dwconv3(cg * hv, conv_w, rows, vertical=False)
    mix = jnp.concatenate([ret, conv], axis=-1) @ w_out
    return mix, s_f, s_b


def conv_ffn(h, w_up, conv_w, conv_b, w_down, rows):
    u = h @ w_up
    a, b = u[..., :D_FF], u[..., D_FF:]
    a = dwconv3(a, conv_w, rows, vertical=True) + conv_b
    return (jax.nn.silu(a) * b) @ w_down


def setup_inputs(seed: int = 0) -> dict:
    key = jax.random.key(seed)
    ks = jax.random.split(key, 20)
    f32 = jnp.float32

    def nrm(k, shape, scale):
        return jax.random.normal(k, shape, f32) * scale

    decay_logit = jnp.asarray(np.log(2.0 ** (5 + np.arange(RET_HEADS)) - 1.0).astype(np.float32))
    return {
        'x': nrm(ks[0], (BATCH, SEQ, D_MODEL), 1.0),
        'c': nrm(ks[1], (BATCH, D_MODEL), 1.0),
        'ctx': nrm(ks[2], (BATCH, CTX_LEN, D_MODEL), 1.0),
        'c_ctx': nrm(ks[3], (D_MODEL,), 1.0),
        'w_mod': nrm(ks[4], (DEPTH, D_MODEL, N_MOD * D_MODEL), D_MODEL ** -0.5),
        'b_mod': nrm(ks[5], (DEPTH, N_MOD * D_MODEL), 0.01),
        'norm1_g': 1.0 + nrm(ks[6], (DEPTH, D_MODEL), 0.02),
        'w_in': nrm(ks[7], (DEPTH, D_MODEL, IN_WIDTH), D_MODEL ** -0.5),
        'ret_decay_fwd': decay_logit[None] + nrm(ks[8], (DEPTH, RET_HEADS), 0.1),
        'ret_decay_bwd': decay_logit[None] + nrm(ks[9], (DEPTH, RET_HEADS), 0.1),
        'conv_w': nrm(ks[10], (DEPTH, CONV_TAPS, CONV_CH), CONV_TAPS ** -0.5),
        'w_out': nrm(ks[11], (DEPTH, MIX_WIDTH, D_MODEL), MIX_WIDTH ** -0.5),
        'norm2_g': 1.0 + nrm(ks[12], (DEPTH, D_MODEL), 0.02),
        'w_up': nrm(ks[13], (DEPTH, D_MODEL, 2 * D_FF), D_MODEL ** -0.5),
        'ffn_conv_w': nrm(ks[14], (DEPTH, CONV_TAPS, D_FF), CONV_TAPS ** -0.5),
        'ffn_conv_b': nrm(ks[15], (DEPTH, D_FF), 0.01),
        'w_down': nrm(ks[16], (DEPTH, D_FF, D_MODEL), D_FF ** -0.5),
        'final_g': 1.0 + nrm(ks[17], (D_MODEL,), 0.02),
    }


def reference(x, c, ctx, c_ctx, w_mod, b_mod, norm1_g, w_in, ret_decay_fwd, ret_decay_bwd,
              conv_w, w_out, norm2_g, w_up, ffn_conv_w, ffn_conv_b, w_down, final_g):
    b, n, _ = x.shape
    rows = n // GRID_W
    pos = jnp.arange(n, dtype=jnp.int32)
    grid_pos = ((pos // GRID_W).astype(jnp.float32), (pos % GRID_W).astype(jnp.float32))
    r = RET_WIDTH

    for layer in range(DEPTH):
        last = layer == DEPTH - 1
        mod = (jax.nn.silu(c) @ w_mod[layer] + b_mod[layer])[:, None, :]
        mod_c = jax.nn.silu(c_ctx) @ w_mod[layer] + b_mod[layer]
        sh1, sc1, g1, sh2, sc2, g2 = jnp.split(mod, N_MOD, axis=-1)
        csh1, csc1, cg1, csh2, csc2, cg2 = jnp.split(mod_c, N_MOD, axis=-1)
        log_gf = jax.nn.log_sigmoid(ret_decay_fwd[layer].astype(jnp.float32))
        log_gb = jax.nn.log_sigmoid(ret_decay_bwd[layer].astype(jnp.float32))

        hc = modulate(rms_norm(ctx, norm1_g[layer]), csh1, csc1)
        if last:
            pc = hc @ w_in[layer][:, r:3 * r]
            kc = split_heads(pc[..., :r]) * (RET_HEAD_DIM ** -0.5)
            vc = split_heads(pc[..., r:])
            s_f = context_final_state(kc, vc, log_gf, reverse=False)
            s_b = context_final_state(kc, vc, log_gb, reverse=True)
        else:
            zeros = jnp.zeros((b, RET_HEADS, RET_HEAD_DIM, RET_HEAD_DIM), hc.dtype)
            mix_c, s_f, s_b = token_mixers(hc @ w_in[layer], zeros, zeros, log_gf, log_gb,
                                           conv_w[layer], w_out[layer], None, None)
            ctx_mid = ctx + cg1 * mix_c
            hc2 = modulate(rms_norm(ctx_mid, norm2_g[layer]), csh2, csc2)
            ctx_next = ctx_mid + cg2 * conv_ffn(hc2, w_up[layer], ffn_conv_w[layer],
                                                ffn_conv_b[layer], w_down[layer], None)

        h = modulate(rms_norm(x, norm1_g[layer]), sh1, sc1)
        mix, _, _ = token_mixers(h @ w_in[layer], s_f, s_b, log_gf, log_gb,
                                 conv_w[layer], w_out[layer], rows, grid_pos)
        x = x + g1 * mix
        h2 = modulate(rms_norm(x, norm2_g[layer]), sh2, sc2)
        x = x + g2 * conv_ffn(h2, w_up[layer], ffn_conv_w[layer], ffn_conv_b[layer],
                              w_down[layer], rows)
        if not last:
            ctx = ctx_next

    return rms_norm(x, final_g)
```

```cpp
#include <hip/hip_runtime.h>
#include <cstdio>
#include <cstdint>

#ifndef ONE_LAUNCH
#define ONE_LAUNCH 0
#endif

namespace pg8 {
#define PG8_LAS __attribute__((address_space(3)))
typedef unsigned short bf16_t;
typedef short bf16x8 __attribute__((ext_vector_type(8)));
typedef float f32x4 __attribute__((ext_vector_type(4)));
typedef unsigned u32x4 __attribute__((ext_vector_type(4)));
constexpr int BM = 256, BK = 64, HALF = 128, HTB = HALF * BK * 2, STAGE_BYTES = 8 * HTB, NXCD = 8, WGM = 8;

__host__ __device__ __forceinline__ int lds_byte(int r, int c) { const int st = (r >> 4) * 2 + (c >> 5), rr = r & 15, cc = c & 31, ob = rr * 64 + cc * 2; return st * 1024 + (ob ^ (((ob >> 9) & 1) << 5)); }
__host__ __device__ __forceinline__ void stage_rc(int b, int& R, int& C) { const int st = b / 1024, sb = b % 1024, swz = sb ^ (((sb >> 9) & 1) << 5); R = (st >> 1) * 16 + swz / 64; C = (st & 1) * 32 + (swz % 64) / 2; }
__host__ __device__ __forceinline__ int perm32(int rho) { const int n = rho >> 4, i = rho & 15; return 8 * (i >> 2) + 4 * n + (i & 3); }

struct Unit { int pm, pn; };
struct Gemm { const bf16_t* A; const bf16_t* Bt; int M, N, K; };

struct StaticOrder {
    int nM, nN, nwg, G, c;
    __host__ __device__ void init(int M, int N, int G_, int c_) { nM = M / BM; nN = N / BM; nwg = nM * nN; G = G_; c = c_; }
    __host__ __device__ bool next(int i, Unit& u) const {
        const long L = (long)i * G + c; if (L >= nwg) return false;
        int wgid = (int)L; { const int q = nwg / NXCD, r = nwg % NXCD, xcd = wgid % NXCD, off = wgid / NXCD; wgid = (xcd < r ? xcd * (q + 1) : r * (q + 1) + (xcd - r) * q) + off; }
        const int nig = WGM * nN, gid = wgid / nig, fm = gid * WGM, gsz = (nM - fm) < WGM ? (nM - fm) : WGM;
        u.pm = fm + ((wgid % nig) % gsz); u.pn = (wgid % nig) / gsz; return true;
    }
    __device__ __forceinline__ void a_ready(const Unit&) const {}
    __device__ __forceinline__ void done(const Unit&) const {}
};

__device__ __forceinline__ unsigned cvt_pk_bf16(float lo, float hi) { unsigned r; asm volatile("v_cvt_pk_bf16_f32 %0, %1, %2" : "=v"(r) : "v"(lo), "v"(hi)); return r; }


struct EpiBf16R {
    static constexpr bool PERM = true, AFTER_DRAIN = false;
    bf16_t* O; int ldc; int split_cols; size_t split_stride;
    const float* cosT; const float* sinT; int rope_hi; int sc_lo, sc_hi; float sc;
    __device__ __forceinline__ void operator()(const f32x4 (&acc)[2][2][4][2], const Unit& u, int wr, int wc, int fr, int fq) const {
        const int row0 = u.pm * BM + wr * 64 + fr; int colt = u.pn * BM; bf16_t* base = O;
        if (split_cols) { const int t = colt / split_cols; base += (size_t)t * split_stride; colt -= t * split_cols; }
        const int col0 = colt + wc * 32 + 8 * fq;
        const bool rope = u.pn < rope_hi; const float s = (u.pn >= sc_lo && u.pn < sc_hi) ? sc : 1.f;
        const int ti = 16 * (wc & 1) + 4 * fq;
#pragma unroll
        for (int ai = 0; ai < 2; ++ai)
#pragma unroll
            for (int m = 0; m < 4; ++m) {
                const int r = row0 + ai * HALF + m * 16;
                f32x4 cs = (f32x4){1.f, 1.f, 1.f, 1.f}, sn = (f32x4){0.f, 0.f, 0.f, 0.f};
                if (rope) { const int ntok = r & 8191; const int pos = (wc >> 1) ? (ntok & 63) : (ntok >> 6); cs = *(const f32x4*)(cosT + pos * 32 + ti); sn = *(const f32x4*)(sinT + pos * 32 + ti); }
                bf16_t* rowp = base + (size_t)r * ldc + col0;
#pragma unroll
                for (int bj = 0; bj < 2; ++bj) {
                    const f32x4 v0 = acc[ai][bj][m][0], v1 = acc[ai][bj][m][1]; f32x4 o0, o1;
                    o0[0] = v0[0] * cs[0] - v0[1] * sn[0]; o0[1] = v0[0] * sn[0] + v0[1] * cs[0];
                    o0[2] = v0[2] * cs[1] - v0[3] * sn[1]; o0[3] = v0[2] * sn[1] + v0[3] * cs[1];
                    o1[0] = v1[0] * cs[2] - v1[1] * sn[2]; o1[1] = v1[0] * sn[2] + v1[1] * cs[2];
                    o1[2] = v1[2] * cs[3] - v1[3] * sn[3]; o1[3] = v1[2] * sn[3] + v1[3] * cs[3];
                    o0 = o0 * s; o1 = o1 * s;
                    u32x4 w; w.x = cvt_pk_bf16(o0[0], o0[1]); w.y = cvt_pk_bf16(o0[2], o0[3]); w.z = cvt_pk_bf16(o1[0], o1[1]); w.w = cvt_pk_bf16(o1[2], o1[3]);
                    *(u32x4*)(rowp + bj * HALF) = w; }
            }
    }
};
struct EpiRes {
    static constexpr bool PERM = false, AFTER_DRAIN = false;
    const float* base; float* out; int ldc; const float* gate; int gate_bstride;
    __device__ __forceinline__ void operator()(const f32x4 (&acc)[2][2][4][2], const Unit& u, int wr, int wc, int fr, int fq) const {
        const int row0 = u.pm * BM + wr * 64 + fr, col0 = u.pn * BM + wc * 32 + 4 * fq;
        const float* gp = gate + (size_t)((u.pm * BM) >> 13) * gate_bstride + col0;
        f32x4 gv[2][2];
#pragma unroll
        for (int bj = 0; bj < 2; ++bj)
#pragma unroll
            for (int n = 0; n < 2; ++n) gv[bj][n] = *(const f32x4*)(gp + bj * HALF + n * 16);
#pragma unroll
        for (int ai = 0; ai < 2; ++ai)
#pragma unroll
            for (int m = 0; m < 4; ++m) { const size_t off = (size_t)(row0 + ai * HALF + m * 16) * ldc + col0;
#pragma unroll
                for (int bj = 0; bj < 2; ++bj)
#pragma unroll
                    for (int n = 0; n < 2; ++n) { const f32x4 bs = *(const f32x4*)(base + off + bj * HALF + n * 16); *(f32x4*)(out + off + bj * HALF + n * 16) = bs + gv[bj][n] * acc[ai][bj][m][n]; }
                if (m & 1) asm volatile("" ::: "memory"); }
    }
};

template <class Epi, class Sched, bool ALIGN_EPI = false, bool SP2 = false>
__device__ __forceinline__ void gemm_phase(PG8_LAS unsigned char* lds, const Gemm g, const Sched& S, const Epi& E) {
    const int tid = threadIdx.x, wid = __builtin_amdgcn_readfirstlane(tid >> 6), lane = tid & 63, wr = wid >> 2, wc = wid & 3, fr = lane & 15, fq = lane >> 4;
    const int K = g.K, nt = K / BK;
    unsigned voffA[2], voffB[2];
#pragma unroll
    for (int i = 0; i < 2; ++i) { int R, C; stage_rc(tid * 16 + i * 8192, R, C); const int Rb = Epi::PERM ? ((R & ~31) + perm32(R & 31)) : R;
        voffA[i] = (unsigned)(R * K + C) * 2u; voffB[i] = (unsigned)(Rb * K + C) * 2u; }
    const size_t kstep = (size_t)(BK * 2);
    const size_t hstep = (size_t)HALF * K * 2;
    const size_t tstep = 2 * hstep;
    const unsigned ldsw = (unsigned)wid * 1024u;
    const int aoff = lds_byte(wr * 64 + fr, fq * 8), boff = lds_byte(wc * 32 + fr, fq * 8);
#define PG8_SA(b, h) (((b) * 2 + (h)) * HTB)
#define PG8_SB(b, h) ((4 + (b) * 2 + (h)) * HTB)
#define PG8_STAGE(bufoff, gbase, voff) do { _Pragma("unroll") for (int _i = 0; _i < 2; ++_i) \
        __builtin_amdgcn_global_load_lds((const unsigned*)((const char*)(gbase) + (voff)[_i]), (PG8_LAS unsigned*)(lds + (bufoff) + ldsw + _i * 8192), 16, 0, 0); } while (0)
#define PG8_LDA(dst, b, h) do { _Pragma("unroll") for (int m = 0; m < 4; ++m) _Pragma("unroll") for (int k = 0; k < 2; ++k) dst[m][k] = *(const PG8_LAS bf16x8*)(lds + PG8_SA(b, h) + aoff + m * 2048 + k * 1024); } while (0)
#define PG8_LDB(dst, b, h) do { _Pragma("unroll") for (int n = 0; n < 2; ++n) _Pragma("unroll") for (int k = 0; k < 2; ++k) dst[n][k] = *(const PG8_LAS bf16x8*)(lds + PG8_SB(b, h) + boff + n * 2048 + k * 1024); } while (0)
#define PG8_MMA(ai, bj, At, Bt) do { __builtin_amdgcn_s_setprio(1); _Pragma("unroll") for (int m = 0; m < 4; ++m) _Pragma("unroll") for (int n = 0; n < 2; ++n) _Pragma("unroll") for (int k = 0; k < 2; ++k) \
        acc[ai][bj][m][n] = __builtin_amdgcn_mfma_f32_16x16x32_bf16(Bt[n][k], At[m][k], acc[ai][bj][m][n], 0, 0, 0); __builtin_amdgcn_s_setprio(0); } while (0)
#define PG8_WAIT_V(n) asm volatile("s_waitcnt vmcnt(" #n ")" ::: "memory")
#define PG8_WAIT_L(n) asm volatile("s_waitcnt lgkmcnt(" #n ")" ::: "memory")
#define PG8_BAR __builtin_amdgcn_s_barrier()
#define PG8_SCHED __builtin_amdgcn_sched_barrier(0)
    Unit cur, nxt; int ui = 0;
    if (!S.next(0, cur)) return;
    f32x4 acc[2][2][4][2];
#pragma unroll
    for (int a = 0; a < 2; ++a)
#pragma unroll
        for (int b = 0; b < 2; ++b)
#pragma unroll
            for (int m = 0; m < 4; ++m)
#pragma unroll
                for (int n = 0; n < 2; ++n) acc[a][b][m][n] = (f32x4){0.f, 0.f, 0.f, 0.f};
    bf16x8 At[4][2], B0[2][2], B1[2][2];
    const char* cA = (const char*)g.A + (size_t)cur.pm * tstep; const char* cB = (const char*)g.Bt + (size_t)cur.pn * tstep;
    S.a_ready(cur);
    if constexpr (SP2) {
        PG8_STAGE(PG8_SB(0, 0), cB, voffB); PG8_STAGE(PG8_SB(0, 1), cB + hstep, voffB); PG8_STAGE(PG8_SA(0, 0), cA, voffA); PG8_STAGE(PG8_SA(0, 1), cA + hstep, voffA);
        if (wr == 1) PG8_BAR;
        PG8_WAIT_V(2); PG8_BAR;
        PG8_STAGE(PG8_SB(1, 0), cB + kstep, voffB); PG8_STAGE(PG8_SA(1, 0), cA + kstep, voffA); PG8_STAGE(PG8_SB(1, 1), cB + hstep + kstep, voffB);
        PG8_WAIT_V(6); PG8_BAR;
    } else {
        PG8_STAGE(PG8_SB(0, 0), cB, voffB); PG8_STAGE(PG8_SA(0, 0), cA, voffA); PG8_STAGE(PG8_SB(0, 1), cB + hstep, voffB); PG8_STAGE(PG8_SA(0, 1), cA + hstep, voffA);
        if (wr == 1) PG8_BAR;
        PG8_WAIT_V(4); PG8_BAR;
        PG8_STAGE(PG8_SB(1, 0), cB + kstep, voffB); PG8_STAGE(PG8_SA(1, 0), cA + kstep, voffA); PG8_STAGE(PG8_SB(1, 1), cB + hstep + kstep, voffB);
        PG8_WAIT_V(6); PG8_BAR;
    }
    for (;;) {
        const bool has_next = S.next(ui + 1, nxt);
        const char* nA = has_next ? (const char*)g.A + (size_t)nxt.pm * tstep : cA; const char* nB = has_next ? (const char*)g.Bt + (size_t)nxt.pn * tstep : cB;
        for (int t = 0; t < nt; t += 2) {
            const bool last = (t == nt - 2);
            const char* a1 = cA + (size_t)(t + 1) * kstep;
            const char* a2 = last ? nA : cA + (size_t)(t + 2) * kstep; const char* b2 = last ? nB : cB + (size_t)(t + 2) * kstep;
            const char* a3 = a2 + kstep; const char* b3 = b2 + kstep;
            if (last && has_next) S.a_ready(nxt);
            if constexpr (SP2) {
            PG8_LDB(B0, 0, 0); PG8_LDB(B1, 0, 1); PG8_SCHED; PG8_LDA(At, 0, 0); PG8_STAGE(PG8_SA(1, 1), a1 + hstep, voffA);
            PG8_WAIT_V(8); PG8_WAIT_L(0); PG8_BAR; PG8_MMA(0, 0, At, B0); PG8_MMA(0, 1, At, B1); PG8_BAR; PG8_SCHED;
            PG8_LDA(At, 0, 1); PG8_STAGE(PG8_SB(0, 0), b2, voffB); PG8_STAGE(PG8_SB(0, 1), b2 + hstep, voffB); PG8_STAGE(PG8_SA(0, 0), a2, voffA);
            PG8_WAIT_V(8); PG8_WAIT_L(0); PG8_BAR; PG8_MMA(1, 0, At, B0); PG8_MMA(1, 1, At, B1); PG8_BAR; PG8_SCHED;
            PG8_LDB(B0, 1, 0); PG8_LDB(B1, 1, 1); PG8_SCHED; PG8_LDA(At, 1, 0); PG8_STAGE(PG8_SA(0, 1), a2 + hstep, voffA);
            PG8_WAIT_V(8); PG8_WAIT_L(0); PG8_BAR; PG8_MMA(0, 0, At, B0); PG8_MMA(0, 1, At, B1); PG8_BAR; PG8_SCHED;
            PG8_LDA(At, 1, 1); PG8_STAGE(PG8_SB(1, 0), b3, voffB); PG8_STAGE(PG8_SB(1, 1), b3 + hstep, voffB); PG8_STAGE(PG8_SA(1, 0), a3, voffA);
            PG8_WAIT_V(8); PG8_WAIT_L(0); PG8_BAR; PG8_MMA(1, 0, At, B0); PG8_MMA(1, 1, At, B1); PG8_BAR; PG8_SCHED;
            } else {
            PG8_LDB(B0, 0, 0); PG8_SCHED; PG8_LDA(At, 0, 0); PG8_STAGE(PG8_SA(1, 1), a1 + hstep, voffA);
            PG8_WAIT_L(8); PG8_BAR; PG8_WAIT_L(0); PG8_MMA(0, 0, At, B0); PG8_BAR; PG8_SCHED;
            PG8_LDB(B1, 0, 1); PG8_STAGE(PG8_SB(0, 0), b2, voffB);
            PG8_BAR; PG8_WAIT_L(0); PG8_MMA(0, 1, At, B1); PG8_BAR;
            PG8_LDA(At, 0, 1); PG8_STAGE(PG8_SA(0, 0), a2, voffA);
            PG8_BAR; PG8_WAIT_L(0); PG8_MMA(1, 0, At, B0); PG8_BAR; PG8_SCHED;
            PG8_STAGE(PG8_SB(0, 1), b2 + hstep, voffB);
            PG8_WAIT_V(6); PG8_BAR; PG8_MMA(1, 1, At, B1); PG8_BAR;
            PG8_LDB(B0, 1, 0); PG8_SCHED; PG8_LDA(At, 1, 0); PG8_STAGE(PG8_SA(0, 1), a2 + hstep, voffA);
            PG8_WAIT_L(8); PG8_BAR; PG8_WAIT_L(0); PG8_MMA(0, 0, At, B0); PG8_BAR; PG8_SCHED;
            PG8_LDB(B1, 1, 1); PG8_STAGE(PG8_SB(1, 0), b3, voffB);
            PG8_BAR; PG8_WAIT_L(0); PG8_MMA(0, 1, At, B1); PG8_BAR;
            PG8_LDA(At, 1, 1); PG8_STAGE(PG8_SA(1, 0), a3, voffA);
            PG8_BAR; PG8_WAIT_L(0); PG8_MMA(1, 0, At, B0); PG8_BAR; PG8_SCHED;
            PG8_STAGE(PG8_SB(1, 1), b3 + hstep, voffB);
            PG8_WAIT_V(6); PG8_BAR; PG8_MMA(1, 1, At, B1); PG8_BAR;
            }
        }
        if constexpr (ALIGN_EPI) { if (wr == 0) PG8_BAR; }
        if constexpr (!Epi::AFTER_DRAIN) { E(acc, cur, wr, wc, fr, fq); S.done(cur); }
        if (!has_next) break;
#pragma unroll
        for (int a = 0; a < 2; ++a)
#pragma unroll
            for (int b = 0; b < 2; ++b)
#pragma unroll
                for (int m = 0; m < 4; ++m)
#pragma unroll
                    for (int n = 0; n < 2; ++n) acc[a][b][m][n] = (f32x4){0.f, 0.f, 0.f, 0.f};
        cur = nxt; cA = nA; cB = nB; ++ui;
        if constexpr (ALIGN_EPI) { if (wr == 1) PG8_BAR; }
    }
    PG8_WAIT_V(0);
    if constexpr (!ALIGN_EPI) { if (wr == 0) PG8_BAR; }
    PG8_BAR;
#undef PG8_SA
#undef PG8_SB
#undef PG8_STAGE
#undef PG8_LDA
#undef PG8_LDB
#undef PG8_MMA
#undef PG8_WAIT_V
#undef PG8_WAIT_L
#undef PG8_BAR
#undef PG8_SCHED
}
}

constexpr int NWAVES = 8, NTHR = 512;
constexpr int BATCH = 2, SEQ = 8192, D = 2048, M = BATCH * SEQ, CTXL = 256, MC = BATCH * CTXL;
constexpr int RW = 1024, NH = 8, DH = 128, CCH = 1024, INW = 7168, DFF = 5632, NUP = 2 * DFF, NCHK = 64, CHK = 128;
constexpr int NMOD = 6 * D;
constexpr float EPS = 1e-6f;
constexpr float KSCALE = 0.08838834764831845f;
constexpr int NSL = 8;

constexpr size_t MiB = 1u << 20;
constexpr size_t WS_CTL = 0, CTL_ZERO_BYTES = 1 * MiB;
constexpr size_t WS_COS = 1 * MiB, WS_SIN = WS_COS + 16384, WS_PW = WS_COS + 32768, WS_MODF = WS_COS + 65536, WS_MODP = WS_COS + 262144;
constexpr int PWS = 260;
constexpr size_t WS_WOUT = 4 * MiB, WS_WUP = 12 * MiB, WS_WDN = 56 * MiB, WS_XN = 78 * MiB, WS_HC = 142 * MiB, WS_KVC = 144 * MiB, WS_BIG = 146 * MiB;
constexpr size_t WS_P = WS_BIG, WS_CAT = WS_BIG + 224 * MiB, WS_WIN = WS_CAT  , WS_UA = WS_BIG, WS_UB = WS_BIG + 176 * MiB;
constexpr size_t WS_END = WS_BIG + 352 * MiB;
static_assert(WS_MODP + (size_t)NSL * 3 * NMOD * 4 <= WS_WOUT, "tables");
constexpr int CW_BAR = 4096;

constexpr int LDS_BYTES = 147456;
constexpr int MISC_OFF = LDS_BYTES - 256;

#define GAS __attribute__((address_space(1)))
#define LAS __attribute__((address_space(3)))
typedef unsigned short bf16;
typedef unsigned v4u __attribute__((ext_vector_type(4)));
typedef unsigned v2u __attribute__((ext_vector_type(2)));
typedef float f32x4 __attribute__((ext_vector_type(4)));
typedef GAS unsigned gu32;
#define LDS_WAIT() asm volatile("s_waitcnt lgkmcnt(0)" ::: "memory")
#define VM_WAIT() asm volatile("s_waitcnt vmcnt(0)" ::: "memory")
__device__ __forceinline__ unsigned f2bf(float f) { unsigned u = __builtin_bit_cast(unsigned, f); return (u + 0x7fffu + ((u >> 16) & 1u)) >> 16; }
__device__ __forceinline__ unsigned pk2(float lo, float hi) { return f2bf(lo) | (f2bf(hi) << 16); }
__device__ __forceinline__ float bflo(unsigned w) { return __builtin_bit_cast(float, w << 16); }
__device__ __forceinline__ float bfhi(unsigned w) { return __builtin_bit_cast(float, w & 0xffff0000u); }
__device__ __forceinline__ float bf1(bf16 h) { return __builtin_bit_cast(float, ((unsigned)h) << 16); }
__device__ __forceinline__ float silu_f(float x) { return x / (1.f + __expf(-x)); }
__device__ __forceinline__ float wave_sum(float v) {
#pragma unroll
    for (int o = 1; o < 64; o <<= 1) v += __shfl_xor(v, o);
    return v;
}

#define XB_TMO      128
#define XB_XCNT(j)  (256  + 64 * (j))
#define XB_XSUB(j)  (1280 + 64 * (j))
#define XB_XGEN(j)  (2304 + 64 * (j))
#define XB_TOP      3328
#define XB_TOPGEN   3392
#define XCD_BAR_WORDS 3456
#define XB_SPIN_CAP (1u << 18)
__device__ __forceinline__ unsigned xb_ld(unsigned* p)              { return __hip_atomic_load(p, __ATOMIC_RELAXED, __HIP_MEMORY_SCOPE_AGENT); }
__device__ __forceinline__ unsigned xb_add(unsigned* p, unsigned v) { return __hip_atomic_fetch_add(p, v, __ATOMIC_RELAXED, __HIP_MEMORY_SCOPE_AGENT); }
__device__ __forceinline__ unsigned xb_xcc_id() { return (unsigned)__builtin_amdgcn_s_getreg((3 << 11) | 20) & 0xFu; }
#define XB_SPIN(cond, bar) do { unsigned _sp = 0; while (cond) { __builtin_amdgcn_s_sleep(1); \
    if ((++_sp & 255u) == 0u) { if (xb_ld(&(bar)[XB_TMO])) break; if (_sp > XB_SPIN_CAP) { atomicAdd(&(bar)[XB_TMO], 1u); break; } } } } while (0)
struct XcdBarrier { unsigned* bar; unsigned x; volatile LAS unsigned* st; };
__device__ __forceinline__ XcdBarrier xcd_barrier_post(unsigned* bar, volatile LAS unsigned* st) {
    XcdBarrier b; b.bar = bar; b.x = xb_xcc_id(); b.st = st;
    if (threadIdx.x == 0) (void)xb_add(&bar[XB_XCNT(b.x)], 1u);
    return b;
}
__device__ __forceinline__ void xcd_barrier_complete(unsigned* bar, unsigned x, unsigned& nloc, unsigned& nx) {
    const unsigned G = gridDim.x * gridDim.y * gridDim.z;
    unsigned sum, cnt, mine, sp = 0u;
    for (;;) {
        sum = 0u; cnt = 0u; mine = 0u;
#pragma unroll
        for (unsigned j = 0; j < 16; ++j) { const unsigned c = xb_ld(&bar[XB_XCNT(j)]); sum += c; cnt += (c > 0u) ? 1u : 0u; mine = (j == x) ? c : mine; }
        if (sum == G) break;
        __builtin_amdgcn_s_sleep(1);
        if ((++sp & 255u) == 0u) { if (xb_ld(&bar[XB_TMO])) break; if (sp > XB_SPIN_CAP) { atomicAdd(&bar[XB_TMO], 1u); break; } }
    }
    nloc = mine > 0u ? mine : 1u; nx = cnt > 0u ? cnt : 1u;
}
__device__ __forceinline__ void xcd_barrier(const XcdBarrier& b) {
    asm volatile("s_waitcnt vmcnt(0)" ::: "memory");
    __syncthreads();
    if (threadIdx.x == 0) {
        unsigned* bar = b.bar;
        __builtin_amdgcn_s_waitcnt(0);
        unsigned nloc = b.st[0], nx = b.st[1];
        if (nloc == 0u) { xcd_barrier_complete(bar, b.x, nloc, nx); b.st[0] = nloc; b.st[1] = nx; }
        const unsigned old = xb_add(&bar[XB_XSUB(b.x)], 1u);
        const unsigned gen = old / nloc;
        if (old + 1u == (gen + 1u) * nloc) {
            __builtin_amdgcn_fence(__ATOMIC_RELEASE, "agent");
            asm volatile("s_waitcnt vmcnt(0)" ::: "memory");
            const unsigned og = xb_add(&bar[XB_TOP], 1u);
            const unsigned tg = og / nx;
            if (og + 1u == (tg + 1u) * nx) xb_add(&bar[XB_TOPGEN], 1u);
            else XB_SPIN(xb_ld(&bar[XB_TOPGEN]) == tg, bar);
            __builtin_amdgcn_fence(__ATOMIC_ACQUIRE, "agent");
            xb_add(&bar[XB_XGEN(b.x)], 1u);
            asm volatile("s_waitcnt vmcnt(0)" ::: "memory");
        } else {
            XB_SPIN(xb_ld(&bar[XB_XGEN(b.x)]) == gen, bar);
            __builtin_amdgcn_fence(__ATOMIC_ACQUIRE, "agent");
            asm volatile("s_waitcnt vmcnt(0)" ::: "memory");
        }
    }
    __syncthreads();
}

struct Args { const float* in[18]; float* out; unsigned char* ws; int ph_lo, ph_hi; };
enum { IN_X = 0, IN_C, IN_CTX, IN_CCTX, IN_WMOD, IN_BMOD, IN_G1, IN_WIN, IN_DECF, IN_DECB, IN_CONVW, IN_WOUT, IN_G2, IN_WUP, IN_FCW, IN_FCB, IN_WDN, IN_GF };
enum { PH_PRO = 0, PH_NORM1, PH_GEMM_IN, PH_KV, PH_SCAN, PH_RETOUT, PH_GEMM_OUT, PH_NORM2, PH_GEMM_UP, PH_GATE, PH_GEMM_DN, PH_FNORM, NPH };

template <bool PERMQK>
__device__ __forceinline__ void p0_transpose_item(const float* W, int K, int N, bf16* WT, LAS float* scr, int item, int lane) {
    const int nblk = N / 32, kb = item / nblk, nb = item % nblk, k0 = 64 * kb, n0 = 32 * nb;
#pragma unroll 8
    for (int i = 0; i < 32; ++i) { const int kk = 2 * i + (lane >> 5); scr[kk * 33 + (lane & 31)] = W[(size_t)(k0 + kk) * N + n0 + (lane & 31)]; }
    LDS_WAIT(); asm volatile("" ::: "memory");
    const int c = lane & 7;
#pragma unroll
    for (int j = 0; j < 4; ++j) { const int n = (lane >> 3) + 8 * j; const LAS float* s = scr + (8 * c) * 33 + n;
        v4u o; o.x = pk2(s[0 * 33], s[1 * 33]); o.y = pk2(s[2 * 33], s[3 * 33]); o.z = pk2(s[4 * 33], s[5 * 33]); o.w = pk2(s[6 * 33], s[7 * 33]);
        int ng = n0 + n;
        if (PERMQK) { if (ng < 2 * RW) ng = (ng & ~63) + 2 * (ng & 31) + ((ng >> 5) & 1); }
        *(GAS v4u*)(WT + (size_t)ng * K + k0 + 8 * c) = o; }
    LDS_WAIT(); asm volatile("" ::: "memory");
}

__device__ __forceinline__ void norm_row_bf16(const float* xrow, bf16* orow, const LAS float* mulT, const LAS float* addT, int lane) {
    const GAS f32x4* xr = (const GAS f32x4*)xrow + lane;
    f32x4 v[8]; float s = 0.f;
#pragma unroll
    for (int j = 0; j < 8; ++j) { v[j] = xr[64 * j]; s += (v[j].x * v[j].x + v[j].y * v[j].y) + (v[j].z * v[j].z + v[j].w * v[j].w); }
    const float rstd = rsqrtf(wave_sum(s) * (1.f / D) + EPS);
    GAS v2u* o8 = (GAS v2u*)orow + lane;
#pragma unroll
    for (int j = 0; j < 8; ++j) { const f32x4 mu = *(const LAS f32x4*)(mulT + 4 * (lane + 64 * j)), ad = *(const LAS f32x4*)(addT + 4 * (lane + 64 * j));
        const f32x4 y = v[j] * rstd * mu + ad; v2u w; w.x = pk2(y.x, y.y); w.y = pk2(y.z, y.w); o8[64 * j] = w; }
}

__global__ void __launch_bounds__(NTHR, 2) fwd_kernel(Args args) {
    extern __shared__ __attribute__((aligned(16))) unsigned char lds_raw[];
    LAS unsigned char* lds = (LAS unsigned char*)lds_raw;
    volatile LAS unsigned* MISC = (volatile LAS unsigned*)(lds + MISC_OFF);
    const int tid = threadIdx.x, lane = tid & 63, wave = __builtin_amdgcn_readfirstlane(tid >> 6);
    const int G = gridDim.x, bx = blockIdx.x;
    const int gw = bx * NWAVES + wave, NGW = G * NWAVES;
    const int gtid = bx * NTHR + tid, NGT = G * NTHR;
    unsigned char* ws = args.ws;
    const float* x = args.in[IN_X]; float* out = args.out;
    float* COS = (float*)(ws + WS_COS); float* SIN = (float*)(ws + WS_SIN); float* PW = (float*)(ws + WS_PW);
    float* MODF = (float*)(ws + WS_MODF); float* MODP = (float*)(ws + WS_MODP);
    bf16* WIN_T = (bf16*)(ws + WS_WIN); bf16* WOUT_T = (bf16*)(ws + WS_WOUT); bf16* WUP_T = (bf16*)(ws + WS_WUP); bf16* WDN_T = (bf16*)(ws + WS_WDN);
    bf16* XN = (bf16*)(ws + WS_XN); bf16* HC = (bf16*)(ws + WS_HC); bf16* KVC = (bf16*)(ws + WS_KVC);
    bf16* P = (bf16*)(ws + WS_P); bf16* CAT = (bf16*)(ws + WS_CAT); bf16* UA = (bf16*)(ws + WS_UA); bf16* UB = (bf16*)(ws + WS_UB);
    float* KVS = out;

    if (tid < 64) MISC[tid] = 0u;
    __syncthreads();
#if ONE_LAUNCH
    XcdBarrier bar = xcd_barrier_post((unsigned*)(ws + WS_CTL) + CW_BAR, MISC + 8);
#define GRID_BAR() xcd_barrier(bar)
#else
#define GRID_BAR() do {} while (0)
#endif
    const int lo = args.ph_lo, hi = args.ph_hi;
#ifndef PHMASK
#define PHMASK 0xFFF
#endif
#define IN(k) (((PHMASK >> (k)) & 1) && lo <= (k) && (k) < hi)
#define BOTH(k) (IN(k) && IN((k) + 1))

    if (IN(PH_PRO)) {
        LAS float* scr = (LAS float*)(lds + wave * 16384);
        constexpr int I_IN = (D / 64) * (INW / 32), I_OUT = (D / 64) * (D / 32), I_UP = (D / 64) * (NUP / 32), I_DN = (DFF / 64) * (D / 32), I_GV = NSL * (NMOD / 256);
        constexpr int NIT = I_IN + I_OUT + I_UP + I_DN + I_GV;
        for (int it = gw; it < NIT; it += NGW) {
            int r = it;
            if (r < I_IN) { p0_transpose_item<true>(args.in[IN_WIN], D, INW, WIN_T, scr, r, lane); continue; } r -= I_IN;
            if (r < I_OUT) { p0_transpose_item<false>(args.in[IN_WOUT], D, D, WOUT_T, scr, r, lane); continue; } r -= I_OUT;
            if (r < I_UP) { p0_transpose_item<false>(args.in[IN_WUP], D, NUP, WUP_T, scr, r, lane); continue; } r -= I_UP;
            if (r < I_DN) { p0_transpose_item<false>(args.in[IN_WDN], DFF, D, WDN_T, scr, r, lane); continue; } r -= I_DN;
            {
                const int s = r / (NMOD / 256), cgp = r % (NMOD / 256), col = cgp * 256 + lane * 4;
                f32x4 a0 = (f32x4){0.f, 0.f, 0.f, 0.f}, a1 = a0, a2 = a0;
                for (int kb = 0; kb < 4; ++kb) {
                    const int kbase = s * 256 + kb * 64;
                    const float c0 = silu_f(args.in[IN_C][kbase + lane]), c1 = silu_f(args.in[IN_C][D + kbase + lane]), c2 = silu_f(args.in[IN_CCTX][kbase + lane]);
                    const float* wp = args.in[IN_WMOD] + (size_t)kbase * NMOD + col;
#pragma unroll 8
                    for (int kk = 0; kk < 64; ++kk) {
                        const f32x4 w = *(const f32x4*)(wp + (size_t)kk * NMOD);
                        const float b0 = __shfl(c0, kk), b1 = __shfl(c1, kk), b2 = __shfl(c2, kk);
                        a0 += w * b0; a1 += w * b1; a2 += w * b2;
                    }
                }
                *(f32x4*)(MODP + ((size_t)(s * 3 + 0)) * NMOD + col) = a0;
                *(f32x4*)(MODP + ((size_t)(s * 3 + 1)) * NMOD + col) = a1;
                *(f32x4*)(MODP + ((size_t)(s * 3 + 2)) * NMOD + col) = a2;
            }
        }
        if (gtid < 4096) { const int pos = gtid >> 5, i = gtid & 31; const float fr = powf(10000.f, -(float)i / 32.f); const float ang = (float)pos * fr; COS[gtid] = cosf(ang); SIN[gtid] = sinf(ang); }
        else if (gtid < 4096 + 2 * NH * 257) { const int idx = gtid - 4096, dir = idx / (NH * 257), h = (idx / 257) % NH, k = idx % 257;
            const float lg0 = args.in[dir ? IN_DECB : IN_DECF][h]; const float lg = fminf(lg0, 0.f) - log1pf(expf(-fabsf(lg0)));
            PW[(dir * NH + h) * PWS + k] = expf(lg * (float)k); }
        if (BOTH(PH_PRO)) GRID_BAR();
    }

    if (IN(PH_NORM1)) {
        LAS float* mulT = (LAS float*)lds;
        LAS float* addT = (LAS float*)(lds + 3 * D * 4);
        for (int i = tid; i < 3 * D; i += NTHR) { const int r = i / D, k = i % D;
            float sh = args.in[IN_BMOD][k], sc = args.in[IN_BMOD][D + k];
#pragma unroll
            for (int s = 0; s < NSL; ++s) { sh += MODP[(size_t)(s * 3 + r) * NMOD + k]; sc += MODP[(size_t)(s * 3 + r) * NMOD + D + k]; }
            mulT[i] = args.in[IN_G1][k] * (1.f + sc); addT[i] = sh; }
        for (int i = gtid; i < 3 * NMOD; i += NGT) { const int r = i / NMOD, col = i % NMOD; float a = args.in[IN_BMOD][col];
#pragma unroll
            for (int s = 0; s < NSL; ++s) a += MODP[(size_t)(s * 3 + r) * NMOD + col];
            MODF[i] = a; }
        __syncthreads();
        for (int m = gw; m < M + MC; m += NGW) {
            if (m < M) { const int b = m >> 13; norm_row_bf16(x + (size_t)m * D, XN + (size_t)m * D, mulT + b * D, addT + b * D, lane); }
            else { const int mc = m - M; norm_row_bf16(args.in[IN_CTX] + (size_t)mc * D, HC + (size_t)mc * D, mulT + 2 * D, addT + 2 * D, lane); }
        }
        if (BOTH(PH_NORM1)) GRID_BAR();
    }

    if (IN(PH_GEMM_IN)) {
        __syncthreads();
        { pg8::Gemm g{XN, WIN_T, M, INW, D}; pg8::StaticOrder S; S.init(M, INW, G, bx);
          pg8::EpiBf16R E{P, INW, 0, 0, COS, SIN, 8, 4, 8, KSCALE};
          pg8::gemm_phase<pg8::EpiBf16R, pg8::StaticOrder, true, true>(lds, g, S, E); }
        { pg8::Gemm g{HC, WIN_T + (size_t)RW * D, MC, 2 * RW, D}; pg8::StaticOrder S; S.init(MC, 2 * RW, G, bx);
          pg8::EpiBf16R E{KVC, 2 * RW, 0, 0, COS, SIN, 0, 0, 4, KSCALE};
          pg8::gemm_phase<pg8::EpiBf16R, pg8::StaticOrder, true, true>(lds, g, S, E); }
        if (BOTH(PH_GEMM_IN)) GRID_BAR();
    }

    if (IN(PH_KV)) {
        __syncthreads();
        LAS float* Kf = (LAS float*)lds;
        LAS float* Vf = (LAS float*)(lds + 65536);
        for (int item = bx; item < BATCH * NH * NCHK; item += G) {
            const int b = item >> 9, h = (item >> 6) & 7, ch = item & 63;
            const size_t tok0 = (size_t)b * SEQ + (size_t)ch * CHK;
#pragma unroll
            for (int i = 0; i < 4; ++i) { const int p = tid + NTHR * i, row = p >> 4, c16 = p & 15;
                const v4u kq = *(const GAS v4u*)(P + (tok0 + row) * INW + RW + h * DH + c16 * 8);
                const v4u vq = *(const GAS v4u*)(P + (tok0 + row) * INW + 2 * RW + h * DH + c16 * 8);
                LAS f32x4* kd = (LAS f32x4*)(Kf + row * 128 + c16 * 8); LAS f32x4* vd = (LAS f32x4*)(Vf + row * 128 + c16 * 8);
                kd[0] = (f32x4){bflo(kq.x), bfhi(kq.x), bflo(kq.y), bfhi(kq.y)}; kd[1] = (f32x4){bflo(kq.z), bfhi(kq.z), bflo(kq.w), bfhi(kq.w)};
                vd[0] = (f32x4){bflo(vq.x), bfhi(vq.x), bflo(vq.y), bfhi(vq.y)}; vd[1] = (f32x4){bflo(vq.z), bfhi(vq.z), bflo(vq.w), bfhi(vq.w)}; }
            __syncthreads();
            const int dk0 = (tid >> 4) * 4, dv0 = (tid & 15) * 8;
            float af[4][8], ab[4][8];
#pragma unroll
            for (int a = 0; a < 4; ++a)
#pragma unroll
                for (int c = 0; c < 8; ++c) { af[a][c] = 0.f; ab[a][c] = 0.f; }
            const float* pwf = PW + (0 * NH + h) * PWS; const float* pwb = PW + (1 * NH + h) * PWS;
            for (int j = 0; j < CHK; ++j) {
                const float wf = pwf[127 - j], wb = pwb[j];
                const f32x4 k4 = *(const LAS f32x4*)(Kf + j * 128 + dk0);
                const f32x4 v0 = *(const LAS f32x4*)(Vf + j * 128 + dv0), v1 = *(const LAS f32x4*)(Vf + j * 128 + dv0 + 4);
#pragma unroll
                for (int a = 0; a < 4; ++a) { const float kf = k4[a] * wf, kb = k4[a] * wb;
#pragma unroll
                    for (int c = 0; c < 4; ++c) { af[a][c] += kf * v0[c]; af[a][c + 4] += kf * v1[c]; ab[a][c] += kb * v0[c]; ab[a][c + 4] += kb * v1[c]; } }
            }
            float* of = KVS + ((((size_t)(0 * BATCH + b) * NH + h) * NCHK + ch) * DH) * DH;
            float* ob = KVS + ((((size_t)(1 * BATCH + b) * NH + h) * NCHK + ch) * DH) * DH;
#pragma unroll
            for (int a = 0; a < 4; ++a) {
                *(f32x4*)(of + (size_t)(dk0 + a) * DH + dv0) = (f32x4){af[a][0], af[a][1], af[a][2], af[a][3]}; *(f32x4*)(of + (size_t)(dk0 + a) * DH + dv0 + 4) = (f32x4){af[a][4], af[a][5], af[a][6], af[a][7]};
                *(f32x4*)(ob + (size_t)(dk0 + a) * DH + dv0) = (f32x4){ab[a][0], ab[a][1], ab[a][2], ab[a][3]}; *(f32x4*)(ob + (size_t)(dk0 + a) * DH + dv0 + 4) = (f32x4){ab[a][4], ab[a][5], ab[a][6], ab[a][7]}; }
            __syncthreads();
        }
        for (int item = bx; item < M / 64; item += G) {
            const int c8 = tid & 127, tg = tid >> 7;
            const size_t n0 = (size_t)item * 64 + tg * 16;
            const float* cw = args.in[IN_CONVW];
            float w0[8], w1[8], w2[8];
#pragma unroll
            for (int e = 0; e < 8; ++e) { w0[e] = cw[c8 * 8 + e]; w1[e] = cw[CCH + c8 * 8 + e]; w2[e] = cw[2 * CCH + c8 * 8 + e]; }
            float pv[8], cv[8], nv[8];
            auto ldch = [&](size_t n, float* o) { const v4u cq = *(const GAS v4u*)(P + n * INW + 5 * RW + c8 * 8), hq = *(const GAS v4u*)(P + n * INW + 6 * RW + c8 * 8);
                o[0] = bflo(cq.x) * bflo(hq.x); o[1] = bfhi(cq.x) * bfhi(hq.x); o[2] = bflo(cq.y) * bflo(hq.y); o[3] = bfhi(cq.y) * bfhi(hq.y);
                o[4] = bflo(cq.z) * bflo(hq.z); o[5] = bfhi(cq.z) * bfhi(hq.z); o[6] = bflo(cq.w) * bflo(hq.w); o[7] = bfhi(cq.w) * bfhi(hq.w); };
            if (tg > 0) ldch(n0 - 1, pv); else {
#pragma unroll
                for (int e = 0; e < 8; ++e) pv[e] = 0.f; }
            ldch(n0, cv);
            for (int t = 0; t < 16; ++t) {
                const size_t n = n0 + t;
                if ((n & 63) != 63) ldch(n + 1, nv); else {
#pragma unroll
                    for (int e = 0; e < 8; ++e) nv[e] = 0.f; }
                const v4u bq = *(const GAS v4u*)(P + n * INW + 4 * RW + c8 * 8);
                float bb[8] = {bflo(bq.x), bfhi(bq.x), bflo(bq.y), bfhi(bq.y), bflo(bq.z), bfhi(bq.z), bflo(bq.w), bfhi(bq.w)};
                float o[8];
#pragma unroll
                for (int e = 0; e < 8; ++e) { o[e] = bb[e] * (w0[e] * pv[e] + w1[e] * cv[e] + w2[e] * nv[e]); pv[e] = cv[e]; cv[e] = nv[e]; }
                v4u w; w.x = pk2(o[0], o[1]); w.y = pk2(o[2], o[3]); w.z = pk2(o[4], o[5]); w.w = pk2(o[6], o[7]);
                *(GAS v4u*)(CAT + n * D + RW + c8 * 8) = w;
            }
        }
        if (BOTH(PH_KV)) GRID_BAR();
    }

    if (IN(PH_SCAN)) {
        for (int e4 = gtid; e4 < 2 * BATCH * NH * DH * DH / 4; e4 += NGT) {
            const int dv4 = e4 & 31, dk = (e4 >> 5) & 127, h = (e4 >> 12) & 7, b = (e4 >> 15) & 1, dir = e4 >> 16;
            const float* pw = PW + (dir * NH + h) * PWS;
            f32x4 s = (f32x4){0.f, 0.f, 0.f, 0.f};
            for (int t = 0; t < CTXL; ++t) {
                const float w = dir ? pw[t] : pw[CTXL - 1 - t];
                const bf16* row = KVC + (size_t)(b * CTXL + t) * (2 * RW);
                const float kk = bf1(row[h * DH + dk]) * w;
                const v2u vq = *(const GAS v2u*)(row + RW + h * DH + dv4 * 4);
                s += (f32x4){bflo(vq.x), bfhi(vq.x), bflo(vq.y), bfhi(vq.y)} * kk;
            }
            const float cd = pw[CHK];
            float* base = KVS + (((size_t)(dir * BATCH + b) * NH + h) * NCHK) * DH * DH + (size_t)dk * DH + dv4 * 4;
#pragma unroll 8
            for (int i = 0; i < NCHK; ++i) {
                const int n = dir ? (NCHK - 1 - i) : i;
                f32x4* p = (f32x4*)(base + (size_t)n * DH * DH);
                const f32x4 t = *p; *p = s; s = s * cd + t;
            }
        }
        if (BOTH(PH_SCAN)) GRID_BAR();
    }

    if (IN(PH_RETOUT)) {
        __syncthreads();
        constexpr int LS = 136;
        LAS bf16* Qs = (LAS bf16*)lds; LAS bf16* Ks = Qs + 128 * LS; LAS bf16* Vs = Ks + 128 * LS; LAS bf16* Ps = Vs + 128 * LS;
        LAS float* pwl = (LAS float*)(lds + 4 * 128 * LS * 2);
        for (int item = bx; item < BATCH * NH * NCHK; item += G) {
            const int b = item >> 9, h = (item >> 6) & 7, ch = item & 63;
            const size_t tok0 = (size_t)b * SEQ + (size_t)ch * CHK;
#pragma unroll
            for (int i = 0; i < 4; ++i) { const int p = tid + NTHR * i, row = p >> 4, c16 = p & 15;
                *(LAS v4u*)(Qs + row * LS + c16 * 8) = *(const GAS v4u*)(P + (tok0 + row) * INW + h * DH + c16 * 8);
                *(LAS v4u*)(Ks + row * LS + c16 * 8) = *(const GAS v4u*)(P + (tok0 + row) * INW + RW + h * DH + c16 * 8);
                *(LAS v4u*)(Vs + row * LS + c16 * 8) = *(const GAS v4u*)(P + (tok0 + row) * INW + 2 * RW + h * DH + c16 * 8); }
            if (tid < 2 * 129) { const int dir = tid / 129, k = tid % 129; pwl[dir * 132 + k] = PW[(dir * NH + h) * PWS + k]; }
            __syncthreads();
            const int ig = tid >> 4, jl = tid & 15;
#pragma unroll 1
            for (int half = 0; half < 2; ++half) {
                float sc[4][4];
#pragma unroll
                for (int a = 0; a < 4; ++a)
#pragma unroll
                    for (int c = 0; c < 4; ++c) sc[a][c] = 0.f;
#pragma unroll 1
                for (int d8 = 0; d8 < 16; ++d8) {
                    v4u q[4], k[4];
#pragma unroll
                    for (int a = 0; a < 4; ++a) q[a] = *(const LAS v4u*)(Qs + (4 * ig + a) * LS + d8 * 8);
#pragma unroll
                    for (int c = 0; c < 4; ++c) k[c] = *(const LAS v4u*)(Ks + (jl + 16 * (4 * half + c)) * LS + d8 * 8);
#pragma unroll
                    for (int a = 0; a < 4; ++a)
#pragma unroll
                        for (int c = 0; c < 4; ++c) {
                            sc[a][c] += bflo(q[a].x) * bflo(k[c].x) + bfhi(q[a].x) * bfhi(k[c].x) + bflo(q[a].y) * bflo(k[c].y) + bfhi(q[a].y) * bfhi(k[c].y)
                                      + bflo(q[a].z) * bflo(k[c].z) + bfhi(q[a].z) * bfhi(k[c].z) + bflo(q[a].w) * bflo(k[c].w) + bfhi(q[a].w) * bfhi(k[c].w); }
                }
#pragma unroll
                for (int a = 0; a < 4; ++a)
#pragma unroll
                    for (int c = 0; c < 4; ++c) { const int i = 4 * ig + a, j = jl + 16 * (4 * half + c);
                        const float dm = (j <= i) ? pwl[i - j] : pwl[132 + (j - i)];
                        Ps[i * LS + j] = (bf16)f2bf(sc[a][c] * dm); }
            }
            __syncthreads();
            {
                const int dv0 = 8 * jl;
                float o[4][8];
#pragma unroll
                for (int a = 0; a < 4; ++a)
#pragma unroll
                    for (int c = 0; c < 8; ++c) o[a][c] = 0.f;
#pragma unroll 1
                for (int j8 = 0; j8 < 16; ++j8) {
                    v4u p[4];
#pragma unroll
                    for (int a = 0; a < 4; ++a) p[a] = *(const LAS v4u*)(Ps + (4 * ig + a) * LS + j8 * 8);
#pragma unroll
                    for (int jj = 0; jj < 8; ++jj) {
                        const v4u vq = *(const LAS v4u*)(Vs + (j8 * 8 + jj) * LS + dv0);
                        const float vv[8] = {bflo(vq.x), bfhi(vq.x), bflo(vq.y), bfhi(vq.y), bflo(vq.z), bfhi(vq.z), bflo(vq.w), bfhi(vq.w)};
#pragma unroll
                        for (int a = 0; a < 4; ++a) { const unsigned pw_ = (jj >> 1) == 0 ? p[a].x : (jj >> 1) == 1 ? p[a].y : (jj >> 1) == 2 ? p[a].z : p[a].w;
                            const float pa = (jj & 1) ? bfhi(pw_) : bflo(pw_);
#pragma unroll
                            for (int c = 0; c < 8; ++c) o[a][c] += pa * vv[c]; }
                    }
                }
                const float* Sf = KVS + ((((size_t)(0 * BATCH + b) * NH + h) * NCHK + ch) * DH) * DH;
                const float* Sb = KVS + ((((size_t)(1 * BATCH + b) * NH + h) * NCHK + ch) * DH) * DH;
                float qdf[4], qdb[4];
#pragma unroll
                for (int a = 0; a < 4; ++a) { const int i = 4 * ig + a; qdf[a] = pwl[i + 1]; qdb[a] = pwl[132 + (CHK - i)]; }
#pragma unroll 1
                for (int kp = 0; kp < 64; ++kp) {
                    unsigned qw[4];
#pragma unroll
                    for (int a = 0; a < 4; ++a) qw[a] = *(const LAS unsigned*)(Qs + (4 * ig + a) * LS + kp * 2);
#pragma unroll
                    for (int kk = 0; kk < 2; ++kk) {
                        const int dk = kp * 2 + kk;
                        const f32x4 f0 = *(const f32x4*)(Sf + (size_t)dk * DH + dv0), f1 = *(const f32x4*)(Sf + (size_t)dk * DH + dv0 + 4);
                        const f32x4 b0 = *(const f32x4*)(Sb + (size_t)dk * DH + dv0), b1 = *(const f32x4*)(Sb + (size_t)dk * DH + dv0 + 4);
#pragma unroll
                        for (int a = 0; a < 4; ++a) { const float qa = kk ? bfhi(qw[a]) : bflo(qw[a]); const float qaf = qa * qdf[a], qab = qa * qdb[a];
#pragma unroll
                            for (int c = 0; c < 4; ++c) { o[a][c] += qaf * f0[c] + qab * b0[c]; o[a][c + 4] += qaf * f1[c] + qab * b1[c]; } }
                    }
                }
#pragma unroll
                for (int a = 0; a < 4; ++a) { const int i = 4 * ig + a;
                    float ss = 0.f;
#pragma unroll
                    for (int c = 0; c < 8; ++c) ss += o[a][c] * o[a][c];
                    ss += __shfl_xor(ss, 1); ss += __shfl_xor(ss, 2); ss += __shfl_xor(ss, 4); ss += __shfl_xor(ss, 8);
                    const float rstd = rsqrtf(ss * (1.f / DH) + EPS);
                    const v4u gq = *(const GAS v4u*)(P + (tok0 + i) * INW + 3 * RW + h * DH + dv0);
                    const float gg[8] = {bflo(gq.x), bfhi(gq.x), bflo(gq.y), bfhi(gq.y), bflo(gq.z), bfhi(gq.z), bflo(gq.w), bfhi(gq.w)};
                    float r[8];
#pragma unroll
                    for (int c = 0; c < 8; ++c) r[c] = o[a][c] * rstd * silu_f(gg[c]);
                    v4u w; w.x = pk2(r[0], r[1]); w.y = pk2(r[2], r[3]); w.z = pk2(r[4], r[5]); w.w = pk2(r[6], r[7]);
                    *(GAS v4u*)(CAT + (tok0 + i) * D + h * DH + dv0) = w; }
            }
            __syncthreads();
        }
        if (BOTH(PH_RETOUT)) GRID_BAR();
    }

    if (IN(PH_GEMM_OUT)) {
        __syncthreads();
        pg8::Gemm g{CAT, WOUT_T, M, D, D}; pg8::StaticOrder S; S.init(M, D, G, bx);
        pg8::EpiRes E{x, out, D, MODF + 2 * D, NMOD};
        pg8::gemm_phase<pg8::EpiRes, pg8::StaticOrder, true, true>(lds, g, S, E);
        if (BOTH(PH_GEMM_OUT)) GRID_BAR();
    }

    if (IN(PH_NORM2)) {
        __syncthreads();
        LAS float* mulT = (LAS float*)lds; LAS float* addT = (LAS float*)(lds + 2 * D * 4);
        for (int i = tid; i < 2 * D; i += NTHR) { const int r = i / D, k = i % D;
            mulT[i] = args.in[IN_G2][k] * (1.f + MODF[(size_t)r * NMOD + 4 * D + k]); addT[i] = MODF[(size_t)r * NMOD + 3 * D + k]; }
        __syncthreads();
        for (int m = gw; m < M; m += NGW) { const int b = m >> 13; norm_row_bf16(out + (size_t)m * D, XN + (size_t)m * D, mulT + b * D, addT + b * D, lane); }
        if (BOTH(PH_NORM2)) GRID_BAR();
    }

    if (IN(PH_GEMM_UP)) {
        __syncthreads();
        pg8::Gemm g{XN, WUP_T, M, NUP, D}; pg8::StaticOrder S; S.init(M, NUP, G, bx);
        pg8::EpiBf16R E{UA, DFF, DFF, (size_t)(WS_UB - WS_UA) / 2, COS, SIN, 0, 0, 0, 1.f};
        pg8::gemm_phase<pg8::EpiBf16R, pg8::StaticOrder, true, true>(lds, g, S, E);
        if (BOTH(PH_GEMM_UP)) GRID_BAR();
    }

    if (IN(PH_GATE)) {
        const float* fw = args.in[IN_FCW]; const float* fb = args.in[IN_FCB];
        for (int idx = gtid; idx < M * (DFF / 8); idx += NGT) {
            const int n = idx / (DFF / 8), c8 = idx % (DFF / 8), grow = (n & (SEQ - 1)) >> 6;
            const size_t off = (size_t)n * DFF + c8 * 8;
            const v4u z = (v4u){0u, 0u, 0u, 0u};
            const v4u a0 = grow > 0 ? *(const GAS v4u*)(UA + off - (size_t)64 * DFF) : z;
            const v4u a1 = *(const GAS v4u*)(UA + off);
            const v4u a2 = grow < 127 ? *(const GAS v4u*)(UA + off + (size_t)64 * DFF) : z;
            const v4u bq = *(const GAS v4u*)(UB + off);
            const float A0[8] = {bflo(a0.x), bfhi(a0.x), bflo(a0.y), bfhi(a0.y), bflo(a0.z), bfhi(a0.z), bflo(a0.w), bfhi(a0.w)};
            const float A1[8] = {bflo(a1.x), bfhi(a1.x), bflo(a1.y), bfhi(a1.y), bflo(a1.z), bfhi(a1.z), bflo(a1.w), bfhi(a1.w)};
            const float A2[8] = {bflo(a2.x), bfhi(a2.x), bflo(a2.y), bfhi(a2.y), bflo(a2.z), bfhi(a2.z), bflo(a2.w), bfhi(a2.w)};
            const float BB[8] = {bflo(bq.x), bfhi(bq.x), bflo(bq.y), bfhi(bq.y), bflo(bq.z), bfhi(bq.z), bflo(bq.w), bfhi(bq.w)};
            float o[8];
#pragma unroll
            for (int e = 0; e < 8; ++e) { const int c = c8 * 8 + e; const float av = fw[c] * A0[e] + fw[DFF + c] * A1[e] + fw[2 * DFF + c] * A2[e] + fb[c]; o[e] = silu_f(av) * BB[e]; }
            v4u w; w.x = pk2(o[0], o[1]); w.y = pk2(o[2], o[3]); w.z = pk2(o[4], o[5]); w.w = pk2(o[6], o[7]);
            *(GAS v4u*)(UB + off) = w;
        }
        if (BOTH(PH_GATE)) GRID_BAR();
    }

    if (IN(PH_GEMM_DN)) {
        __syncthreads();
        pg8::Gemm g{UB, WDN_T, M, D, DFF}; pg8::StaticOrder S; S.init(M, D, G, bx);
        pg8::EpiRes E{out, out, D, MODF + 5 * D, NMOD};
        pg8::gemm_phase<pg8::EpiRes, pg8::StaticOrder, true, true>(lds, g, S, E);
        if (BOTH(PH_GEMM_DN)) GRID_BAR();
    }

    if (IN(PH_FNORM)) {
        const float* gfin = args.in[IN_GF];
        for (int m = gw; m < M; m += NGW) {
            GAS f32x4* xr = (GAS f32x4*)(out + (size_t)m * D) + lane;
            f32x4 v[8]; float s = 0.f;
#pragma unroll
            for (int j = 0; j < 8; ++j) { v[j] = xr[64 * j]; s += (v[j].x * v[j].x + v[j].y * v[j].y) + (v[j].z * v[j].z + v[j].w * v[j].w); }
            const float rstd = rsqrtf(wave_sum(s) * (1.f / D) + EPS);
#pragma unroll
            for (int j = 0; j < 8; ++j) { const f32x4 gg = *(const f32x4*)(gfin + 4 * (lane + 64 * j)); xr[64 * j] = v[j] * rstd * gg; }
        }
    }
#undef IN
#undef BOTH
}

extern "C" void kernel_launch(void* const* d_in, const int* in_sizes, int n_in, void* d_out, int out_size, void* d_ws, size_t ws_size, hipStream_t stream) {
    static int grid = 0;
    if (grid == 0) {
        if (n_in != 18 || in_sizes[0] != M * D || out_size != M * D || ws_size < WS_END) { fprintf(stderr, "kernel_launch: unexpected shapes/workspace (n_in %d, in0 %d, out %d, ws %zu, need %zu); nothing launched\n", n_in, n_in > 0 ? in_sizes[0] : -1, out_size, ws_size, (size_t)WS_END); grid = -1; return; }
        int dev = 0, cus = 0, per_cu = 0;
        if (hipGetDevice(&dev) != hipSuccess || hipDeviceGetAttribute(&cus, hipDeviceAttributeMultiprocessorCount, dev) != hipSuccess) { grid = -1; return; }
        if (hipFuncSetAttribute((const void*)fwd_kernel, hipFuncAttributeMaxDynamicSharedMemorySize, LDS_BYTES) != hipSuccess) { fprintf(stderr, "kernel_launch: hipFuncSetAttribute failed\n"); grid = -1; return; }
        if (hipOccupancyMaxActiveBlocksPerMultiprocessor(&per_cu, (const void*)fwd_kernel, NTHR, LDS_BYTES) != hipSuccess || per_cu < 1) { fprintf(stderr, "kernel_launch: occupancy query says %d\n", per_cu); per_cu = 1; }
        (void)hipGetLastError();
        grid = cus * (per_cu < 1 ? 1 : 1);
    }
    if (grid < 0) return;
    (void)hipMemsetAsync((char*)d_ws + WS_CTL, 0, CTL_ZERO_BYTES, stream);
    Args a{};
    for (int i = 0; i < 18; ++i) a.in[i] = (const float*)d_in[i];
    a.out = (float*)d_out; a.ws = (unsigned char*)d_ws;
#if ONE_LAUNCH
    a.ph_lo = 0; a.ph_hi = NPH;
    void* kargs[] = {&a};
    hipError_t e = hipLaunchCooperativeKernel((const void*)fwd_kernel, dim3(grid), dim3(NTHR), kargs, LDS_BYTES, stream);
    if (e != hipSuccess) fprintf(stderr, "kernel_launch: cooperative launch failed: %s (grid %d)\n", hipGetErrorString(e), grid);
#else
    for (int p = 0; p < NPH; ++p) { a.ph_lo = p; a.ph_hi = p + 1; hipLaunchKernelGGL(fwd_kernel, dim3(grid), dim3(NTHR), LDS_BYTES, stream, a); }
#endif
}
```

```cpp
#include <hip/hip_runtime.h>
#include <cstdio>
#include <cstdint>

#ifndef ONE_LAUNCH
#define ONE_LAUNCH 1
#endif

namespace pg8 {
#define PG8_LAS __attribute__((address_space(3)))
typedef unsigned short bf16_t;
typedef short bf16x8 __attribute__((ext_vector_type(8)));
typedef float f32x4 __attribute__((ext_vector_type(4)));
typedef unsigned u32x4 __attribute__((ext_vector_type(4)));
constexpr int BM = 256, BK = 64, HALF = 128, HTB = HALF * BK * 2, STAGE_BYTES = 8 * HTB, NXCD = 8, WGM = 8;

__host__ __device__ __forceinline__ int lds_byte(int r, int c) { const int st = (r >> 4) * 2 + (c >> 5), rr = r & 15, cc = c & 31, ob = rr * 64 + cc * 2; return st * 1024 + (ob ^ (((ob >> 9) & 1) << 5)); }
__host__ __device__ __forceinline__ void stage_rc(int b, int& R, int& C) { const int st = b / 1024, sb = b % 1024, swz = sb ^ (((sb >> 9) & 1) << 5); R = (st >> 1) * 16 + swz / 64; C = (st & 1) * 32 + (swz % 64) / 2; }
__host__ __device__ __forceinline__ int perm32(int rho) { const int n = rho >> 4, i = rho & 15; return 8 * (i >> 2) + 4 * n + (i & 3); }

struct Unit { int pm, pn; };
struct Gemm { const bf16_t* A; const bf16_t* Bt; int M, N, K; };

struct StaticOrder {
    int nM, nN, nwg, G, c;
    __host__ __device__ void init(int M, int N, int G_, int c_) { nM = M / BM; nN = N / BM; nwg = nM * nN; G = G_; c = c_; }
    __host__ __device__ bool next(int i, Unit& u) const {
        const long L = (long)i * G + c; if (L >= nwg) return false;
        int wgid = (int)L; { const int q = nwg / NXCD, r = nwg % NXCD, xcd = wgid % NXCD, off = wgid / NXCD; wgid = (xcd < r ? xcd * (q + 1) : r * (q + 1) + (xcd - r) * q) + off; }
        const int nig = WGM * nN, gid = wgid / nig, fm = gid * WGM, gsz = (nM - fm) < WGM ? (nM - fm) : WGM;
        u.pm = fm + ((wgid % nig) % gsz); u.pn = (wgid % nig) / gsz; return true;
    }
    __device__ __forceinline__ void a_ready(const Unit&) const {}
    __device__ __forceinline__ void done(const Unit&) const {}
};

__device__ __forceinline__ unsigned cvt_pk_bf16(float lo, float hi) { unsigned r; asm volatile("v_cvt_pk_bf16_f32 %0, %1, %2" : "=v"(r) : "v"(lo), "v"(hi)); return r; }


struct EpiBf16R {
    static constexpr bool PERM = true, AFTER_DRAIN = false;
    bf16_t* O; int ldc; int split_cols; size_t split_stride;
    const float* cosT; const float* sinT; int rope_hi; int sc_lo, sc_hi; float sc;
    __device__ __forceinline__ void operator()(const f32x4 (&acc)[2][2][4][2], const Unit& u, int wr, int wc, int fr, int fq) const {
        const int row0 = u.pm * BM + wr * 64 + fr; int colt = u.pn * BM; bf16_t* base = O;
        if (split_cols) { const int t = colt / split_cols; base += (size_t)t * split_stride; colt -= t * split_cols; }
        const int col0 = colt + wc * 32 + 8 * fq;
        const bool rope = u.pn < rope_hi; const float s = (u.pn >= sc_lo && u.pn < sc_hi) ? sc : 1.f;
        const int ti = 16 * (wc & 1) + 4 * fq;
#pragma unroll
        for (int ai = 0; ai < 2; ++ai)
#pragma unroll
            for (int m = 0; m < 4; ++m) {
                const int r = row0 + ai * HALF + m * 16;
                f32x4 cs = (f32x4){1.f, 1.f, 1.f, 1.f}, sn = (f32x4){0.f, 0.f, 0.f, 0.f};
                if (rope) { const int ntok = r & 8191; const int pos = (wc >> 1) ? (ntok & 63) : (ntok >> 6); cs = *(const f32x4*)(cosT + pos * 32 + ti); sn = *(const f32x4*)(sinT + pos * 32 + ti); }
                bf16_t* rowp = base + (size_t)r * ldc + col0;
#pragma unroll
                for (int bj = 0; bj < 2; ++bj) {
                    const f32x4 v0 = acc[ai][bj][m][0], v1 = acc[ai][bj][m][1]; f32x4 o0, o1;
                    o0[0] = v0[0] * cs[0] - v0[1] * sn[0]; o0[1] = v0[0] * sn[0] + v0[1] * cs[0];
                    o0[2] = v0[2] * cs[1] - v0[3] * sn[1]; o0[3] = v0[2] * sn[1] + v0[3] * cs[1];
                    o1[0] = v1[0] * cs[2] - v1[1] * sn[2]; o1[1] = v1[0] * sn[2] + v1[1] * cs[2];
                    o1[2] = v1[2] * cs[3] - v1[3] * sn[3]; o1[3] = v1[2] * sn[3] + v1[3] * cs[3];
                    o0 = o0 * s; o1 = o1 * s;
                    u32x4 w; w.x = cvt_pk_bf16(o0[0], o0[1]); w.y = cvt_pk_bf16(o0[2], o0[3]); w.z = cvt_pk_bf16(o1[0], o1[1]); w.w = cvt_pk_bf16(o1[2], o1[3]);
                    *(u32x4*)(rowp + bj * HALF) = w; }
            }
    }
};
struct EpiRes {
    static constexpr bool PERM = false, AFTER_DRAIN = false;
    const float* base; float* out; int ldc; const float* gate; int gate_bstride;
    __device__ __forceinline__ void operator()(const f32x4 (&acc)[2][2][4][2], const Unit& u, int wr, int wc, int fr, int fq) const {
        const int row0 = u.pm * BM + wr * 64 + fr, col0 = u.pn * BM + wc * 32 + 4 * fq;
        const float* gp = gate + (size_t)((u.pm * BM) >> 13) * gate_bstride + col0;
        f32x4 gv[2][2];
#pragma unroll
        for (int bj = 0; bj < 2; ++bj)
#pragma unroll
            for (int n = 0; n < 2; ++n) gv[bj][n] = *(const f32x4*)(gp + bj * HALF + n * 16);
#pragma unroll
        for (int ai = 0; ai < 2; ++ai)
#pragma unroll
            for (int m = 0; m < 4; ++m) { const size_t off = (size_t)(row0 + ai * HALF + m * 16) * ldc + col0;
#pragma unroll
                for (int bj = 0; bj < 2; ++bj)
#pragma unroll
                    for (int n = 0; n < 2; ++n) { const f32x4 bs = *(const f32x4*)(base + off + bj * HALF + n * 16); *(f32x4*)(out + off + bj * HALF + n * 16) = bs + gv[bj][n] * acc[ai][bj][m][n]; }
                if (m & 1) asm volatile("" ::: "memory"); }
    }
};

template <class Epi, class Sched, bool ALIGN_EPI = false, bool SP2 = false>
__device__ __forceinline__ void gemm_phase(PG8_LAS unsigned char* lds, const Gemm g, const Sched& S, const Epi& E) {
    const int tid = threadIdx.x, wid = __builtin_amdgcn_readfirstlane(tid >> 6), lane = tid & 63, wr = wid >> 2, wc = wid & 3, fr = lane & 15, fq = lane >> 4;
    const int K = g.K, nt = K / BK;
    unsigned voffA[2], voffB[2];
#pragma unroll
    for (int i = 0; i < 2; ++i) { int R, C; stage_rc(tid * 16 + i * 8192, R, C); const int Rb = Epi::PERM ? ((R & ~31) + perm32(R & 31)) : R;
        voffA[i] = (unsigned)(R * K + C) * 2u; voffB[i] = (unsigned)(Rb * K + C) * 2u; }
    const size_t kstep = (size_t)(BK * 2);
    const size_t hstep = (size_t)HALF * K * 2;
    const size_t tstep = 2 * hstep;
    const unsigned ldsw = (unsigned)wid * 1024u;
    const int aoff = lds_byte(wr * 64 + fr, fq * 8), boff = lds_byte(wc * 32 + fr, fq * 8);
#define PG8_SA(b, h) (((b) * 2 + (h)) * HTB)
#define PG8_SB(b, h) ((4 + (b) * 2 + (h)) * HTB)
#define PG8_STAGE(bufoff, gbase, voff) do { _Pragma("unroll") for (int _i = 0; _i < 2; ++_i) \
        __builtin_amdgcn_global_load_lds((const unsigned*)((const char*)(gbase) + (voff)[_i]), (PG8_LAS unsigned*)(lds + (bufoff) + ldsw + _i * 8192), 16, 0, 0); } while (0)
#define PG8_LDA(dst, b, h) do { _Pragma("unroll") for (int m = 0; m < 4; ++m) _Pragma("unroll") for (int k = 0; k < 2; ++k) dst[m][k] = *(const PG8_LAS bf16x8*)(lds + PG8_SA(b, h) + aoff + m * 2048 + k * 1024); } while (0)
#define PG8_LDB(dst, b, h) do { _Pragma("unroll") for (int n = 0; n < 2; ++n) _Pragma("unroll") for (int k = 0; k < 2; ++k) dst[n][k] = *(const PG8_LAS bf16x8*)(lds + PG8_SB(b, h) + boff + n * 2048 + k * 1024); } while (0)
#define PG8_MMA(ai, bj, At, Bt) do { __builtin_amdgcn_s_setprio(1); _Pragma("unroll") for (int m = 0; m < 4; ++m) _Pragma("unroll") for (int n = 0; n < 2; ++n) _Pragma("unroll") for (int k = 0; k < 2; ++k) \
        acc[ai][bj][m][n] = __builtin_amdgcn_mfma_f32_16x16x32_bf16(Bt[n][k], At[m][k], acc[ai][bj][m][n], 0, 0, 0); __builtin_amdgcn_s_setprio(0); } while (0)
#define PG8_WAIT_V(n) asm volatile("s_waitcnt vmcnt(" #n ")" ::: "memory")
#define PG8_WAIT_L(n) asm volatile("s_waitcnt lgkmcnt(" #n ")" ::: "memory")
#define PG8_BAR __builtin_amdgcn_s_barrier()
#define PG8_SCHED __builtin_amdgcn_sched_barrier(0)
    Unit cur, nxt; int ui = 0;
    if (!S.next(0, cur)) return;
    f32x4 acc[2][2][4][2];
#pragma unroll
    for (int a = 0; a < 2; ++a)
#pragma unroll
        for (int b = 0; b < 2; ++b)
#pragma unroll
            for (int m = 0; m < 4; ++m)
#pragma unroll
                for (int n = 0; n < 2; ++n) acc[a][b][m][n] = (f32x4){0.f, 0.f, 0.f, 0.f};
    bf16x8 At[4][2], B0[2][2], B1[2][2];
    const char* cA = (const char*)g.A + (size_t)cur.pm * tstep; const char* cB = (const char*)g.Bt + (size_t)cur.pn * tstep;
    S.a_ready(cur);
    if constexpr (SP2) {
        PG8_STAGE(PG8_SB(0, 0), cB, voffB); PG8_STAGE(PG8_SB(0, 1), cB + hstep, voffB); PG8_STAGE(PG8_SA(0, 0), cA, voffA); PG8_STAGE(PG8_SA(0, 1), cA + hstep, voffA);
        if (wr == 1) PG8_BAR;
        PG8_WAIT_V(2); PG8_BAR;
        PG8_STAGE(PG8_SB(1, 0), cB + kstep, voffB); PG8_STAGE(PG8_SA(1, 0), cA + kstep, voffA); PG8_STAGE(PG8_SB(1, 1), cB + hstep + kstep, voffB);
        PG8_WAIT_V(6); PG8_BAR;
    } else {
        PG8_STAGE(PG8_SB(0, 0), cB, voffB); PG8_STAGE(PG8_SA(0, 0), cA, voffA); PG8_STAGE(PG8_SB(0, 1), cB + hstep, voffB); PG8_STAGE(PG8_SA(0, 1), cA + hstep, voffA);
        if (wr == 1) PG8_BAR;
        PG8_WAIT_V(4); PG8_BAR;
        PG8_STAGE(PG8_SB(1, 0), cB + kstep, voffB); PG8_STAGE(PG8_SA(1, 0), cA + kstep, voffA); PG8_STAGE(PG8_SB(1, 1), cB + hstep + kstep, voffB);
        PG8_WAIT_V(6); PG8_BAR;
    }
    for (;;) {
        const bool has_next = S.next(ui + 1, nxt);
        const char* nA = has_next ? (const char*)g.A + (size_t)nxt.pm * tstep : cA; const char* nB = has_next ? (const char*)g.Bt + (size_t)nxt.pn * tstep : cB;
        for (int t = 0; t < nt; t += 2) {
            const bool last = (t == nt - 2);
            const char* a1 = cA + (size_t)(t + 1) * kstep;
            const char* a2 = last ? nA : cA + (size_t)(t + 2) * kstep; const char* b2 = last ? nB : cB + (size_t)(t + 2) * kstep;
            const char* a3 = a2 + kstep; const char* b3 = b2 + kstep;
            if (last && has_next) S.a_ready(nxt);
            if constexpr (SP2) {
            PG8_LDB(B0, 0, 0); PG8_LDB(B1, 0, 1); PG8_SCHED; PG8_LDA(At, 0, 0); PG8_STAGE(PG8_SA(1, 1), a1 + hstep, voffA);
            PG8_WAIT_V(8); PG8_WAIT_L(0); PG8_BAR; PG8_MMA(0, 0, At, B0); PG8_MMA(0, 1, At, B1); PG8_BAR; PG8_SCHED;
            PG8_LDA(At, 0, 1); PG8_STAGE(PG8_SB(0, 0), b2, voffB); PG8_STAGE(PG8_SB(0, 1), b2 + hstep, voffB); PG8_STAGE(PG8_SA(0, 0), a2, voffA);
            PG8_WAIT_V(8); PG8_WAIT_L(0); PG8_BAR; PG8_MMA(1, 0, At, B0); PG8_MMA(1, 1, At, B1); PG8_BAR; PG8_SCHED;
            PG8_LDB(B0, 1, 0); PG8_LDB(B1, 1, 1); PG8_SCHED; PG8_LDA(At, 1, 0); PG8_STAGE(PG8_SA(0, 1), a2 + hstep, voffA);
            PG8_WAIT_V(8); PG8_WAIT_L(0); PG8_BAR; PG8_MMA(0, 0, At, B0); PG8_MMA(0, 1, At, B1); PG8_BAR; PG8_SCHED;
            PG8_LDA(At, 1, 1); PG8_STAGE(PG8_SB(1, 0), b3, voffB); PG8_STAGE(PG8_SB(1, 1), b3 + hstep, voffB); PG8_STAGE(PG8_SA(1, 0), a3, voffA);
            PG8_WAIT_V(8); PG8_WAIT_L(0); PG8_BAR; PG8_MMA(1, 0, At, B0); PG8_MMA(1, 1, At, B1); PG8_BAR; PG8_SCHED;
            } else {
            PG8_LDB(B0, 0, 0); PG8_SCHED; PG8_LDA(At, 0, 0); PG8_STAGE(PG8_SA(1, 1), a1 + hstep, voffA);
            PG8_WAIT_L(8); PG8_BAR; PG8_WAIT_L(0); PG8_MMA(0, 0, At, B0); PG8_BAR; PG8_SCHED;
            PG8_LDB(B1, 0, 1); PG8_STAGE(PG8_SB(0, 0), b2, voffB);
            PG8_BAR; PG8_WAIT_L(0); PG8_MMA(0, 1, At, B1); PG8_BAR;
            PG8_LDA(At, 0, 1); PG8_STAGE(PG8_SA(0, 0), a2, voffA);
            PG8_BAR; PG8_WAIT_L(0); PG8_MMA(1, 0, At, B0); PG8_BAR; PG8_SCHED;
            PG8_STAGE(PG8_SB(0, 1), b2 + hstep, voffB);
            PG8_WAIT_V(6); PG8_BAR; PG8_MMA(1, 1, At, B1); PG8_BAR;
            PG8_LDB(B0, 1, 0); PG8_SCHED; PG8_LDA(At, 1, 0); PG8_STAGE(PG8_SA(0, 1), a2 + hstep, voffA);
            PG8_WAIT_L(8); PG8_BAR; PG8_WAIT_L(0); PG8_MMA(0, 0, At, B0); PG8_BAR; PG8_SCHED;
            PG8_LDB(B1, 1, 1); PG8_STAGE(PG8_SB(1, 0), b3, voffB);
            PG8_BAR; PG8_WAIT_L(0); PG8_MMA(0, 1, At, B1); PG8_BAR;
            PG8_LDA(At, 1, 1); PG8_STAGE(PG8_SA(1, 0), a3, voffA);
            PG8_BAR; PG8_WAIT_L(0); PG8_MMA(1, 0, At, B0); PG8_BAR; PG8_SCHED;
            PG8_STAGE(PG8_SB(1, 1), b3 + hstep, voffB);
            PG8_WAIT_V(6); PG8_BAR; PG8_MMA(1, 1, At, B1); PG8_BAR;
            }
        }
        if constexpr (ALIGN_EPI) { if (wr == 0) PG8_BAR; }
        if constexpr (!Epi::AFTER_DRAIN) { E(acc, cur, wr, wc, fr, fq); S.done(cur); }
        if (!has_next) break;
#pragma unroll
        for (int a = 0; a < 2; ++a)
#pragma unroll
            for (int b = 0; b < 2; ++b)
#pragma unroll
                for (int m = 0; m < 4; ++m)
#pragma unroll
                    for (int n = 0; n < 2; ++n) acc[a][b][m][n] = (f32x4){0.f, 0.f, 0.f, 0.f};
        cur = nxt; cA = nA; cB = nB; ++ui;
        if constexpr (ALIGN_EPI) { if (wr == 1) PG8_BAR; }
    }
    PG8_WAIT_V(0);
    if constexpr (!ALIGN_EPI) { if (wr == 0) PG8_BAR; }
    PG8_BAR;
#undef PG8_SA
#undef PG8_SB
#undef PG8_STAGE
#undef PG8_LDA
#undef PG8_LDB
#undef PG8_MMA
#undef PG8_WAIT_V
#undef PG8_WAIT_L
#undef PG8_BAR
#undef PG8_SCHED
}
}

constexpr int NWAVES = 8, NTHR = 512;
constexpr int BATCH = 2, SEQ = 8192, D = 2048, M = BATCH * SEQ, CTXL = 256, MC = BATCH * CTXL;
constexpr int RW = 1024, NH = 8, DH = 128, CCH = 1024, INW = 7168, DFF = 5632, NUP = 2 * DFF, NCHK = 64, CHK = 128;
constexpr int NMOD = 6 * D;
constexpr float EPS = 1e-6f;
constexpr float KSCALE = 0.08838834764831845f;
constexpr int NSL = 8;

constexpr size_t MiB = 1u << 20;
constexpr size_t WS_CTL = 0, CTL_ZERO_BYTES = 1 * MiB;
constexpr size_t WS_COS = 1 * MiB, WS_SIN = WS_COS + 16384, WS_PW = WS_COS + 32768, WS_MODF = WS_COS + 65536, WS_MODP = WS_COS + 262144;
constexpr int PWS = 260;
constexpr size_t WS_WOUT = 4 * MiB, WS_WUP = 12 * MiB, WS_WDN = 56 * MiB, WS_XN = 78 * MiB, WS_HC = 142 * MiB, WS_KVC = 144 * MiB, WS_BIG = 146 * MiB;
constexpr size_t WS_P = WS_BIG, WS_CAT = WS_BIG + 224 * MiB, WS_WIN = WS_CAT  , WS_UA = WS_BIG, WS_UB = WS_BIG + 176 * MiB;
constexpr size_t WS_END = WS_BIG + 352 * MiB;
static_assert(WS_MODP + (size_t)NSL * 3 * NMOD * 4 <= WS_WOUT, "tables");
constexpr int CW_BAR = 4096;

constexpr int LDS_BYTES = 147456;
constexpr int MISC_OFF = LDS_BYTES - 256;

#define GAS __attribute__((address_space(1)))
#define LAS __attribute__((address_space(3)))
typedef unsigned short bf16;
typedef unsigned v4u __attribute__((ext_vector_type(4)));
typedef unsigned v2u __attribute__((ext_vector_type(2)));
typedef float f32x4 __attribute__((ext_vector_type(4)));
typedef GAS unsigned gu32;
#define LDS_WAIT() asm volatile("s_waitcnt lgkmcnt(0)" ::: "memory")
#define VM_WAIT() asm volatile("s_waitcnt vmcnt(0)" ::: "memory")
__device__ __forceinline__ unsigned f2bf(float f) { unsigned u = __builtin_bit_cast(unsigned, f); return (u + 0x7fffu + ((u >> 16) & 1u)) >> 16; }
__device__ __forceinline__ unsigned pk2(float lo, float hi) { return f2bf(lo) | (f2bf(hi) << 16); }
__device__ __forceinline__ float bflo(unsigned w) { return __builtin_bit_cast(float, w << 16); }
__device__ __forceinline__ float bfhi(unsigned w) { return __builtin_bit_cast(float, w & 0xffff0000u); }
__device__ __forceinline__ float bf1(bf16 h) { return __builtin_bit_cast(float, ((unsigned)h) << 16); }
__device__ __forceinline__ float silu_f(float x) { return x / (1.f + __expf(-x)); }
__device__ __forceinline__ float wave_sum(float v) {
#pragma unroll
    for (int o = 1; o < 64; o <<= 1) v += __shfl_xor(v, o);
    return v;
}

#define XB_TMO      128
#define XB_XCNT(j)  (256  + 64 * (j))
#define XB_XSUB(j)  (1280 + 64 * (j))
#define XB_XGEN(j)  (2304 + 64 * (j))
#define XB_TOP      3328
#define XB_TOPGEN   3392
#define XCD_BAR_WORDS 3456
#define XB_SPIN_CAP (1u << 18)
__device__ __forceinline__ unsigned xb_ld(unsigned* p)              { return __hip_atomic_load(p, __ATOMIC_RELAXED, __HIP_MEMORY_SCOPE_AGENT); }
__device__ __forceinline__ unsigned xb_add(unsigned* p, unsigned v) { return __hip_atomic_fetch_add(p, v, __ATOMIC_RELAXED, __HIP_MEMORY_SCOPE_AGENT); }
__device__ __forceinline__ unsigned xb_xcc_id() { return (unsigned)__builtin_amdgcn_s_getreg((3 << 11) | 20) & 0xFu; }
#define XB_SPIN(cond, bar) do { unsigned _sp = 0; while (cond) { __builtin_amdgcn_s_sleep(1); \
    if ((++_sp & 255u) == 0u) { if (xb_ld(&(bar)[XB_TMO])) break; if (_sp > XB_SPIN_CAP) { atomicAdd(&(bar)[XB_TMO], 1u); break; } } } } while (0)
struct XcdBarrier { unsigned* bar; unsigned x; volatile LAS unsigned* st; };
__device__ __forceinline__ XcdBarrier xcd_barrier_post(unsigned* bar, volatile LAS unsigned* st) {
    XcdBarrier b; b.bar = bar; b.x = xb_xcc_id(); b.st = st;
    if (threadIdx.x == 0) (void)xb_add(&bar[XB_XCNT(b.x)], 1u);
    return b;
}
__device__ __forceinline__ void xcd_barrier_complete(unsigned* bar, unsigned x, unsigned& nloc, unsigned& nx) {
    const unsigned G = gridDim.x * gridDim.y * gridDim.z;
    unsigned sum, cnt, mine, sp = 0u;
    for (;;) {
        sum = 0u; cnt = 0u; mine = 0u;
#pragma unroll
        for (unsigned j = 0; j < 16; ++j) { const unsigned c = xb_ld(&bar[XB_XCNT(j)]); sum += c; cnt += (c > 0u) ? 1u : 0u; mine = (j == x) ? c : mine; }
        if (sum == G) break;
        __builtin_amdgcn_s_sleep(1);
        if ((++sp & 255u) == 0u) { if (xb_ld(&bar[XB_TMO])) break; if (sp > XB_SPIN_CAP) { atomicAdd(&bar[XB_TMO], 1u); break; } }
    }
    nloc = mine > 0u ? mine : 1u; nx = cnt > 0u ? cnt : 1u;
}
__device__ __forceinline__ void xcd_barrier(const XcdBarrier& b) {
    asm volatile("s_waitcnt vmcnt(0)" ::: "memory");
    __syncthreads();
    if (threadIdx.x == 0) {
        unsigned* bar = b.bar;
        __builtin_amdgcn_s_waitcnt(0);
        unsigned nloc = b.st[0], nx = b.st[1];
        if (nloc == 0u) { xcd_barrier_complete(bar, b.x, nloc, nx); b.st[0] = nloc; b.st[1] = nx; }
        const unsigned old = xb_add(&bar[XB_XSUB(b.x)], 1u);
        const unsigned gen = old / nloc;
        if (old + 1u == (gen + 1u) * nloc) {
            __builtin_amdgcn_fence(__ATOMIC_RELEASE, "agent");
            asm volatile("s_waitcnt vmcnt(0)" ::: "memory");
            const unsigned og = xb_add(&bar[XB_TOP], 1u);
            const unsigned tg = og / nx;
            if (og + 1u == (tg + 1u) * nx) xb_add(&bar[XB_TOPGEN], 1u);
            else XB_SPIN(xb_ld(&bar[XB_TOPGEN]) == tg, bar);
            __builtin_amdgcn_fence(__ATOMIC_ACQUIRE, "agent");
            xb_add(&bar[XB_XGEN(b.x)], 1u);
            asm volatile("s_waitcnt vmcnt(0)" ::: "memory");
        } else {
            XB_SPIN(xb_ld(&bar[XB_XGEN(b.x)]) == gen, bar);
            __builtin_amdgcn_fence(__ATOMIC_ACQUIRE, "agent");
            asm volatile("s_waitcnt vmcnt(0)" ::: "memory");
        }
    }
    __syncthreads();
}

struct Args { const float* in[18]; float* out; unsigned char* ws; int ph_lo, ph_hi; };
enum { IN_X = 0, IN_C, IN_CTX, IN_CCTX, IN_WMOD, IN_BMOD, IN_G1, IN_WIN, IN_DECF, IN_DECB, IN_CONVW, IN_WOUT, IN_G2, IN_WUP, IN_FCW, IN_FCB, IN_WDN, IN_GF };
enum { PH_PRO = 0, PH_NORM1, PH_GEMM_IN, PH_KV, PH_SCAN, PH_RETOUT, PH_GEMM_OUT, PH_NORM2, PH_GEMM_UP, PH_GATE, PH_GEMM_DN, PH_FNORM, NPH };

template <bool PERMQK>
__device__ __forceinline__ void p0_transpose_item(const float* W, int K, int N, bf16* WT, LAS float* scr, int item, int lane) {
    const int nblk = N / 32, kb = item / nblk, nb = item % nblk, k0 = 64 * kb, n0 = 32 * nb;
#pragma unroll 8
    for (int i = 0; i < 32; ++i) { const int kk = 2 * i + (lane >> 5); scr[kk * 33 + (lane & 31)] = W[(size_t)(k0 + kk) * N + n0 + (lane & 31)]; }
    LDS_WAIT(); asm volatile("" ::: "memory");
    const int c = lane & 7;
#pragma unroll
    for (int j = 0; j < 4; ++j) { const int n = (lane >> 3) + 8 * j; const LAS float* s = scr + (8 * c) * 33 + n;
        v4u o; o.x = pk2(s[0 * 33], s[1 * 33]); o.y = pk2(s[2 * 33], s[3 * 33]); o.z = pk2(s[4 * 33], s[5 * 33]); o.w = pk2(s[6 * 33], s[7 * 33]);
        int ng = n0 + n;
        if (PERMQK) { if (ng < 2 * RW) ng = (ng & ~63) + 2 * (ng & 31) + ((ng >> 5) & 1); }
        *(GAS v4u*)(WT + (size_t)ng * K + k0 + 8 * c) = o; }
    LDS_WAIT(); asm volatile("" ::: "memory");
}

__device__ __forceinline__ void norm_row_bf16(const float* xrow, bf16* orow, const LAS float* mulT, const LAS float* addT, int lane) {
    const GAS f32x4* xr = (const GAS f32x4*)xrow + lane;
    f32x4 v[8]; float s = 0.f;
#pragma unroll
    for (int j = 0; j < 8; ++j) { v[j] = xr[64 * j]; s += (v[j].x * v[j].x + v[j].y * v[j].y) + (v[j].z * v[j].z + v[j].w * v[j].w); }
    const float rstd = rsqrtf(wave_sum(s) * (1.f / D) + EPS);
    GAS v2u* o8 = (GAS v2u*)orow + lane;
#pragma unroll
    for (int j = 0; j < 8; ++j) { const f32x4 mu = *(const LAS f32x4*)(mulT + 4 * (lane + 64 * j)), ad = *(const LAS f32x4*)(addT + 4 * (lane + 64 * j));
        const f32x4 y = v[j] * rstd * mu + ad; v2u w; w.x = pk2(y.x, y.y); w.y = pk2(y.z, y.w); o8[64 * j] = w; }
}

__global__ void __launch_bounds__(NTHR, 2) fwd_kernel(Args args) {
    extern __shared__ __attribute__((aligned(16))) unsigned char lds_raw[];
    LAS unsigned char* lds = (LAS unsigned char*)lds_raw;
    volatile LAS unsigned* MISC = (volatile LAS unsigned*)(lds + MISC_OFF);
    const int tid = threadIdx.x, lane = tid & 63, wave = __builtin_amdgcn_readfirstlane(tid >> 6);
    const int G = gridDim.x, bx = blockIdx.x;
    const int gw = bx * NWAVES + wave, NGW = G * NWAVES;
    const int gtid = bx * NTHR + tid, NGT = G * NTHR;
    unsigned char* ws = args.ws;
    const float* x = args.in[IN_X]; float* out = args.out;
    float* COS = (float*)(ws + WS_COS); float* SIN = (float*)(ws + WS_SIN); float* PW = (float*)(ws + WS_PW);
    float* MODF = (float*)(ws + WS_MODF); float* MODP = (float*)(ws + WS_MODP);
    bf16* WIN_T = (bf16*)(ws + WS_WIN); bf16* WOUT_T = (bf16*)(ws + WS_WOUT); bf16* WUP_T = (bf16*)(ws + WS_WUP); bf16* WDN_T = (bf16*)(ws + WS_WDN);
    bf16* XN = (bf16*)(ws + WS_XN); bf16* HC = (bf16*)(ws + WS_HC); bf16* KVC = (bf16*)(ws + WS_KVC);
    bf16* P = (bf16*)(ws + WS_P); bf16* CAT = (bf16*)(ws + WS_CAT); bf16* UA = (bf16*)(ws + WS_UA); bf16* UB = (bf16*)(ws + WS_UB);
    float* KVS = out;

    if (tid < 64) MISC[tid] = 0u;
    __syncthreads();
#if ONE_LAUNCH
    XcdBarrier bar = xcd_barrier_post((unsigned*)(ws + WS_CTL) + CW_BAR, MISC + 8);
#define GRID_BAR() xcd_barrier(bar)
#else
#define GRID_BAR() do {} while (0)
#endif
    const int lo = args.ph_lo, hi = args.ph_hi;
#ifndef PHMASK
#define PHMASK 0xFFF
#endif
#define IN(k) (((PHMASK >> (k)) & 1) && lo <= (k) && (k) < hi)
#define BOTH(k) (IN(k) && IN((k) + 1))

    if (IN(PH_PRO)) {
        LAS float* scr = (LAS float*)(lds + wave * 16384);
        constexpr int I_IN = (D / 64) * (INW / 32), I_OUT = (D / 64) * (D / 32), I_UP = (D / 64) * (NUP / 32), I_DN = (DFF / 64) * (D / 32), I_GV = NSL * (NMOD / 256);
        constexpr int NIT = I_IN + I_OUT + I_UP + I_DN + I_GV;
        for (int it = gw; it < NIT; it += NGW) {
            int r = it;
            if (r < I_IN) { p0_transpose_item<true>(args.in[IN_WIN], D, INW, WIN_T, scr, r, lane); continue; } r -= I_IN;
            if (r < I_OUT) { p0_transpose_item<false>(args.in[IN_WOUT], D, D, WOUT_T, scr, r, lane); continue; } r -= I_OUT;
            if (r < I_UP) { p0_transpose_item<false>(args.in[IN_WUP], D, NUP, WUP_T, scr, r, lane); continue; } r -= I_UP;
            if (r < I_DN) { p0_transpose_item<false>(args.in[IN_WDN], DFF, D, WDN_T, scr, r, lane); continue; } r -= I_DN;
            {
                const int s = r / (NMOD / 256), cgp = r % (NMOD / 256), col = cgp * 256 + lane * 4;
                f32x4 a0 = (f32x4){0.f, 0.f, 0.f, 0.f}, a1 = a0, a2 = a0;
                for (int kb = 0; kb < 4; ++kb) {
                    const int kbase = s * 256 + kb * 64;
                    const float c0 = silu_f(args.in[IN_C][kbase + lane]), c1 = silu_f(args.in[IN_C][D + kbase + lane]), c2 = silu_f(args.in[IN_CCTX][kbase + lane]);
                    const float* wp = args.in[IN_WMOD] + (size_t)kbase * NMOD + col;
#pragma unroll 8
                    for (int kk = 0; kk < 64; ++kk) {
                        const f32x4 w = *(const f32x4*)(wp + (size_t)kk * NMOD);
                        const float b0 = __shfl(c0, kk), b1 = __shfl(c1, kk), b2 = __shfl(c2, kk);
                        a0 += w * b0; a1 += w * b1; a2 += w * b2;
                    }
                }
                *(f32x4*)(MODP + ((size_t)(s * 3 + 0)) * NMOD + col) = a0;
                *(f32x4*)(MODP + ((size_t)(s * 3 + 1)) * NMOD + col) = a1;
                *(f32x4*)(MODP + ((size_t)(s * 3 + 2)) * NMOD + col) = a2;
            }
        }
        if (gtid < 4096) { const int pos = gtid >> 5, i = gtid & 31; const float fr = powf(10000.f, -(float)i / 32.f); const float ang = (float)pos * fr; COS[gtid] = cosf(ang); SIN[gtid] = sinf(ang); }
        else if (gtid < 4096 + 2 * NH * 257) { const int idx = gtid - 4096, dir = idx / (NH * 257), h = (idx / 257) % NH, k = idx % 257;
            const float lg0 = args.in[dir ? IN_DECB : IN_DECF][h]; const float lg = fminf(lg0, 0.f) - log1pf(expf(-fabsf(lg0)));
            PW[(dir * NH + h) * PWS + k] = expf(lg * (float)k); }
        if (BOTH(PH_PRO)) GRID_BAR();
    }

    if (IN(PH_NORM1)) {
        LAS float* mulT = (LAS float*)lds;
        LAS float* addT = (LAS float*)(lds + 3 * D * 4);
        for (int i = tid; i < 3 * D; i += NTHR) { const int r = i / D, k = i % D;
            float sh = args.in[IN_BMOD][k], sc = args.in[IN_BMOD][D + k];
#pragma unroll
            for (int s = 0; s < NSL; ++s) { sh += MODP[(size_t)(s * 3 + r) * NMOD + k]; sc += MODP[(size_t)(s * 3 + r) * NMOD + D + k]; }
            mulT[i] = args.in[IN_G1][k] * (1.f + sc); addT[i] = sh; }
        for (int i = gtid; i < 3 * NMOD; i += NGT) { const int r = i / NMOD, col = i % NMOD; float a = args.in[IN_BMOD][col];
#pragma unroll
            for (int s = 0; s < NSL; ++s) a += MODP[(size_t)(s * 3 + r) * NMOD + col];
            MODF[i] = a; }
        __syncthreads();
        for (int m = gw; m < M + MC; m += NGW) {
            if (m < M) { const int b = m >> 13; norm_row_bf16(x + (size_t)m * D, XN + (size_t)m * D, mulT + b * D, addT + b * D, lane); }
            else { const int mc = m - M; norm_row_bf16(args.in[IN_CTX] + (size_t)mc * D, HC + (size_t)mc * D, mulT + 2 * D, addT + 2 * D, lane); }
        }
        if (BOTH(PH_NORM1)) GRID_BAR();
    }

    if (IN(PH_GEMM_IN)) {
        __syncthreads();
        { pg8::Gemm g{XN, WIN_T, M, INW, D}; pg8::StaticOrder S; S.init(M, INW, G, bx);
          pg8::EpiBf16R E{P, INW, 0, 0, COS, SIN, 8, 4, 8, KSCALE};
          pg8::gemm_phase<pg8::EpiBf16R, pg8::StaticOrder, true, true>(lds, g, S, E); }
        { pg8::Gemm g{HC, WIN_T + (size_t)RW * D, MC, 2 * RW, D}; pg8::StaticOrder S; S.init(MC, 2 * RW, G, bx);
          pg8::EpiBf16R E{KVC, 2 * RW, 0, 0, COS, SIN, 0, 0, 4, KSCALE};
          pg8::gemm_phase<pg8::EpiBf16R, pg8::StaticOrder, true, true>(lds, g, S, E); }
        if (BOTH(PH_GEMM_IN)) GRID_BAR();
    }

    if (IN(PH_KV)) {
        __syncthreads();
        LAS float* Kf = (LAS float*)lds;
        LAS float* Vf = (LAS float*)(lds + 65536);
        for (int item = bx; item < BATCH * NH * NCHK; item += G) {
            const int b = item >> 9, h = (item >> 6) & 7, ch = item & 63;
            const size_t tok0 = (size_t)b * SEQ + (size_t)ch * CHK;
#pragma unroll
            for (int i = 0; i < 4; ++i) { const int p = tid + NTHR * i, row = p >> 4, c16 = p & 15;
                const v4u kq = *(const GAS v4u*)(P + (tok0 + row) * INW + RW + h * DH + c16 * 8);
                const v4u vq = *(const GAS v4u*)(P + (tok0 + row) * INW + 2 * RW + h * DH + c16 * 8);
                LAS f32x4* kd = (LAS f32x4*)(Kf + row * 128 + c16 * 8); LAS f32x4* vd = (LAS f32x4*)(Vf + row * 128 + c16 * 8);
                kd[0] = (f32x4){bflo(kq.x), bfhi(kq.x), bflo(kq.y), bfhi(kq.y)}; kd[1] = (f32x4){bflo(kq.z), bfhi(kq.z), bflo(kq.w), bfhi(kq.w)};
                vd[0] = (f32x4){bflo(vq.x), bfhi(vq.x), bflo(vq.y), bfhi(vq.y)}; vd[1] = (f32x4){bflo(vq.z), bfhi(vq.z), bflo(vq.w), bfhi(vq.w)}; }
            __syncthreads();
            const int dk0 = (tid >> 4) * 4, dv0 = (tid & 15) * 8;
            float af[4][8], ab[4][8];
#pragma unroll
            for (int a = 0; a < 4; ++a)
#pragma unroll
                for (int c = 0; c < 8; ++c) { af[a][c] = 0.f; ab[a][c] = 0.f; }
            const float* pwf = PW + (0 * NH + h) * PWS; const float* pwb = PW + (1 * NH + h) * PWS;
            for (int j = 0; j < CHK; ++j) {
                const float wf = pwf[127 - j], wb = pwb[j];
                const f32x4 k4 = *(const LAS f32x4*)(Kf + j * 128 + dk0);
                const f32x4 v0 = *(const LAS f32x4*)(Vf + j * 128 + dv0), v1 = *(const LAS f32x4*)(Vf + j * 128 + dv0 + 4);
#pragma unroll
                for (int a = 0; a < 4; ++a) { const float kf = k4[a] * wf, kb = k4[a] * wb;
#pragma unroll
                    for (int c = 0; c < 4; ++c) { af[a][c] += kf * v0[c]; af[a][c + 4] += kf * v1[c]; ab[a][c] += kb * v0[c]; ab[a][c + 4] += kb * v1[c]; } }
            }
            float* of = KVS + ((((size_t)(0 * BATCH + b) * NH + h) * NCHK + ch) * DH) * DH;
            float* ob = KVS + ((((size_t)(1 * BATCH + b) * NH + h) * NCHK + ch) * DH) * DH;
#pragma unroll
            for (int a = 0; a < 4; ++a) {
                *(f32x4*)(of + (size_t)(dk0 + a) * DH + dv0) = (f32x4){af[a][0], af[a][1], af[a][2], af[a][3]}; *(f32x4*)(of + (size_t)(dk0 + a) * DH + dv0 + 4) = (f32x4){af[a][4], af[a][5], af[a][6], af[a][7]};
                *(f32x4*)(ob + (size_t)(dk0 + a) * DH + dv0) = (f32x4){ab[a][0], ab[a][1], ab[a][2], ab[a][3]}; *(f32x4*)(ob + (size_t)(dk0 + a) * DH + dv0 + 4) = (f32x4){ab[a][4], ab[a][5], ab[a][6], ab[a][7]}; }
            __syncthreads();
        }
        for (int item = bx; item < M / 64; item += G) {
            const int c8 = tid & 127, tg = tid >> 7;
            const size_t n0 = (size_t)item * 64 + tg * 16;
            const float* cw = args.in[IN_CONVW];
            float w0[8], w1[8], w2[8];
#pragma unroll
            for (int e = 0; e < 8; ++e) { w0[e] = cw[c8 * 8 + e]; w1[e] = cw[CCH + c8 * 8 + e]; w2[e] = cw[2 * CCH + c8 * 8 + e]; }
            float pv[8], cv[8], nv[8];
            auto ldch = [&](size_t n, float* o) { const v4u cq = *(const GAS v4u*)(P + n * INW + 5 * RW + c8 * 8), hq = *(const GAS v4u*)(P + n * INW + 6 * RW + c8 * 8);
                o[0] = bflo(cq.x) * bflo(hq.x); o[1] = bfhi(cq.x) * bfhi(hq.x); o[2] = bflo(cq.y) * bflo(hq.y); o[3] = bfhi(cq.y) * bfhi(hq.y);
                o[4] = bflo(cq.z) * bflo(hq.z); o[5] = bfhi(cq.z) * bfhi(hq.z); o[6] = bflo(cq.w) * bflo(hq.w); o[7] = bfhi(cq.w) * bfhi(hq.w); };
            if (tg > 0) ldch(n0 - 1, pv); else {
#pragma unroll
                for (int e = 0; e < 8; ++e) pv[e] = 0.f; }
            ldch(n0, cv);
            for (int t = 0; t < 16; ++t) {
                const size_t n = n0 + t;
                if ((n & 63) != 63) ldch(n + 1, nv); else {
#pragma unroll
                    for (int e = 0; e < 8; ++e) nv[e] = 0.f; }
                const v4u bq = *(const GAS v4u*)(P + n * INW + 4 * RW + c8 * 8);
                float bb[8] = {bflo(bq.x), bfhi(bq.x), bflo(bq.y), bfhi(bq.y), bflo(bq.z), bfhi(bq.z), bflo(bq.w), bfhi(bq.w)};
                float o[8];
#pragma unroll
                for (int e = 0; e < 8; ++e) { o[e] = bb[e] * (w0[e] * pv[e] + w1[e] * cv[e] + w2[e] * nv[e]); pv[e] = cv[e]; cv[e] = nv[e]; }
                v4u w; w.x = pk2(o[0], o[1]); w.y = pk2(o[2], o[3]); w.z = pk2(o[4], o[5]); w.w = pk2(o[6], o[7]);
                *(GAS v4u*)(CAT + n * D + RW + c8 * 8) = w;
            }
        }
        if (BOTH(PH_KV)) GRID_BAR();
    }

    if (IN(PH_SCAN)) {
        for (int e4 = gtid; e4 < 2 * BATCH * NH * DH * DH / 4; e4 += NGT) {
            const int dv4 = e4 & 31, dk = (e4 >> 5) & 127, h = (e4 >> 12) & 7, b = (e4 >> 15) & 1, dir = e4 >> 16;
            const float* pw = PW + (dir * NH + h) * PWS;
            f32x4 s = (f32x4){0.f, 0.f, 0.f, 0.f};
            for (int t = 0; t < CTXL; ++t) {
                const float w = dir ? pw[t] : pw[CTXL - 1 - t];
                const bf16* row = KVC + (size_t)(b * CTXL + t) * (2 * RW);
                const float kk = bf1(row[h * DH + dk]) * w;
                const v2u vq = *(const GAS v2u*)(row + RW + h * DH + dv4 * 4);
                s += (f32x4){bflo(vq.x), bfhi(vq.x), bflo(vq.y), bfhi(vq.y)} * kk;
            }
            const float cd = pw[CHK];
            float* base = KVS + (((size_t)(dir * BATCH + b) * NH + h) * NCHK) * DH * DH + (size_t)dk * DH + dv4 * 4;
#pragma unroll 8
            for (int i = 0; i < NCHK; ++i) {
                const int n = dir ? (NCHK - 1 - i) : i;
                f32x4* p = (f32x4*)(base + (size_t)n * DH * DH);
                const f32x4 t = *p; *p = s; s = s * cd + t;
            }
        }
        if (BOTH(PH_SCAN)) GRID_BAR();
    }

    if (IN(PH_RETOUT)) {
        __syncthreads();
        constexpr int LS = 136;
        LAS bf16* Qs = (LAS bf16*)lds; LAS bf16* Ks = Qs + 128 * LS; LAS bf16* Vs = Ks + 128 * LS; LAS bf16* Ps = Vs + 128 * LS;
        LAS float* pwl = (LAS float*)(lds + 4 * 128 * LS * 2);
        for (int item = bx; item < BATCH * NH * NCHK; item += G) {
            const int b = item >> 9, h = (item >> 6) & 7, ch = item & 63;
            const size_t tok0 = (size_t)b * SEQ + (size_t)ch * CHK;
#pragma unroll
            for (int i = 0; i < 4; ++i) { const int p = tid + NTHR * i, row = p >> 4, c16 = p & 15;
                *(LAS v4u*)(Qs + row * LS + c16 * 8) = *(const GAS v4u*)(P + (tok0 + row) * INW + h * DH + c16 * 8);
                *(LAS v4u*)(Ks + row * LS + c16 * 8) = *(const GAS v4u*)(P + (tok0 + row) * INW + RW + h * DH + c16 * 8);
                *(LAS v4u*)(Vs + row * LS + c16 * 8) = *(const GAS v4u*)(P + (tok0 + row) * INW + 2 * RW + h * DH + c16 * 8); }
            if (tid < 2 * 129) { const int dir = tid / 129, k = tid % 129; pwl[dir * 132 + k] = PW[(dir * NH + h) * PWS + k]; }
            __syncthreads();
            const int ig = tid >> 4, jl = tid & 15;
#pragma unroll 1
            for (int half = 0; half < 2; ++half) {
                float sc[4][4];
#pragma unroll
                for (int a = 0; a < 4; ++a)
#pragma unroll
                    for (int c = 0; c < 4; ++c) sc[a][c] = 0.f;
#pragma unroll 1
                for (int d8 = 0; d8 < 16; ++d8) {
                    v4u q[4], k[4];
#pragma unroll
                    for (int a = 0; a < 4; ++a) q[a] = *(const LAS v4u*)(Qs + (4 * ig + a) * LS + d8 * 8);
#pragma unroll
                    for (int c = 0; c < 4; ++c) k[c] = *(const LAS v4u*)(Ks + (jl + 16 * (4 * half + c)) * LS + d8 * 8);
#pragma unroll
                    for (int a = 0; a < 4; ++a)
#pragma unroll
                        for (int c = 0; c < 4; ++c) {
                            sc[a][c] += bflo(q[a].x) * bflo(k[c].x) + bfhi(q[a].x) * bfhi(k[c].x) + bflo(q[a].y) * bflo(k[c].y) + bfhi(q[a].y) * bfhi(k[c].y)
                                      + bflo(q[a].z) * bflo(k[c].z) + bfhi(q[a].z) * bfhi(k[c].z) + bflo(q[a].w) * bflo(k[c].w) + bfhi(q[a].w) * bfhi(k[c].w); }
                }
#pragma unroll
                for (int a = 0; a < 4; ++a)
#pragma unroll
                    for (int c = 0; c < 4; ++c) { const int i = 4 * ig + a, j = jl + 16 * (4 * half + c);
                        const float dm = (j <= i) ? pwl[i - j] : pwl[132 + (j - i)];
                        Ps[i * LS + j] = (bf16)f2bf(sc[a][c] * dm); }
            }
            __syncthreads();
            {
                const int dv0 = 8 * jl;
                float o[4][8];
#pragma unroll
                for (int a = 0; a < 4; ++a)
#pragma unroll
                    for (int c = 0; c < 8; ++c) o[a][c] = 0.f;
#pragma unroll 1
                for (int j8 = 0; j8 < 16; ++j8) {
                    v4u p[4];
#pragma unroll
                    for (int a = 0; a < 4; ++a) p[a] = *(const LAS v4u*)(Ps + (4 * ig + a) * LS + j8 * 8);
#pragma unroll
                    for (int jj = 0; jj < 8; ++jj) {
                        const v4u vq = *(const LAS v4u*)(Vs + (j8 * 8 + jj) * LS + dv0);
                        const float vv[8] = {bflo(vq.x), bfhi(vq.x), bflo(vq.y), bfhi(vq.y), bflo(vq.z), bfhi(vq.z), bflo(vq.w), bfhi(vq.w)};
#pragma unroll
                        for (int a = 0; a < 4; ++a) { const unsigned pw_ = (jj >> 1) == 0 ? p[a].x : (jj >> 1) == 1 ? p[a].y : (jj >> 1) == 2 ? p[a].z : p[a].w;
                            const float pa = (jj & 1) ? bfhi(pw_) : bflo(pw_);
#pragma unroll
                            for (int c = 0; c < 8; ++c) o[a][c] += pa * vv[c]; }
                    }
                }
                const float* Sf = KVS + ((((size_t)(0 * BATCH + b) * NH + h) * NCHK + ch) * DH) * DH;
                const float* Sb = KVS + ((((size_t)(1 * BATCH + b) * NH + h) * NCHK + ch) * DH) * DH;
                float qdf[4], qdb[4];
#pragma unroll
                for (int a = 0; a < 4; ++a) { const int i = 4 * ig + a; qdf[a] = pwl[i + 1]; qdb[a] = pwl[132 + (CHK - i)]; }
#pragma unroll 1
                for (int kp = 0; kp < 64; ++kp) {
                    unsigned qw[4];
#pragma unroll
                    for (int a = 0; a < 4; ++a) qw[a] = *(const LAS unsigned*)(Qs + (4 * ig + a) * LS + kp * 2);
#pragma unroll
                    for (int kk = 0; kk < 2; ++kk) {
                        const int dk = kp * 2 + kk;
                        const f32x4 f0 = *(const f32x4*)(Sf + (size_t)dk * DH + dv0), f1 = *(const f32x4*)(Sf + (size_t)dk * DH + dv0 + 4);
                        const f32x4 b0 = *(const f32x4*)(Sb + (size_t)dk * DH + dv0), b1 = *(const f32x4*)(Sb + (size_t)dk * DH + dv0 + 4);
#pragma unroll
                        for (int a = 0; a < 4; ++a) { const float qa = kk ? bfhi(qw[a]) : bflo(qw[a]); const float qaf = qa * qdf[a], qab = qa * qdb[a];
#pragma unroll
                            for (int c = 0; c < 4; ++c) { o[a][c] += qaf * f0[c] + qab * b0[c]; o[a][c + 4] += qaf * f1[c] + qab * b1[c]; } }
                    }
                }
#pragma unroll
                for (int a = 0; a < 4; ++a) { const int i = 4 * ig + a;
                    float ss = 0.f;
#pragma unroll
                    for (int c = 0; c < 8; ++c) ss += o[a][c] * o[a][c];
                    ss += __shfl_xor(ss, 1); ss += __shfl_xor(ss, 2); ss += __shfl_xor(ss, 4); ss += __shfl_xor(ss, 8);
                    const float rstd = rsqrtf(ss * (1.f / DH) + EPS);
                    const v4u gq = *(const GAS v4u*)(P + (tok0 + i) * INW + 3 * RW + h * DH + dv0);
                    const float gg[8] = {bflo(gq.x), bfhi(gq.x), bflo(gq.y), bfhi(gq.y), bflo(gq.z), bfhi(gq.z), bflo(gq.w), bfhi(gq.w)};
                    float r[8];
#pragma unroll
                    for (int c = 0; c < 8; ++c) r[c] = o[a][c] * rstd * silu_f(gg[c]);
                    v4u w; w.x = pk2(r[0], r[1]); w.y = pk2(r[2], r[3]); w.z = pk2(r[4], r[5]); w.w = pk2(r[6], r[7]);
                    *(GAS v4u*)(CAT + (tok0 + i) * D + h * DH + dv0) = w; }
            }
            __syncthreads();
        }
        if (BOTH(PH_RETOUT)) GRID_BAR();
    }

    if (IN(PH_GEMM_OUT)) {
        __syncthreads();
        pg8::Gemm g{CAT, WOUT_T, M, D, D}; pg8::StaticOrder S; S.init(M, D, G, bx);
        pg8::EpiRes E{x, out, D, MODF + 2 * D, NMOD};
        pg8::gemm_phase<pg8::EpiRes, pg8::StaticOrder, true, true>(lds, g, S, E);
        if (BOTH(PH_GEMM_OUT)) GRID_BAR();
    }

    if (IN(PH_NORM2)) {
        __syncthreads();
        LAS float* mulT = (LAS float*)lds; LAS float* addT = (LAS float*)(lds + 2 * D * 4);
        for (int i = tid; i < 2 * D; i += NTHR) { const int r = i / D, k = i % D;
            mulT[i] = args.in[IN_G2][k] * (1.f + MODF[(size_t)r * NMOD + 4 * D + k]); addT[i] = MODF[(size_t)r * NMOD + 3 * D + k]; }
        __syncthreads();
        for (int m = gw; m < M; m += NGW) { const int b = m >> 13; norm_row_bf16(out + (size_t)m * D, XN + (size_t)m * D, mulT + b * D, addT + b * D, lane); }
        if (BOTH(PH_NORM2)) GRID_BAR();
    }

    if (IN(PH_GEMM_UP)) {
        __syncthreads();
        pg8::Gemm g{XN, WUP_T, M, NUP, D}; pg8::StaticOrder S; S.init(M, NUP, G, bx);
        pg8::EpiBf16R E{UA, DFF, DFF, (size_t)(WS_UB - WS_UA) / 2, COS, SIN, 0, 0, 0, 1.f};
        pg8::gemm_phase<pg8::EpiBf16R, pg8::StaticOrder, true, true>(lds, g, S, E);
        if (BOTH(PH_GEMM_UP)) GRID_BAR();
    }

    if (IN(PH_GATE)) {
        const float* fw = args.in[IN_FCW]; const float* fb = args.in[IN_FCB];
        for (int idx = gtid; idx < M * (DFF / 8); idx += NGT) {
            const int n = idx / (DFF / 8), c8 = idx % (DFF / 8), grow = (n & (SEQ - 1)) >> 6;
            const size_t off = (size_t)n * DFF + c8 * 8;
            const v4u z = (v4u){0u, 0u, 0u, 0u};
            const v4u a0 = grow > 0 ? *(const GAS v4u*)(UA + off - (size_t)64 * DFF) : z;
            const v4u a1 = *(const GAS v4u*)(UA + off);
            const v4u a2 = grow < 127 ? *(const GAS v4u*)(UA + off + (size_t)64 * DFF) : z;
            const v4u bq = *(const GAS v4u*)(UB + off);
            const float A0[8] = {bflo(a0.x), bfhi(a0.x), bflo(a0.y), bfhi(a0.y), bflo(a0.z), bfhi(a0.z), bflo(a0.w), bfhi(a0.w)};
            const float A1[8] = {bflo(a1.x), bfhi(a1.x), bflo(a1.y), bfhi(a1.y), bflo(a1.z), bfhi(a1.z), bflo(a1.w), bfhi(a1.w)};
            const float A2[8] = {bflo(a2.x), bfhi(a2.x), bflo(a2.y), bfhi(a2.y), bflo(a2.z), bfhi(a2.z), bflo(a2.w), bfhi(a2.w)};
            const float BB[8] = {bflo(bq.x), bfhi(bq.x), bflo(bq.y), bfhi(bq.y), bflo(bq.z), bfhi(bq.z), bflo(bq.w), bfhi(bq.w)};
            float o[8];
#pragma unroll
            for (int e = 0; e < 8; ++e) { const int c = c8 * 8 + e; const float av = fw[c] * A0[e] + fw[DFF + c] * A1[e] + fw[2 * DFF + c] * A2[e] + fb[c]; o[e] = silu_f(av) * BB[e]; }
            v4u w; w.x = pk2(o[0], o[1]); w.y = pk2(o[2], o[3]); w.z = pk2(o[4], o[5]); w.w = pk2(o[6], o[7]);
            *(GAS v4u*)(UB + off) = w;
        }
        if (BOTH(PH_GATE)) GRID_BAR();
    }

    if (IN(PH_GEMM_DN)) {
        __syncthreads();
        pg8::Gemm g{UB, WDN_T, M, D, DFF}; pg8::StaticOrder S; S.init(M, D, G, bx);
        pg8::EpiRes E{out, out, D, MODF + 5 * D, NMOD};
        pg8::gemm_phase<pg8::EpiRes, pg8::StaticOrder, true, true>(lds, g, S, E);
        if (BOTH(PH_GEMM_DN)) GRID_BAR();
    }

    if (IN(PH_FNORM)) {
        const float* gfin = args.in[IN_GF];
        for (int m = gw; m < M; m += NGW) {
            GAS f32x4* xr = (GAS f32x4*)(out + (size_t)m * D) + lane;
            f32x4 v[8]; float s = 0.f;
#pragma unroll
            for (int j = 0; j < 8; ++j) { v[j] = xr[64 * j]; s += (v[j].x * v[j].x + v[j].y * v[j].y) + (v[j].z * v[j].z + v[j].w * v[j].w); }
            const float rstd = rsqrtf(wave_sum(s) * (1.f / D) + EPS);
#pragma unroll
            for (int j = 0; j < 8; ++j) { const f32x4 gg = *(const f32x4*)(gfin + 4 * (lane + 64 * j)); xr[64 * j] = v[j] * rstd * gg; }
        }
    }
#undef IN
#undef BOTH
}

extern "C" void kernel_launch(void* const* d_in, const int* in_sizes, int n_in, void* d_out, int out_size, void* d_ws, size_t ws_size, hipStream_t stream) {
    static int grid = 0;
    if (grid == 0) {
        if (n_in != 18 || in_sizes[0] != M * D || out_size != M * D || ws_size < WS_END) { fprintf(stderr, "kernel_launch: unexpected shapes/workspace (n_in %d, in0 %d, out %d, ws %zu, need %zu); nothing launched\n", n_in, n_in > 0 ? in_sizes[0] : -1, out_size, ws_size, (size_t)WS_END); grid = -1; return; }
        int dev = 0, cus = 0, per_cu = 0;
        if (hipGetDevice(&dev) != hipSuccess || hipDeviceGetAttribute(&cus, hipDeviceAttributeMultiprocessorCount, dev) != hipSuccess) { grid = -1; return; }
        if (hipFuncSetAttribute((const void*)fwd_kernel, hipFuncAttributeMaxDynamicSharedMemorySize, LDS_BYTES) != hipSuccess) { fprintf(stderr, "kernel_launch: hipFuncSetAttribute failed\n"); grid = -1; return; }
        if (hipOccupancyMaxActiveBlocksPerMultiprocessor(&per_cu, (const void*)fwd_kernel, NTHR, LDS_BYTES) != hipSuccess || per_cu < 1) { fprintf(stderr, "kernel_launch: occupancy query says %d\n", per_cu); per_cu = 1; }
        (void)hipGetLastError();
        grid = cus * (per_cu < 1 ? 1 : 1);
    }
    if (grid < 0) return;
    (void)hipMemsetAsync((char*)d_ws + WS_CTL, 0, CTL_ZERO_BYTES, stream);
    Args a{};
    for (int i = 0; i < 18; ++i) a.in[i] = (const float*)d_in[i];
    a.out = (float*)d_out; a.ws = (unsigned char*)d_ws;
#if ONE_LAUNCH
    a.ph_lo = 0; a.ph_hi = NPH;
    void* kargs[] = {&a};
    hipError_t e = hipLaunchCooperativeKernel((const void*)fwd_kernel, dim3(grid), dim3(NTHR), kargs, LDS_BYTES, stream);
    if (e != hipSuccess) fprintf(stderr, "kernel_launch: cooperative launch failed: %s (grid %d)\n", hipGetErrorString(e), grid);
#else
    for (int p = 0; p < NPH; ++p) { a.ph_lo = p; a.ph_hi = p + 1; hipLaunchKernelGGL(fwd_kernel, dim3(grid), dim3(NTHR), LDS_BYTES, stream, a); }
#endif
}
```

```cpp
#include <hip/hip_runtime.h>
#include <cstdio>
#include <cstdint>

#ifndef ONE_LAUNCH
#define ONE_LAUNCH 1
#endif

namespace pg8 {
#define PG8_LAS __attribute__((address_space(3)))
typedef unsigned short bf16_t;
typedef short bf16x8 __attribute__((ext_vector_type(8)));
typedef float f32x4 __attribute__((ext_vector_type(4)));
typedef unsigned u32x4 __attribute__((ext_vector_type(4)));
constexpr int BM = 256, BK = 64, HALF = 128, HTB = HALF * BK * 2, STAGE_BYTES = 8 * HTB, NXCD = 8, WGM = 8;

__host__ __device__ __forceinline__ int lds_byte(int r, int c) { const int st = (r >> 4) * 2 + (c >> 5), rr = r & 15, cc = c & 31, ob = rr * 64 + cc * 2; return st * 1024 + (ob ^ (((ob >> 9) & 1) << 5)); }
__host__ __device__ __forceinline__ void stage_rc(int b, int& R, int& C) { const int st = b / 1024, sb = b % 1024, swz = sb ^ (((sb >> 9) & 1) << 5); R = (st >> 1) * 16 + swz / 64; C = (st & 1) * 32 + (swz % 64) / 2; }
__host__ __device__ __forceinline__ int perm32(int rho) { const int n = rho >> 4, i = rho & 15; return 8 * (i >> 2) + 4 * n + (i & 3); }

struct Unit { int pm, pn; };
struct Gemm { const bf16_t* A; const bf16_t* Bt; int M, N, K; };

struct StaticOrder {
    int nM, nN, nwg, G, c;
    __host__ __device__ void init(int M, int N, int G_, int c_) { nM = M / BM; nN = N / BM; nwg = nM * nN; G = G_; c = c_; }
    __host__ __device__ bool next(int i, Unit& u) const {
        const long L = (long)i * G + c; if (L >= nwg) return false;
        int wgid = (int)L; { const int q = nwg / NXCD, r = nwg % NXCD, xcd = wgid % NXCD, off = wgid / NXCD; wgid = (xcd < r ? xcd * (q + 1) : r * (q + 1) + (xcd - r) * q) + off; }
        const int nig = WGM * nN, gid = wgid / nig, fm = gid * WGM, gsz = (nM - fm) < WGM ? (nM - fm) : WGM;
        u.pm = fm + ((wgid % nig) % gsz); u.pn = (wgid % nig) / gsz; return true;
    }
    __device__ __forceinline__ void a_ready(const Unit&) const {}
    __device__ __forceinline__ void done(const Unit&) const {}
};

__device__ __forceinline__ unsigned cvt_pk_bf16(float lo, float hi) { unsigned r; asm volatile("v_cvt_pk_bf16_f32 %0, %1, %2" : "=v"(r) : "v"(lo), "v"(hi)); return r; }


struct EpiBf16R {
    static constexpr bool PERM = true, AFTER_DRAIN = false;
    bf16_t* O; int ldc; int split_cols; size_t split_stride;
    const float* cosT; const float* sinT; int rope_hi; int sc_lo, sc_hi; float sc;
    __device__ __forceinline__ void operator()(const f32x4 (&acc)[2][2][4][2], const Unit& u, int wr, int wc, int fr, int fq) const {
        const int row0 = u.pm * BM + wr * 64 + fr; int colt = u.pn * BM; bf16_t* base = O;
        if (split_cols) { const int t = colt / split_cols; base += (size_t)t * split_stride; colt -= t * split_cols; }
        const int col0 = colt + wc * 32 + 8 * fq;
        const bool rope = u.pn < rope_hi; const float s = (u.pn >= sc_lo && u.pn < sc_hi) ? sc : 1.f;
        const int ti = 16 * (wc & 1) + 4 * fq;
#pragma unroll
        for (int ai = 0; ai < 2; ++ai)
#pragma unroll
            for (int m = 0; m < 4; ++m) {
                const int r = row0 + ai * HALF + m * 16;
                f32x4 cs = (f32x4){1.f, 1.f, 1.f, 1.f}, sn = (f32x4){0.f, 0.f, 0.f, 0.f};
                if (rope) { const int ntok = r & 8191; const int pos = (wc >> 1) ? (ntok & 63) : (ntok >> 6); cs = *(const f32x4*)(cosT + pos * 32 + ti); sn = *(const f32x4*)(sinT + pos * 32 + ti); }
                bf16_t* rowp = base + (size_t)r * ldc + col0;
#pragma unroll
                for (int bj = 0; bj < 2; ++bj) {
                    const f32x4 v0 = acc[ai][bj][m][0], v1 = acc[ai][bj][m][1]; f32x4 o0, o1;
                    o0[0] = v0[0] * cs[0] - v0[1] * sn[0]; o0[1] = v0[0] * sn[0] + v0[1] * cs[0];
                    o0[2] = v0[2] * cs[1] - v0[3] * sn[1]; o0[3] = v0[2] * sn[1] + v0[3] * cs[1];
                    o1[0] = v1[0] * cs[2] - v1[1] * sn[2]; o1[1] = v1[0] * sn[2] + v1[1] * cs[2];
                    o1[2] = v1[2] * cs[3] - v1[3] * sn[3]; o1[3] = v1[2] * sn[3] + v1[3] * cs[3];
                    o0 = o0 * s; o1 = o1 * s;
                    u32x4 w; w.x = cvt_pk_bf16(o0[0], o0[1]); w.y = cvt_pk_bf16(o0[2], o0[3]); w.z = cvt_pk_bf16(o1[0], o1[1]); w.w = cvt_pk_bf16(o1[2], o1[3]);
                    *(u32x4*)(rowp + bj * HALF) = w; }
            }
    }
};
struct EpiRes {
    static constexpr bool PERM = false, AFTER_DRAIN = false;
    const float* base; float* out; int ldc; const float* gate; int gate_bstride;
    __device__ __forceinline__ void operator()(const f32x4 (&acc)[2][2][4][2], const Unit& u, int wr, int wc, int fr, int fq) const {
        const int row0 = u.pm * BM + wr * 64 + fr, col0 = u.pn * BM + wc * 32 + 4 * fq;
        const float* gp = gate + (size_t)((u.pm * BM) >> 13) * gate_bstride + col0;
        f32x4 gv[2][2];
#pragma unroll
        for (int bj = 0; bj < 2; ++bj)
#pragma unroll
            for (int n = 0; n < 2; ++n) gv[bj][n] = *(const f32x4*)(gp + bj * HALF + n * 16);
#pragma unroll
        for (int ai = 0; ai < 2; ++ai)
#pragma unroll
            for (int m = 0; m < 4; ++m) { const size_t off = (size_t)(row0 + ai * HALF + m * 16) * ldc + col0;
#pragma unroll
                for (int bj = 0; bj < 2; ++bj)
#pragma unroll
                    for (int n = 0; n < 2; ++n) { const f32x4 bs = *(const f32x4*)(base + off + bj * HALF + n * 16); *(f32x4*)(out + off + bj * HALF + n * 16) = bs + gv[bj][n] * acc[ai][bj][m][n]; }
                if (m & 1) asm volatile("" ::: "memory"); }
    }
};

template <class Epi, class Sched, bool ALIGN_EPI = false, bool SP2 = false>
__device__ __forceinline__ void gemm_phase(PG8_LAS unsigned char* lds, const Gemm g, const Sched& S, const Epi& E) {
    const int tid = threadIdx.x, wid = __builtin_amdgcn_readfirstlane(tid >> 6), lane = tid & 63, wr = wid >> 2, wc = wid & 3, fr = lane & 15, fq = lane >> 4;
    const int K = g.K, nt = K / BK;
    unsigned voffA[2], voffB[2];
#pragma unroll
    for (int i = 0; i < 2; ++i) { int R, C; stage_rc(tid * 16 + i * 8192, R, C); const int Rb = Epi::PERM ? ((R & ~31) + perm32(R & 31)) : R;
        voffA[i] = (unsigned)(R * K + C) * 2u; voffB[i] = (unsigned)(Rb * K + C) * 2u; }
    const size_t kstep = (size_t)(BK * 2);
    const size_t hstep = (size_t)HALF * K * 2;
    const size_t tstep = 2 * hstep;
    const unsigned ldsw = (unsigned)wid * 1024u;
    const int aoff = lds_byte(wr * 64 + fr, fq * 8), boff = lds_byte(wc * 32 + fr, fq * 8);
#define PG8_SA(b, h) (((b) * 2 + (h)) * HTB)
#define PG8_SB(b, h) ((4 + (b) * 2 + (h)) * HTB)
#define PG8_STAGE(bufoff, gbase, voff) do { _Pragma("unroll") for (int _i = 0; _i < 2; ++_i) \
        __builtin_amdgcn_global_load_lds((const unsigned*)((const char*)(gbase) + (voff)[_i]), (PG8_LAS unsigned*)(lds + (bufoff) + ldsw + _i * 8192), 16, 0, 0); } while (0)
#define PG8_LDA(dst, b, h) do { _Pragma("unroll") for (int m = 0; m < 4; ++m) _Pragma("unroll") for (int k = 0; k < 2; ++k) dst[m][k] = *(const PG8_LAS bf16x8*)(lds + PG8_SA(b, h) + aoff + m * 2048 + k * 1024); } while (0)
#define PG8_LDB(dst, b, h) do { _Pragma("unroll") for (int n = 0; n < 2; ++n) _Pragma("unroll") for (int k = 0; k < 2; ++k) dst[n][k] = *(const PG8_LAS bf16x8*)(lds + PG8_SB(b, h) + boff + n * 2048 + k * 1024); } while (0)
#define PG8_MMA(ai, bj, At, Bt) do { __builtin_amdgcn_s_setprio(1); _Pragma("unroll") for (int m = 0; m < 4; ++m) _Pragma("unroll") for (int n = 0; n < 2; ++n) _Pragma("unroll") for (int k = 0; k < 2; ++k) \
        acc[ai][bj][m][n] = __builtin_amdgcn_mfma_f32_16x16x32_bf16(Bt[n][k], At[m][k], acc[ai][bj][m][n], 0, 0, 0); __builtin_amdgcn_s_setprio(0); } while (0)
#define PG8_WAIT_V(n) asm volatile("s_waitcnt vmcnt(" #n ")" ::: "memory")
#define PG8_WAIT_L(n) asm volatile("s_waitcnt lgkmcnt(" #n ")" ::: "memory")
#define PG8_BAR __builtin_amdgcn_s_barrier()
#define PG8_SCHED __builtin_amdgcn_sched_barrier(0)
    Unit cur, nxt; int ui = 0;
    if (!S.next(0, cur)) return;
    f32x4 acc[2][2][4][2];
#pragma unroll
    for (int a = 0; a < 2; ++a)
#pragma unroll
        for (int b = 0; b < 2; ++b)
#pragma unroll
            for (int m = 0; m < 4; ++m)
#pragma unroll
                for (int n = 0; n < 2; ++n) acc[a][b][m][n] = (f32x4){0.f, 0.f, 0.f, 0.f};
    bf16x8 At[4][2], B0[2][2], B1[2][2];
    const char* cA = (const char*)g.A + (size_t)cur.pm * tstep; const char* cB = (const char*)g.Bt + (size_t)cur.pn * tstep;
    S.a_ready(cur);
    if constexpr (SP2) {
        PG8_STAGE(PG8_SB(0, 0), cB, voffB); PG8_STAGE(PG8_SB(0, 1), cB + hstep, voffB); PG8_STAGE(PG8_SA(0, 0), cA, voffA); PG8_STAGE(PG8_SA(0, 1), cA + hstep, voffA);
        if (wr == 1) PG8_BAR;
        PG8_WAIT_V(2); PG8_BAR;
        PG8_STAGE(PG8_SB(1, 0), cB + kstep, voffB); PG8_STAGE(PG8_SA(1, 0), cA + kstep, voffA); PG8_STAGE(PG8_SB(1, 1), cB + hstep + kstep, voffB);
        PG8_WAIT_V(6); PG8_BAR;
    } else {
        PG8_STAGE(PG8_SB(0, 0), cB, voffB); PG8_STAGE(PG8_SA(0, 0), cA, voffA); PG8_STAGE(PG8_SB(0, 1), cB + hstep, voffB); PG8_STAGE(PG8_SA(0, 1), cA + hstep, voffA);
        if (wr == 1) PG8_BAR;
        PG8_WAIT_V(4); PG8_BAR;
        PG8_STAGE(PG8_SB(1, 0), cB + kstep, voffB); PG8_STAGE(PG8_SA(1, 0), cA + kstep, voffA); PG8_STAGE(PG8_SB(1, 1), cB + hstep + kstep, voffB);
        PG8_WAIT_V(6); PG8_BAR;
    }
    for (;;) {
        const bool has_next = S.next(ui + 1, nxt);
        const char* nA = has_next ? (const char*)g.A + (size_t)nxt.pm * tstep : cA; const char* nB = has_next ? (const char*)g.Bt + (size_t)nxt.pn * tstep : cB;
        for (int t = 0; t < nt; t += 2) {
            const bool last = (t == nt - 2);
            const char* a1 = cA + (size_t)(t + 1) * kstep;
            const char* a2 = last ? nA : cA + (size_t)(t + 2) * kstep; const char* b2 = last ? nB : cB + (size_t)(t + 2) * kstep;
            const char* a3 = a2 + kstep; const char* b3 = b2 + kstep;
            if (last && has_next) S.a_ready(nxt);
            if constexpr (SP2) {
            PG8_LDB(B0, 0, 0); PG8_LDB(B1, 0, 1); PG8_SCHED; PG8_LDA(At, 0, 0); PG8_STAGE(PG8_SA(1, 1), a1 + hstep, voffA);
            PG8_WAIT_V(8); PG8_WAIT_L(0); PG8_BAR; PG8_MMA(0, 0, At, B0); PG8_MMA(0, 1, At, B1); PG8_BAR; PG8_SCHED;
            PG8_LDA(At, 0, 1); PG8_STAGE(PG8_SB(0, 0), b2, voffB); PG8_STAGE(PG8_SB(0, 1), b2 + hstep, voffB); PG8_STAGE(PG8_SA(0, 0), a2, voffA);
            PG8_WAIT_V(8); PG8_WAIT_L(0); PG8_BAR; PG8_MMA(1, 0, At, B0); PG8_MMA(1, 1, At, B1); PG8_BAR; PG8_SCHED;
            PG8_LDB(B0, 1, 0); PG8_LDB(B1, 1, 1); PG8_SCHED; PG8_LDA(At, 1, 0); PG8_STAGE(PG8_SA(0, 1), a2 + hstep, voffA);
            PG8_WAIT_V(8); PG8_WAIT_L(0); PG8_BAR; PG8_MMA(0, 0, At, B0); PG8_MMA(0, 1, At, B1); PG8_BAR; PG8_SCHED;
            PG8_LDA(At, 1, 1); PG8_STAGE(PG8_SB(1, 0), b3, voffB); PG8_STAGE(PG8_SB(1, 1), b3 + hstep, voffB); PG8_STAGE(PG8_SA(1, 0), a3, voffA);
            PG8_WAIT_V(8); PG8_WAIT_L(0); PG8_BAR; PG8_MMA(1, 0, At, B0); PG8_MMA(1, 1, At, B1); PG8_BAR; PG8_SCHED;
            } else {
            PG8_LDB(B0, 0, 0); PG8_SCHED; PG8_LDA(At, 0, 0); PG8_STAGE(PG8_SA(1, 1), a1 + hstep, voffA);
            PG8_WAIT_L(8); PG8_BAR; PG8_WAIT_L(0); PG8_MMA(0, 0, At, B0); PG8_BAR; PG8_SCHED;
            PG8_LDB(B1, 0, 1); PG8_STAGE(PG8_SB(0, 0), b2, voffB);
            PG8_BAR; PG8_WAIT_L(0); PG8_MMA(0, 1, At, B1); PG8_BAR;
            PG8_LDA(At, 0, 1); PG8_STAGE(PG8_SA(0, 0), a2, voffA);
            PG8_BAR; PG8_WAIT_L(0); PG8_MMA(1, 0, At, B0); PG8_BAR; PG8_SCHED;
            PG8_STAGE(PG8_SB(0, 1), b2 + hstep, voffB);
            PG8_WAIT_V(6); PG8_BAR; PG8_MMA(1, 1, At, B1); PG8_BAR;
            PG8_LDB(B0, 1, 0); PG8_SCHED; PG8_LDA(At, 1, 0); PG8_STAGE(PG8_SA(0, 1), a2 + hstep, voffA);
            PG8_WAIT_L(8); PG8_BAR; PG8_WAIT_L(0); PG8_MMA(0, 0, At, B0); PG8_BAR; PG8_SCHED;
            PG8_LDB(B1, 1, 1); PG8_STAGE(PG8_SB(1, 0), b3, voffB);
            PG8_BAR; PG8_WAIT_L(0); PG8_MMA(0, 1, At, B1); PG8_BAR;
            PG8_LDA(At, 1, 1); PG8_STAGE(PG8_SA(1, 0), a3, voffA);
            PG8_BAR; PG8_WAIT_L(0); PG8_MMA(1, 0, At, B0); PG8_BAR; PG8_SCHED;
            PG8_STAGE(PG8_SB(1, 1), b3 + hstep, voffB);
            PG8_WAIT_V(6); PG8_BAR; PG8_MMA(1, 1, At, B1); PG8_BAR;
            }
        }
        if constexpr (ALIGN_EPI) { if (wr == 0) PG8_BAR; }
        if constexpr (!Epi::AFTER_DRAIN) { E(acc, cur, wr, wc, fr, fq); S.done(cur); }
        if (!has_next) break;
#pragma unroll
        for (int a = 0; a < 2; ++a)
#pragma unroll
            for (int b = 0; b < 2; ++b)
#pragma unroll
                for (int m = 0; m < 4; ++m)
#pragma unroll
                    for (int n = 0; n < 2; ++n) acc[a][b][m][n] = (f32x4){0.f, 0.f, 0.f, 0.f};
        cur = nxt; cA = nA; cB = nB; ++ui;
        if constexpr (ALIGN_EPI) { if (wr == 1) PG8_BAR; }
    }
    PG8_WAIT_V(0);
    if constexpr (!ALIGN_EPI) { if (wr == 0) PG8_BAR; }
    PG8_BAR;
#undef PG8_SA
#undef PG8_SB
#undef PG8_STAGE
#undef PG8_LDA
#undef PG8_LDB
#undef PG8_MMA
#undef PG8_WAIT_V
#undef PG8_WAIT_L
#undef PG8_BAR
#undef PG8_SCHED
}
}

constexpr int NWAVES = 8, NTHR = 512;
constexpr int BATCH = 2, SEQ = 8192, D = 2048, M = BATCH * SEQ, CTXL = 256, MC = BATCH * CTXL;
constexpr int RW = 1024, NH = 8, DH = 128, CCH = 1024, INW = 7168, DFF = 5632, NUP = 2 * DFF, NCHK = 64, CHK = 128;
constexpr int NMOD = 6 * D;
constexpr float EPS = 1e-6f;
constexpr float KSCALE = 0.08838834764831845f;
constexpr int NSL = 8;

constexpr size_t MiB = 1u << 20;
constexpr size_t WS_CTL = 0, CTL_ZERO_BYTES = 1 * MiB;
constexpr size_t WS_COS = 1 * MiB, WS_SIN = WS_COS + 16384, WS_PW = WS_COS + 32768, WS_MODF = WS_COS + 65536, WS_MODP = WS_COS + 262144;
constexpr int PWS = 260;
constexpr size_t WS_WOUT = 4 * MiB, WS_WUP = 12 * MiB, WS_WDN = 56 * MiB, WS_XN = 78 * MiB, WS_HC = 142 * MiB, WS_KVC = 144 * MiB, WS_BIG = 146 * MiB;
constexpr size_t WS_P = WS_BIG, WS_CAT = WS_BIG + 224 * MiB, WS_WIN = WS_CAT  , WS_UA = WS_BIG, WS_UB = WS_BIG + 176 * MiB;
constexpr size_t WS_SPV = WS_BIG + 288 * MiB;
constexpr size_t WS_CTXS = WS_BIG + 352 * MiB;
constexpr size_t WS_END = WS_CTXS + 4 * MiB;
static_assert(WS_MODP + (size_t)NSL * 3 * NMOD * 4 <= WS_WOUT, "tables");
constexpr int CW_BAR = 4096;

constexpr int LDS_BYTES = 147456;
constexpr int MISC_OFF = LDS_BYTES - 256;

#define GAS __attribute__((address_space(1)))
#define LAS __attribute__((address_space(3)))
typedef unsigned short bf16;
typedef unsigned v4u __attribute__((ext_vector_type(4)));
typedef unsigned v2u __attribute__((ext_vector_type(2)));
typedef float f32x4 __attribute__((ext_vector_type(4)));
typedef GAS unsigned gu32;
#define LDS_WAIT() asm volatile("s_waitcnt lgkmcnt(0)" ::: "memory")
#define VM_WAIT() asm volatile("s_waitcnt vmcnt(0)" ::: "memory")
__device__ __forceinline__ unsigned f2bf(float f) { unsigned u = __builtin_bit_cast(unsigned, f); return (u + 0x7fffu + ((u >> 16) & 1u)) >> 16; }
__device__ __forceinline__ unsigned pk2(float lo, float hi) { return f2bf(lo) | (f2bf(hi) << 16); }
__device__ __forceinline__ float bflo(unsigned w) { return __builtin_bit_cast(float, w << 16); }
__device__ __forceinline__ float bfhi(unsigned w) { return __builtin_bit_cast(float, w & 0xffff0000u); }
__device__ __forceinline__ float bf1(bf16 h) { return __builtin_bit_cast(float, ((unsigned)h) << 16); }
__device__ __forceinline__ float silu_f(float x) { return x / (1.f + __expf(-x)); }
__device__ __forceinline__ float wave_sum(float v) {
#pragma unroll
    for (int o = 1; o < 64; o <<= 1) v += __shfl_xor(v, o);
    return v;
}


typedef short s16x4 __attribute__((ext_vector_type(4)));
typedef short bf16x8 __attribute__((ext_vector_type(8)));
__device__ __forceinline__ unsigned off_b(unsigned row, unsigned ch) { return 256u * row + 16u * (ch ^ (((row & 3u) << 2) | ((row >> 2) & 3u))); }
__device__ __forceinline__ s16x4 tr_rd(LAS unsigned char* p) { return __builtin_bit_cast(s16x4, __builtin_amdgcn_ds_read_tr16_b64_v4i16((LAS s16x4*)p)); }
__device__ __forceinline__ bf16x8 tr_frag(LAS unsigned char* img, unsigned lane, unsigned Ra, unsigned Rb, unsigned c) {
    const unsigned q = (lane & 15u) >> 2, p = lane & 3u;
    const s16x4 lo = tr_rd(img + off_b(Ra + q, 2u * c + (p >> 1)) + 8u * (p & 1u));
    const s16x4 hi = tr_rd(img + off_b(Rb + q, 2u * c + (p >> 1)) + 8u * (p & 1u));
    return __builtin_shufflevector(lo, hi, 0, 1, 2, 3, 4, 5, 6, 7);
}
__device__ __forceinline__ bf16x8 row_frag(LAS unsigned char* img, unsigned lane, unsigned rb, unsigned s_) { return *(const LAS bf16x8*)(img + off_b(16u * rb + (lane & 15u), 4u * s_ + (lane >> 4))); }
__device__ __forceinline__ v4u scale_pk8(v4u q, float w) { v4u o; o.x = pk2(bflo(q.x) * w, bfhi(q.x) * w); o.y = pk2(bflo(q.y) * w, bfhi(q.y) * w); o.z = pk2(bflo(q.z) * w, bfhi(q.z) * w); o.w = pk2(bflo(q.w) * w, bfhi(q.w) * w); return o; }

#define XB_TMO      128
#define XB_XCNT(j)  (256  + 64 * (j))
#define XB_XSUB(j)  (1280 + 64 * (j))
#define XB_XGEN(j)  (2304 + 64 * (j))
#define XB_TOP      3328
#define XB_TOPGEN   3392
#define XCD_BAR_WORDS 3456
#define XB_SPIN_CAP (1u << 18)
__device__ __forceinline__ unsigned xb_ld(unsigned* p)              { return __hip_atomic_load(p, __ATOMIC_RELAXED, __HIP_MEMORY_SCOPE_AGENT); }
__device__ __forceinline__ unsigned xb_add(unsigned* p, unsigned v) { return __hip_atomic_fetch_add(p, v, __ATOMIC_RELAXED, __HIP_MEMORY_SCOPE_AGENT); }
__device__ __forceinline__ unsigned xb_xcc_id() { return (unsigned)__builtin_amdgcn_s_getreg((3 << 11) | 20) & 0xFu; }
#define XB_SPIN(cond, bar) do { unsigned _sp = 0; while (cond) { __builtin_amdgcn_s_sleep(1); \
    if ((++_sp & 255u) == 0u) { if (xb_ld(&(bar)[XB_TMO])) break; if (_sp > XB_SPIN_CAP) { atomicAdd(&(bar)[XB_TMO], 1u); break; } } } } while (0)
struct XcdBarrier { unsigned* bar; unsigned x; volatile LAS unsigned* st; };
__device__ __forceinline__ XcdBarrier xcd_barrier_post(unsigned* bar, volatile LAS unsigned* st) {
    XcdBarrier b; b.bar = bar; b.x = xb_xcc_id(); b.st = st;
    if (threadIdx.x == 0) (void)xb_add(&bar[XB_XCNT(b.x)], 1u);
    return b;
}
__device__ __forceinline__ void xcd_barrier_complete(unsigned* bar, unsigned x, unsigned& nloc, unsigned& nx) {
    const unsigned G = gridDim.x * gridDim.y * gridDim.z;
    unsigned sum, cnt, mine, sp = 0u;
    for (;;) {
        sum = 0u; cnt = 0u; mine = 0u;
#pragma unroll
        for (unsigned j = 0; j < 16; ++j) { const unsigned c = xb_ld(&bar[XB_XCNT(j)]); sum += c; cnt += (c > 0u) ? 1u : 0u; mine = (j == x) ? c : mine; }
        if (sum == G) break;
        __builtin_amdgcn_s_sleep(1);
        if ((++sp & 255u) == 0u) { if (xb_ld(&bar[XB_TMO])) break; if (sp > XB_SPIN_CAP) { atomicAdd(&bar[XB_TMO], 1u); break; } }
    }
    nloc = mine > 0u ? mine : 1u; nx = cnt > 0u ? cnt : 1u;
}
__device__ __forceinline__ void xcd_barrier(const XcdBarrier& b) {
    asm volatile("s_waitcnt vmcnt(0)" ::: "memory");
    __syncthreads();
    if (threadIdx.x == 0) {
        unsigned* bar = b.bar;
        __builtin_amdgcn_s_waitcnt(0);
        unsigned nloc = b.st[0], nx = b.st[1];
        if (nloc == 0u) { xcd_barrier_complete(bar, b.x, nloc, nx); b.st[0] = nloc; b.st[1] = nx; }
        const unsigned old = xb_add(&bar[XB_XSUB(b.x)], 1u);
        const unsigned gen = old / nloc;
        if (old + 1u == (gen + 1u) * nloc) {
            __builtin_amdgcn_fence(__ATOMIC_RELEASE, "agent");
            asm volatile("s_waitcnt vmcnt(0)" ::: "memory");
            const unsigned og = xb_add(&bar[XB_TOP], 1u);
            const unsigned tg = og / nx;
            if (og + 1u == (tg + 1u) * nx) xb_add(&bar[XB_TOPGEN], 1u);
            else XB_SPIN(xb_ld(&bar[XB_TOPGEN]) == tg, bar);
            __builtin_amdgcn_fence(__ATOMIC_ACQUIRE, "agent");
            xb_add(&bar[XB_XGEN(b.x)], 1u);
            asm volatile("s_waitcnt vmcnt(0)" ::: "memory");
        } else {
            XB_SPIN(xb_ld(&bar[XB_XGEN(b.x)]) == gen, bar);
            __builtin_amdgcn_fence(__ATOMIC_ACQUIRE, "agent");
            asm volatile("s_waitcnt vmcnt(0)" ::: "memory");
        }
    }
    __syncthreads();
}

struct Args { const float* in[18]; float* out; unsigned char* ws; int ph_lo, ph_hi; };
enum { IN_X = 0, IN_C, IN_CTX, IN_CCTX, IN_WMOD, IN_BMOD, IN_G1, IN_WIN, IN_DECF, IN_DECB, IN_CONVW, IN_WOUT, IN_G2, IN_WUP, IN_FCW, IN_FCB, IN_WDN, IN_GF };
enum { PH_PRO = 0, PH_NORM1, PH_GEMM_IN, PH_KV, PH_SCAN, PH_RETOUT, PH_GEMM_OUT, PH_NORM2, PH_GEMM_UP, PH_GATE, PH_GEMM_DN, PH_FNORM, NPH };

template <bool PERMQK>
__device__ __forceinline__ void p0_transpose_item(const float* W, int K, int N, bf16* WT, LAS float* scr, int item, int lane) {
    const int nblk = N / 32, kb = item / nblk, nb = item % nblk, k0 = 64 * kb, n0 = 32 * nb;
#pragma unroll 8
    for (int i = 0; i < 32; ++i) { const int kk = 2 * i + (lane >> 5); scr[kk * 33 + (lane & 31)] = W[(size_t)(k0 + kk) * N + n0 + (lane & 31)]; }
    LDS_WAIT(); asm volatile("" ::: "memory");
    const int c = lane & 7;
#pragma unroll
    for (int j = 0; j < 4; ++j) { const int n = (lane >> 3) + 8 * j; const LAS float* s = scr + (8 * c) * 33 + n;
        v4u o; o.x = pk2(s[0 * 33], s[1 * 33]); o.y = pk2(s[2 * 33], s[3 * 33]); o.z = pk2(s[4 * 33], s[5 * 33]); o.w = pk2(s[6 * 33], s[7 * 33]);
        int ng = n0 + n;
        if (PERMQK) { if (ng < 2 * RW) ng = (ng & ~63) + 2 * (ng & 31) + ((ng >> 5) & 1); }
        *(GAS v4u*)(WT + (size_t)ng * K + k0 + 8 * c) = o; }
    LDS_WAIT(); asm volatile("" ::: "memory");
}

__device__ __forceinline__ void norm_row_bf16(const float* xrow, bf16* orow, const LAS float* mulT, const LAS float* addT, int lane) {
    const GAS f32x4* xr = (const GAS f32x4*)xrow + lane;
    f32x4 v[8]; float s = 0.f;
#pragma unroll
    for (int j = 0; j < 8; ++j) { v[j] = xr[64 * j]; s += (v[j].x * v[j].x + v[j].y * v[j].y) + (v[j].z * v[j].z + v[j].w * v[j].w); }
    const float rstd = rsqrtf(wave_sum(s) * (1.f / D) + EPS);
    GAS v2u* o8 = (GAS v2u*)orow + lane;
#pragma unroll
    for (int j = 0; j < 8; ++j) { const f32x4 mu = *(const LAS f32x4*)(mulT + 4 * (lane + 64 * j)), ad = *(const LAS f32x4*)(addT + 4 * (lane + 64 * j));
        const f32x4 y = v[j] * rstd * mu + ad; v2u w; w.x = pk2(y.x, y.y); w.y = pk2(y.z, y.w); o8[64 * j] = w; }
}

__global__ void __launch_bounds__(NTHR, 2) fwd_kernel(Args args) {
    extern __shared__ __attribute__((aligned(16))) unsigned char lds_raw[];
    LAS unsigned char* lds = (LAS unsigned char*)lds_raw;
    volatile LAS unsigned* MISC = (volatile LAS unsigned*)(lds + MISC_OFF);
    const int tid = threadIdx.x, lane = tid & 63, wave = __builtin_amdgcn_readfirstlane(tid >> 6);
    const int G = gridDim.x, bx = blockIdx.x;
    const int gw = bx * NWAVES + wave, NGW = G * NWAVES;
    const int gtid = bx * NTHR + tid, NGT = G * NTHR;
    unsigned char* ws = args.ws;
    const float* x = args.in[IN_X]; float* out = args.out;
    float* COS = (float*)(ws + WS_COS); float* SIN = (float*)(ws + WS_SIN); float* PW = (float*)(ws + WS_PW);
    float* MODF = (float*)(ws + WS_MODF); float* MODP = (float*)(ws + WS_MODP);
    bf16* WIN_T = (bf16*)(ws + WS_WIN); bf16* WOUT_T = (bf16*)(ws + WS_WOUT); bf16* WUP_T = (bf16*)(ws + WS_WUP); bf16* WDN_T = (bf16*)(ws + WS_WDN);
    bf16* XN = (bf16*)(ws + WS_XN); bf16* HC = (bf16*)(ws + WS_HC); bf16* KVC = (bf16*)(ws + WS_KVC);
    bf16* P = (bf16*)(ws + WS_P); bf16* CAT = (bf16*)(ws + WS_CAT); bf16* UA = (bf16*)(ws + WS_UA); bf16* UB = (bf16*)(ws + WS_UB);
    float* CTXS = (float*)(ws + WS_CTXS); bf16* SPV = (bf16*)(ws + WS_SPV);
    float* KVS = out;

    if (tid < 64) MISC[tid] = 0u;
    __syncthreads();
#if ONE_LAUNCH
    XcdBarrier bar = xcd_barrier_post((unsigned*)(ws + WS_CTL) + CW_BAR, MISC + 8);
#define GRID_BAR() xcd_barrier(bar)
#else
#define GRID_BAR() do {} while (0)
#endif
    const int lo = args.ph_lo, hi = args.ph_hi;
#ifndef PHMASK
#define PHMASK 0xFFF
#endif
#define IN(k) (((PHMASK >> (k)) & 1) && lo <= (k) && (k) < hi)
#define BOTH(k) (IN(k) && IN((k) + 1))
#ifndef REP_MASK
#define REP_MASK 0
#endif
#define REPS(k) ((((REP_MASK) >> (k)) & 1) + 1)

    if (IN(PH_PRO)) {
      for (int rep_ = 0; rep_ < REPS(PH_PRO); ++rep_) {
        LAS float* scr = (LAS float*)(lds + wave * 16384);
        constexpr int I_IN = (D / 64) * (INW / 32), I_OUT = (D / 64) * (D / 32), I_UP = (D / 64) * (NUP / 32), I_DN = (DFF / 64) * (D / 32), I_GV = NSL * (NMOD / 256);
        constexpr int NIT = I_IN + I_OUT + I_UP + I_DN + I_GV;
        for (int it = gw; it < NIT; it += NGW) {
            int r = it;
            if (r < I_IN) { p0_transpose_item<true>(args.in[IN_WIN], D, INW, WIN_T, scr, r, lane); continue; } r -= I_IN;
            if (r < I_OUT) { p0_transpose_item<false>(args.in[IN_WOUT], D, D, WOUT_T, scr, r, lane); continue; } r -= I_OUT;
            if (r < I_UP) { p0_transpose_item<false>(args.in[IN_WUP], D, NUP, WUP_T, scr, r, lane); continue; } r -= I_UP;
            if (r < I_DN) { p0_transpose_item<false>(args.in[IN_WDN], DFF, D, WDN_T, scr, r, lane); continue; } r -= I_DN;
            {
                const int s = r / (NMOD / 256), cgp = r % (NMOD / 256), col = cgp * 256 + lane * 4;
                f32x4 a0 = (f32x4){0.f, 0.f, 0.f, 0.f}, a1 = a0, a2 = a0;
                for (int kb = 0; kb < 4; ++kb) {
                    const int kbase = s * 256 + kb * 64;
                    const float c0 = silu_f(args.in[IN_C][kbase + lane]), c1 = silu_f(args.in[IN_C][D + kbase + lane]), c2 = silu_f(args.in[IN_CCTX][kbase + lane]);
                    const float* wp = args.in[IN_WMOD] + (size_t)kbase * NMOD + col;
#pragma unroll 8
                    for (int kk = 0; kk < 64; ++kk) {
                        const f32x4 w = *(const f32x4*)(wp + (size_t)kk * NMOD);
                        const float b0 = __shfl(c0, kk), b1 = __shfl(c1, kk), b2 = __shfl(c2, kk);
                        a0 += w * b0; a1 += w * b1; a2 += w * b2;
                    }
                }
                *(f32x4*)(MODP + ((size_t)(s * 3 + 0)) * NMOD + col) = a0;
                *(f32x4*)(MODP + ((size_t)(s * 3 + 1)) * NMOD + col) = a1;
                *(f32x4*)(MODP + ((size_t)(s * 3 + 2)) * NMOD + col) = a2;
            }
        }
        if (gtid < 4096) { const int pos = gtid >> 5, i = gtid & 31; const float fr = powf(10000.f, -(float)i / 32.f); const float ang = (float)pos * fr; COS[gtid] = cosf(ang); SIN[gtid] = sinf(ang); }
        else if (gtid < 4096 + 2 * NH * 257) { const int idx = gtid - 4096, dir = idx / (NH * 257), h = (idx / 257) % NH, k = idx % 257;
            const float lg0 = args.in[dir ? IN_DECB : IN_DECF][h]; const float lg = fminf(lg0, 0.f) - log1pf(expf(-fabsf(lg0)));
            PW[(dir * NH + h) * PWS + k] = expf(lg * (float)k); }
      }
        if (BOTH(PH_PRO)) GRID_BAR();
    }

    if (IN(PH_NORM1)) {
      for (int rep_ = 0; rep_ < REPS(PH_NORM1); ++rep_) {
        LAS float* mulT = (LAS float*)lds;
        LAS float* addT = (LAS float*)(lds + 3 * D * 4);
        for (int i = tid; i < 3 * D; i += NTHR) { const int r = i / D, k = i % D;
            float sh = args.in[IN_BMOD][k], sc = args.in[IN_BMOD][D + k];
#pragma unroll
            for (int s = 0; s < NSL; ++s) { sh += MODP[(size_t)(s * 3 + r) * NMOD + k]; sc += MODP[(size_t)(s * 3 + r) * NMOD + D + k]; }
            mulT[i] = args.in[IN_G1][k] * (1.f + sc); addT[i] = sh; }
        for (int i = gtid; i < 3 * NMOD; i += NGT) { const int r = i / NMOD, col = i % NMOD; float a = args.in[IN_BMOD][col];
#pragma unroll
            for (int s = 0; s < NSL; ++s) a += MODP[(size_t)(s * 3 + r) * NMOD + col];
            MODF[i] = a; }
        __syncthreads();
        for (int m = gw; m < M + MC; m += NGW) {
            if (m < M) { const int b = m >> 13; norm_row_bf16(x + (size_t)m * D, XN + (size_t)m * D, mulT + b * D, addT + b * D, lane); }
            else { const int mc = m - M; norm_row_bf16(args.in[IN_CTX] + (size_t)mc * D, HC + (size_t)mc * D, mulT + 2 * D, addT + 2 * D, lane); }
        }
      }
        if (BOTH(PH_NORM1)) GRID_BAR();
    }

    if (IN(PH_GEMM_IN)) {
      for (int rep_ = 0; rep_ < REPS(PH_GEMM_IN); ++rep_) {
        __syncthreads();
        { pg8::Gemm g{XN, WIN_T, M, INW, D}; pg8::StaticOrder S; S.init(M, INW, G, bx);
          pg8::EpiBf16R E{P, INW, 0, 0, COS, SIN, 8, 4, 8, KSCALE};
          pg8::gemm_phase<pg8::EpiBf16R, pg8::StaticOrder, true, true>(lds, g, S, E); }
        { pg8::Gemm g{HC, WIN_T + (size_t)RW * D, MC, 2 * RW, D}; pg8::StaticOrder S; S.init(MC, 2 * RW, G, bx);
          pg8::EpiBf16R E{KVC, 2 * RW, 0, 0, COS, SIN, 0, 0, 4, KSCALE};
          pg8::gemm_phase<pg8::EpiBf16R, pg8::StaticOrder, true, true>(lds, g, S, E); }
      }
        if (BOTH(PH_GEMM_IN)) GRID_BAR();
    }

    if (IN(PH_KV)) {
      for (int rep_ = 0; rep_ < REPS(PH_KV); ++rep_) {
        __syncthreads();
        LAS unsigned char* Kimg = lds; LAS unsigned char* Vfimg = lds + 32768; LAS unsigned char* Vbimg = lds + 65536;
        for (int item = bx; item < BATCH * NH * NCHK + BATCH * NH * 2; item += G) {
            const bf16* kptr; const bf16* vptr; size_t stride; int wfo, wbo, h; float* outf; float* outb;
            if (item < BATCH * NH * NCHK) { const int b = item >> 9, ch = item & 63; h = (item >> 6) & 7;
                kptr = P + ((size_t)b * SEQ + (size_t)ch * CHK) * INW + RW + h * DH; vptr = kptr + RW; stride = INW; wfo = 127; wbo = 0;
                outf = KVS + ((((size_t)(0 * BATCH + b) * NH + h) * NCHK + ch) * DH) * DH; outb = KVS + ((((size_t)(1 * BATCH + b) * NH + h) * NCHK + ch) * DH) * DH; }
            else { const int r = item - BATCH * NH * NCHK, b = r >> 4, c = r & 1; h = (r >> 1) & 7;
                kptr = KVC + ((size_t)b * CTXL + (size_t)c * CHK) * (2 * RW) + h * DH; vptr = kptr + RW; stride = 2 * RW; wfo = CTXL - 1 - CHK * c; wbo = CHK * c;
                outf = CTXS + ((((size_t)(0 * BATCH + b) * NH + h) * 2 + c) * DH) * DH; outb = CTXS + ((((size_t)(1 * BATCH + b) * NH + h) * 2 + c) * DH) * DH; }
            const float* pwf = PW + (0 * NH + h) * PWS; const float* pwb = PW + (1 * NH + h) * PWS;
#pragma unroll
            for (int i = 0; i < 4; ++i) { const int p = tid + NTHR * i, row = p >> 4, c16 = p & 15;
                const v4u kq = *(const GAS v4u*)(kptr + (size_t)row * stride + c16 * 8);
                const v4u vq = *(const GAS v4u*)(vptr + (size_t)row * stride + c16 * 8);
                const float wf = pwf[wfo - row], wb = pwb[wbo + row];
                const unsigned o = off_b(row, c16);
                *(LAS v4u*)(Kimg + o) = kq; *(LAS v4u*)(Vfimg + o) = scale_pk8(vq, wf); *(LAS v4u*)(Vbimg + o) = scale_pk8(vq, wb); }
            __syncthreads();
            {
                const unsigned g4 = lane >> 4, fr = lane & 15; const int dkg = wave >> 1, dvh = wave & 1;
                f32x4 accf[4][2], accb[4][2];
#pragma unroll
                for (int mt = 0; mt < 4; ++mt)
#pragma unroll
                    for (int nt = 0; nt < 2; ++nt) { accf[mt][nt] = (f32x4){0.f, 0.f, 0.f, 0.f}; accb[mt][nt] = (f32x4){0.f, 0.f, 0.f, 0.f}; }
#pragma unroll
                for (int ks = 0; ks < 4; ++ks) {
                    bf16x8 kf[2];
#pragma unroll
                    for (int nt = 0; nt < 2; ++nt) kf[nt] = tr_frag(Kimg, lane, 32 * ks + 8 * g4, 32 * ks + 8 * g4 + 4, 2 * dkg + nt);
#pragma unroll
                    for (int mt = 0; mt < 4; ++mt) {
                        const bf16x8 vf = tr_frag(Vfimg, lane, 32 * ks + 8 * g4, 32 * ks + 8 * g4 + 4, 4 * dvh + mt);
                        const bf16x8 vb = tr_frag(Vbimg, lane, 32 * ks + 8 * g4, 32 * ks + 8 * g4 + 4, 4 * dvh + mt);
#pragma unroll
                        for (int nt = 0; nt < 2; ++nt) { accf[mt][nt] = __builtin_amdgcn_mfma_f32_16x16x32_bf16(vf, kf[nt], accf[mt][nt], 0, 0, 0); accb[mt][nt] = __builtin_amdgcn_mfma_f32_16x16x32_bf16(vb, kf[nt], accb[mt][nt], 0, 0, 0); }
                    }
                }
#pragma unroll
                for (int mt = 0; mt < 4; ++mt)
#pragma unroll
                    for (int nt = 0; nt < 2; ++nt) { const size_t o = (size_t)(16 * (2 * dkg + nt) + fr) * DH + 16 * (4 * dvh + mt) + 4 * g4;
                        *(f32x4*)(outf + o) = accf[mt][nt]; *(f32x4*)(outb + o) = accb[mt][nt]; }
            }
            __syncthreads();
        }
        for (int item = bx; item < M / 64; item += G) {
            const int c8 = tid & 127, tg = tid >> 7;
            const size_t n0 = (size_t)item * 64 + tg * 16;
            const float* cw = args.in[IN_CONVW];
            float w0[8], w1[8], w2[8];
#pragma unroll
            for (int e = 0; e < 8; ++e) { w0[e] = cw[c8 * 8 + e]; w1[e] = cw[CCH + c8 * 8 + e]; w2[e] = cw[2 * CCH + c8 * 8 + e]; }
            float pv[8], cv[8], nv[8];
            auto ldch = [&](size_t n, float* o) { const v4u cq = *(const GAS v4u*)(P + n * INW + 5 * RW + c8 * 8), hq = *(const GAS v4u*)(P + n * INW + 6 * RW + c8 * 8);
                o[0] = bflo(cq.x) * bflo(hq.x); o[1] = bfhi(cq.x) * bfhi(hq.x); o[2] = bflo(cq.y) * bflo(hq.y); o[3] = bfhi(cq.y) * bfhi(hq.y);
                o[4] = bflo(cq.z) * bflo(hq.z); o[5] = bfhi(cq.z) * bfhi(hq.z); o[6] = bflo(cq.w) * bflo(hq.w); o[7] = bfhi(cq.w) * bfhi(hq.w); };
            if (tg > 0) ldch(n0 - 1, pv); else {
#pragma unroll
                for (int e = 0; e < 8; ++e) pv[e] = 0.f; }
            ldch(n0, cv);
            for (int t = 0; t < 16; ++t) {
                const size_t n = n0 + t;
                if ((n & 63) != 63) ldch(n + 1, nv); else {
#pragma unroll
                    for (int e = 0; e < 8; ++e) nv[e] = 0.f; }
                const v4u bq = *(const GAS v4u*)(P + n * INW + 4 * RW + c8 * 8);
                float bb[8] = {bflo(bq.x), bfhi(bq.x), bflo(bq.y), bfhi(bq.y), bflo(bq.z), bfhi(bq.z), bflo(bq.w), bfhi(bq.w)};
                float o[8];
#pragma unroll
                for (int e = 0; e < 8; ++e) { o[e] = bb[e] * (w0[e] * pv[e] + w1[e] * cv[e] + w2[e] * nv[e]); pv[e] = cv[e]; cv[e] = nv[e]; }
                v4u w; w.x = pk2(o[0], o[1]); w.y = pk2(o[2], o[3]); w.z = pk2(o[4], o[5]); w.w = pk2(o[6], o[7]);
                *(GAS v4u*)(CAT + n * D + RW + c8 * 8) = w;
            }
        }
      }
        if (BOTH(PH_KV)) GRID_BAR();
    }

    if (IN(PH_SCAN)) {
      for (int rep_ = 0; rep_ < REPS(PH_SCAN); ++rep_) {
        for (int e4 = gtid; e4 < 2 * BATCH * NH * DH * DH / 4; e4 += NGT) {
            const int dv4 = e4 & 31, dk = (e4 >> 5) & 127, h = (e4 >> 12) & 7, b = (e4 >> 15) & 1, dir = e4 >> 16;
            const float* pw = PW + (dir * NH + h) * PWS;
            const float* c0 = CTXS + ((((size_t)(dir * BATCH + b) * NH + h) * 2 + 0) * DH) * DH + (size_t)dk * DH + dv4 * 4;
            f32x4 s = *(const f32x4*)c0 + *(const f32x4*)(c0 + (size_t)DH * DH);
            const float cd = pw[CHK];
            const size_t boff = (((size_t)(dir * BATCH + b) * NH + h) * NCHK) * DH * DH + (size_t)dk * DH + dv4 * 4;
#pragma unroll 8
            for (int i = 0; i < NCHK; ++i) {
                const int n = dir ? (NCHK - 1 - i) : i;
                const f32x4 t = *(const f32x4*)(KVS + boff + (size_t)n * DH * DH);
                v2u w; w.x = pk2(s.x, s.y); w.y = pk2(s.z, s.w);
                *(GAS v2u*)(SPV + boff + (size_t)n * DH * DH) = w;
                s = s * cd + t;
            }
        }
      }
        if (BOTH(PH_SCAN)) GRID_BAR();
    }

    if (IN(PH_RETOUT)) {
      for (int rep_ = 0; rep_ < REPS(PH_RETOUT); ++rep_) {
        __syncthreads();
        LAS unsigned char* Qi = lds; LAS unsigned char* Ki = lds + 32768; LAS unsigned char* Vi = lds + 65536; LAS unsigned char* Si = lds + 98304;
        LAS float* pwl = (LAS float*)(lds + 131072);
        for (int item = bx; item < BATCH * NH * NCHK; item += G) {
            const int b = item >> 9, h = (item >> 6) & 7, ch = item & 63;
            const size_t tok0 = (size_t)b * SEQ + (size_t)ch * CHK;
            const bf16* qptr = P + tok0 * INW + h * DH;
            const bf16* sfp = SPV + ((((size_t)(0 * BATCH + b) * NH + h) * NCHK + ch) * DH) * DH;
            const bf16* sbp = SPV + ((((size_t)(1 * BATCH + b) * NH + h) * NCHK + ch) * DH) * DH;
            v4u sbq[4];
#pragma unroll
            for (int i = 0; i < 4; ++i) { const int p = tid + NTHR * i, row = p >> 4, c16 = p & 15; const unsigned o = off_b(row, c16);
                *(LAS v4u*)(Qi + o) = *(const GAS v4u*)(qptr + (size_t)row * INW + c16 * 8);
                *(LAS v4u*)(Ki + o) = *(const GAS v4u*)(qptr + (size_t)row * INW + RW + c16 * 8);
                *(LAS v4u*)(Vi + o) = *(const GAS v4u*)(qptr + (size_t)row * INW + 2 * RW + c16 * 8);
                *(LAS v4u*)(Si + o) = *(const GAS v4u*)(sfp + (size_t)row * DH + c16 * 8);
                sbq[i] = *(const GAS v4u*)(sbp + (size_t)row * DH + c16 * 8); }
            if (tid < 2 * 129) { const int dir = tid / 129, k = tid % 129; pwl[dir * 132 + k] = PW[(dir * NH + h) * PWS + k]; }
            __syncthreads();
            const unsigned g4 = lane >> 4, fr = lane & 15; const int i_in = 16 * wave + (int)fr;
            bf16x8 qf[4];
#pragma unroll
            for (int ks = 0; ks < 4; ++ks) qf[ks] = row_frag(Qi, lane, wave, ks);
            f32x4 sc[8];
#pragma unroll
            for (int jt = 0; jt < 8; ++jt) { sc[jt] = (f32x4){0.f, 0.f, 0.f, 0.f};
#pragma unroll
                for (int ks = 0; ks < 4; ++ks) sc[jt] = __builtin_amdgcn_mfma_f32_16x16x32_bf16(row_frag(Ki, lane, jt, ks), qf[ks], sc[jt], 0, 0, 0); }
            __syncthreads();
#pragma unroll
            for (int i = 0; i < 4; ++i) { const int p = tid + NTHR * i, row = p >> 4, c16 = p & 15; *(LAS v4u*)(Ki + off_b(row, c16)) = sbq[i]; }
            bf16x8 pf[4];
#pragma unroll
            for (int ks = 0; ks < 4; ++ks) {
                float pv[8];
#pragma unroll
                for (int hf = 0; hf < 2; ++hf)
#pragma unroll
                    for (int rg = 0; rg < 4; ++rg) { const int j = 16 * (2 * ks + hf) + 4 * (int)g4 + rg;
                        const float dm = (j <= i_in) ? pwl[i_in - j] : pwl[132 + (j - i_in)];
                        pv[4 * hf + rg] = sc[2 * ks + hf][rg] * dm; }
                v4u w; w.x = pk2(pv[0], pv[1]); w.y = pk2(pv[2], pv[3]); w.z = pk2(pv[4], pv[5]); w.w = pk2(pv[6], pv[7]);
                pf[ks] = __builtin_bit_cast(bf16x8, w);
            }
            f32x4 o[8];
#pragma unroll
            for (int nt = 0; nt < 8; ++nt) { o[nt] = (f32x4){0.f, 0.f, 0.f, 0.f};
#pragma unroll
                for (int ks = 0; ks < 4; ++ks) o[nt] = __builtin_amdgcn_mfma_f32_16x16x32_bf16(tr_frag(Vi, lane, 32 * ks + 4 * g4, 32 * ks + 16 + 4 * g4, nt), pf[ks], o[nt], 0, 0, 0); }
            {
                const float qd = pwl[i_in + 1]; bf16x8 qs[4];
#pragma unroll
                for (int ks = 0; ks < 4; ++ks) qs[ks] = __builtin_bit_cast(bf16x8, scale_pk8(__builtin_bit_cast(v4u, qf[ks]), qd));
#pragma unroll
                for (int nt = 0; nt < 8; ++nt)
#pragma unroll
                    for (int ks = 0; ks < 4; ++ks) o[nt] = __builtin_amdgcn_mfma_f32_16x16x32_bf16(tr_frag(Si, lane, 32 * ks + 8 * g4, 32 * ks + 8 * g4 + 4, nt), qs[ks], o[nt], 0, 0, 0);
            }
            __syncthreads();
            {
                const float qd = pwl[132 + (CHK - i_in)]; bf16x8 qs[4];
#pragma unroll
                for (int ks = 0; ks < 4; ++ks) qs[ks] = __builtin_bit_cast(bf16x8, scale_pk8(__builtin_bit_cast(v4u, qf[ks]), qd));
#pragma unroll
                for (int nt = 0; nt < 8; ++nt)
#pragma unroll
                    for (int ks = 0; ks < 4; ++ks) o[nt] = __builtin_amdgcn_mfma_f32_16x16x32_bf16(tr_frag(Ki, lane, 32 * ks + 8 * g4, 32 * ks + 8 * g4 + 4, nt), qs[ks], o[nt], 0, 0, 0);
            }
            {
                float ss = 0.f;
#pragma unroll
                for (int nt = 0; nt < 8; ++nt) ss += (o[nt].x * o[nt].x + o[nt].y * o[nt].y) + (o[nt].z * o[nt].z + o[nt].w * o[nt].w);
                ss += __shfl_xor(ss, 16); ss += __shfl_xor(ss, 32);
                const float rstd = rsqrtf(ss * (1.f / DH) + EPS);
                const bf16* gp = P + (tok0 + i_in) * INW + 3 * RW + h * DH + 4 * g4;
                bf16* op = CAT + (tok0 + i_in) * D + h * DH + 4 * g4;
#pragma unroll
                for (int nt = 0; nt < 8; ++nt) { const v2u gq = *(const GAS v2u*)(gp + 16 * nt);
                    v2u w; w.x = pk2(o[nt].x * rstd * silu_f(bflo(gq.x)), o[nt].y * rstd * silu_f(bfhi(gq.x))); w.y = pk2(o[nt].z * rstd * silu_f(bflo(gq.y)), o[nt].w * rstd * silu_f(bfhi(gq.y)));
                    *(GAS v2u*)(op + 16 * nt) = w; }
            }
            __syncthreads();
        }
      }
        if (BOTH(PH_RETOUT)) GRID_BAR();
    }

    if (IN(PH_GEMM_OUT)) {
      for (int rep_ = 0; rep_ < REPS(PH_GEMM_OUT); ++rep_) {
        __syncthreads();
        pg8::Gemm g{CAT, WOUT_T, M, D, D}; pg8::StaticOrder S; S.init(M, D, G, bx);
        pg8::EpiRes E{x, out, D, MODF + 2 * D, NMOD};
        pg8::gemm_phase<pg8::EpiRes, pg8::StaticOrder, true, true>(lds, g, S, E);
      }
        if (BOTH(PH_GEMM_OUT)) GRID_BAR();
    }

    if (IN(PH_NORM2)) {
      for (int rep_ = 0; rep_ < REPS(PH_NORM2); ++rep_) {
        __syncthreads();
        LAS float* mulT = (LAS float*)lds; LAS float* addT = (LAS float*)(lds + 2 * D * 4);
        for (int i = tid; i < 2 * D; i += NTHR) { const int r = i / D, k = i % D;
            mulT[i] = args.in[IN_G2][k] * (1.f + MODF[(size_t)r * NMOD + 4 * D + k]); addT[i] = MODF[(size_t)r * NMOD + 3 * D + k]; }
        __syncthreads();
        for (int m = gw; m < M; m += NGW) { const int b = m >> 13; norm_row_bf16(out + (size_t)m * D, XN + (size_t)m * D, mulT + b * D, addT + b * D, lane); }
      }
        if (BOTH(PH_NORM2)) GRID_BAR();
    }

    if (IN(PH_GEMM_UP)) {
      for (int rep_ = 0; rep_ < REPS(PH_GEMM_UP); ++rep_) {
        __syncthreads();
        pg8::Gemm g{XN, WUP_T, M, NUP, D}; pg8::StaticOrder S; S.init(M, NUP, G, bx);
        pg8::EpiBf16R E{UA, DFF, DFF, (size_t)(WS_UB - WS_UA) / 2, COS, SIN, 0, 0, 0, 1.f};
        pg8::gemm_phase<pg8::EpiBf16R, pg8::StaticOrder, true, true>(lds, g, S, E);
      }
        if (BOTH(PH_GEMM_UP)) GRID_BAR();
    }

    if (IN(PH_GATE)) {
      for (int rep_ = 0; rep_ < REPS(PH_GATE); ++rep_) {
        const float* fw = args.in[IN_FCW]; const float* fb = args.in[IN_FCB];
        for (int idx = gtid; idx < M * (DFF / 8); idx += NGT) {
            const int n = idx / (DFF / 8), c8 = idx % (DFF / 8), grow = (n & (SEQ - 1)) >> 6;
            const size_t off = (size_t)n * DFF + c8 * 8;
            const v4u z = (v4u){0u, 0u, 0u, 0u};
            const v4u a0 = grow > 0 ? *(const GAS v4u*)(UA + off - (size_t)64 * DFF) : z;
            const v4u a1 = *(const GAS v4u*)(UA + off);
            const v4u a2 = grow < 127 ? *(const GAS v4u*)(UA + off + (size_t)64 * DFF) : z;
            const v4u bq = *(const GAS v4u*)(UB + off);
            const float A0[8] = {bflo(a0.x), bfhi(a0.x), bflo(a0.y), bfhi(a0.y), bflo(a0.z), bfhi(a0.z), bflo(a0.w), bfhi(a0.w)};
            const float A1[8] = {bflo(a1.x), bfhi(a1.x), bflo(a1.y), bfhi(a1.y), bflo(a1.z), bfhi(a1.z), bflo(a1.w), bfhi(a1.w)};
            const float A2[8] = {bflo(a2.x), bfhi(a2.x), bflo(a2.y), bfhi(a2.y), bflo(a2.z), bfhi(a2.z), bflo(a2.w), bfhi(a2.w)};
            const float BB[8] = {bflo(bq.x), bfhi(bq.x), bflo(bq.y), bfhi(bq.y), bflo(bq.z), bfhi(bq.z), bflo(bq.w), bfhi(bq.w)};
            float o[8];
#pragma unroll
            for (int e = 0; e < 8; ++e) { const int c = c8 * 8 + e; const float av = fw[c] * A0[e] + fw[DFF + c] * A1[e] + fw[2 * DFF + c] * A2[e] + fb[c]; o[e] = silu_f(av) * BB[e]; }
            v4u w; w.x = pk2(o[0], o[1]); w.y = pk2(o[2], o[3]); w.z = pk2(o[4], o[5]); w.w = pk2(o[6], o[7]);
            *(GAS v4u*)(UB + off) = w;
        }
      }
        if (BOTH(PH_GATE)) GRID_BAR();
    }

    if (IN(PH_GEMM_DN)) {
      for (int rep_ = 0; rep_ < REPS(PH_GEMM_DN); ++rep_) {
        __syncthreads();
        pg8::Gemm g{UB, WDN_T, M, D, DFF}; pg8::StaticOrder S; S.init(M, D, G, bx);
        pg8::EpiRes E{out, out, D, MODF + 5 * D, NMOD};
        pg8::gemm_phase<pg8::EpiRes, pg8::StaticOrder, true, true>(lds, g, S, E);
      }
        if (BOTH(PH_GEMM_DN)) GRID_BAR();
    }

    if (IN(PH_FNORM)) {
        const float* gfin = args.in[IN_GF];
        for (int m = gw; m < M; m += NGW) {
            GAS f32x4* xr = (GAS f32x4*)(out + (size_t)m * D) + lane;
            f32x4 v[8]; float s = 0.f;
#pragma unroll
            for (int j = 0; j < 8; ++j) { v[j] = xr[64 * j]; s += (v[j].x * v[j].x + v[j].y * v[j].y) + (v[j].z * v[j].z + v[j].w * v[j].w); }
            const float rstd = rsqrtf(wave_sum(s) * (1.f / D) + EPS);
#pragma unroll
            for (int j = 0; j < 8; ++j) { const f32x4 gg = *(const f32x4*)(gfin + 4 * (lane + 64 * j)); xr[64 * j] = v[j] * rstd * gg; }
        }
    }
#undef IN
#undef BOTH
}

extern "C" void kernel_launch(void* const* d_in, const int* in_sizes, int n_in, void* d_out, int out_size, void* d_ws, size_t ws_size, hipStream_t stream) {
    static int grid = 0;
    if (grid == 0) {
        if (n_in != 18 || in_sizes[0] != M * D || out_size != M * D || ws_size < WS_END) { fprintf(stderr, "kernel_launch: unexpected shapes/workspace (n_in %d, in0 %d, out %d, ws %zu, need %zu); nothing launched\n", n_in, n_in > 0 ? in_sizes[0] : -1, out_size, ws_size, (size_t)WS_END); grid = -1; return; }
        int dev = 0, cus = 0, per_cu = 0;
        if (hipGetDevice(&dev) != hipSuccess || hipDeviceGetAttribute(&cus, hipDeviceAttributeMultiprocessorCount, dev) != hipSuccess) { grid = -1; return; }
        if (hipFuncSetAttribute((const void*)fwd_kernel, hipFuncAttributeMaxDynamicSharedMemorySize, LDS_BYTES) != hipSuccess) { fprintf(stderr, "kernel_launch: hipFuncSetAttribute failed\n"); grid = -1; return; }
        if (hipOccupancyMaxActiveBlocksPerMultiprocessor(&per_cu, (const void*)fwd_kernel, NTHR, LDS_BYTES) != hipSuccess || per_cu < 1) { fprintf(stderr, "kernel_launch: occupancy query says %d\n", per_cu); per_cu = 1; }
        (void)hipGetLastError();
        grid = cus * (per_cu < 1 ? 1 : 1);
    }
    if (grid < 0) return;
    (void)hipMemsetAsync((char*)d_ws + WS_CTL, 0, CTL_ZERO_BYTES, stream);
    Args a{};
    for (int i = 0; i < 18; ++i) a.in[i] = (const float*)d_in[i];
    a.out = (float*)d_out; a.ws = (unsigned char*)d_ws;
#if ONE_LAUNCH
    a.ph_lo = 0; a.ph_hi = NPH;
    void* kargs[] = {&a};
    hipError_t e = hipLaunchCooperativeKernel((const void*)fwd_kernel, dim3(grid), dim3(NTHR), kargs, LDS_BYTES, stream);
    if (e != hipSuccess) fprintf(stderr, "kernel_launch: cooperative launch failed: %s (grid %d)\n", hipGetErrorString(e), grid);
#else
    for (int p = 0; p < NPH; ++p) { a.ph_lo = p; a.ph_hi = p + 1; hipLaunchKernelGGL(fwd_kernel, dim3(grid), dim3(NTHR), LDS_BYTES, stream, a); }
#endif
}
```

```cpp
#include <hip/hip_runtime.h>
#include <cstdio>
#include <cstdint>

#ifndef GP_ALIGN
#define GP_ALIGN true
#endif
#ifndef GP_SP2
#define GP_SP2 true
#endif
#ifndef ONE_LAUNCH
#define ONE_LAUNCH 1
#endif

namespace pg8 {
#define PG8_LAS __attribute__((address_space(3)))
typedef unsigned short bf16_t;
typedef short bf16x8 __attribute__((ext_vector_type(8)));
typedef float f32x4 __attribute__((ext_vector_type(4)));
typedef unsigned u32x4 __attribute__((ext_vector_type(4)));
constexpr int BM = 256, BK = 64, HALF = 128, HTB = HALF * BK * 2, STAGE_BYTES = 8 * HTB, NXCD = 8, WGM = 8;

__host__ __device__ __forceinline__ int lds_byte(int r, int c) { const int st = (r >> 4) * 2 + (c >> 5), rr = r & 15, cc = c & 31, ob = rr * 64 + cc * 2; return st * 1024 + (ob ^ (((ob >> 9) & 1) << 5)); }
__host__ __device__ __forceinline__ void stage_rc(int b, int& R, int& C) { const int st = b / 1024, sb = b % 1024, swz = sb ^ (((sb >> 9) & 1) << 5); R = (st >> 1) * 16 + swz / 64; C = (st & 1) * 32 + (swz % 64) / 2; }
__host__ __device__ __forceinline__ int perm32(int rho) { const int n = rho >> 4, i = rho & 15; return 8 * (i >> 2) + 4 * n + (i & 3); }

struct Unit { int pm, pn; };
struct Gemm { const bf16_t* A; const bf16_t* Bt; int M, N, K; };

struct StaticOrder {
    int nM, nN, nwg, G, c;
    __host__ __device__ void init(int M, int N, int G_, int c_) { nM = M / BM; nN = N / BM; nwg = nM * nN; G = G_; c = c_; }
    __host__ __device__ bool next(int i, Unit& u) const {
        const long L = (long)i * G + c; if (L >= nwg) return false;
        int wgid = (int)L; { const int q = nwg / NXCD, r = nwg % NXCD, xcd = wgid % NXCD, off = wgid / NXCD; wgid = (xcd < r ? xcd * (q + 1) : r * (q + 1) + (xcd - r) * q) + off; }
        const int nig = WGM * nN, gid = wgid / nig, fm = gid * WGM, gsz = (nM - fm) < WGM ? (nM - fm) : WGM;
        u.pm = fm + ((wgid % nig) % gsz); u.pn = (wgid % nig) / gsz; return true;
    }
    __device__ __forceinline__ void a_ready(const Unit&) const {}
    __device__ __forceinline__ void done(const Unit&) const {}
};

__device__ __forceinline__ unsigned cvt_pk_bf16(float lo, float hi) { unsigned r; asm volatile("v_cvt_pk_bf16_f32 %0, %1, %2" : "=v"(r) : "v"(lo), "v"(hi)); return r; }


struct EpiBf16R {
    static constexpr bool PERM = true, AFTER_DRAIN = false;
    bf16_t* O; int ldc; int split_cols; size_t split_stride;
    const float* cosT; const float* sinT; int rope_hi; int sc_lo, sc_hi; float sc;
    __device__ __forceinline__ void operator()(const f32x4 (&acc)[2][2][4][2], const Unit& u, int wr, int wc, int fr, int fq) const {
        const int row0 = u.pm * BM + wr * 64 + fr; int colt = u.pn * BM; bf16_t* base = O;
        if (split_cols) { const int t = colt / split_cols; base += (size_t)t * split_stride; colt -= t * split_cols; }
        const int col0 = colt + wc * 32 + 8 * fq;
        const bool rope = u.pn < rope_hi; const float s = (u.pn >= sc_lo && u.pn < sc_hi) ? sc : 1.f;
        const int ti = 16 * (wc & 1) + 4 * fq;
#pragma unroll
        for (int ai = 0; ai < 2; ++ai)
#pragma unroll
            for (int m = 0; m < 4; ++m) {
                const int r = row0 + ai * HALF + m * 16;
                f32x4 cs = (f32x4){1.f, 1.f, 1.f, 1.f}, sn = (f32x4){0.f, 0.f, 0.f, 0.f};
                if (rope) { const int ntok = r & 8191; const int pos = (wc >> 1) ? (ntok & 63) : (ntok >> 6); cs = *(const f32x4*)(cosT + pos * 32 + ti); sn = *(const f32x4*)(sinT + pos * 32 + ti); }
                bf16_t* rowp = base + (size_t)r * ldc + col0;
#pragma unroll
                for (int bj = 0; bj < 2; ++bj) {
                    const f32x4 v0 = acc[ai][bj][m][0], v1 = acc[ai][bj][m][1]; f32x4 o0, o1;
                    o0[0] = v0[0] * cs[0] - v0[1] * sn[0]; o0[1] = v0[0] * sn[0] + v0[1] * cs[0];
                    o0[2] = v0[2] * cs[1] - v0[3] * sn[1]; o0[3] = v0[2] * sn[1] + v0[3] * cs[1];
                    o1[0] = v1[0] * cs[2] - v1[1] * sn[2]; o1[1] = v1[0] * sn[2] + v1[1] * cs[2];
                    o1[2] = v1[2] * cs[3] - v1[3] * sn[3]; o1[3] = v1[2] * sn[3] + v1[3] * cs[3];
                    o0 = o0 * s; o1 = o1 * s;
                    u32x4 w; w.x = cvt_pk_bf16(o0[0], o0[1]); w.y = cvt_pk_bf16(o0[2], o0[3]); w.z = cvt_pk_bf16(o1[0], o1[1]); w.w = cvt_pk_bf16(o1[2], o1[3]);
                    *(u32x4*)(rowp + bj * HALF) = w; }
            }
    }
};
struct EpiRes {
    static constexpr bool PERM = false, AFTER_DRAIN = false;
    const float* base; float* out; int ldc; const float* gate; int gate_bstride;
    __device__ __forceinline__ void operator()(const f32x4 (&acc)[2][2][4][2], const Unit& u, int wr, int wc, int fr, int fq) const {
        const int row0 = u.pm * BM + wr * 64 + fr, col0 = u.pn * BM + wc * 32 + 4 * fq;
        const float* gp = gate + (size_t)((u.pm * BM) >> 13) * gate_bstride + col0;
        f32x4 gv[2][2];
#pragma unroll
        for (int bj = 0; bj < 2; ++bj)
#pragma unroll
            for (int n = 0; n < 2; ++n) gv[bj][n] = *(const f32x4*)(gp + bj * HALF + n * 16);
#pragma unroll
        for (int ai = 0; ai < 2; ++ai)
#pragma unroll
            for (int m = 0; m < 4; ++m) { const size_t off = (size_t)(row0 + ai * HALF + m * 16) * ldc + col0;
#pragma unroll
                for (int bj = 0; bj < 2; ++bj)
#pragma unroll
                    for (int n = 0; n < 2; ++n) { const f32x4 bs = *(const f32x4*)(base + off + bj * HALF + n * 16); *(f32x4*)(out + off + bj * HALF + n * 16) = bs + gv[bj][n] * acc[ai][bj][m][n]; }
                if (m & 1) asm volatile("" ::: "memory"); }
    }
};

struct EpiResNorm {
    static constexpr bool PERM = false, AFTER_DRAIN = false;
    const float* base; float* out; int ldc; const float* gate; int gate_bstride; const float* mul; bf16_t* xn; float* rowss;
    __device__ __forceinline__ void operator()(const f32x4 (&acc)[2][2][4][2], const Unit& u, int wr, int wc, int fr, int fq) const {
        const int row0 = u.pm * BM + wr * 64 + fr, col0 = u.pn * BM + wc * 32 + 4 * fq, b = (u.pm * BM) >> 13;
        const float* gp = gate + (size_t)b * gate_bstride + col0; const float* mp = mul + (size_t)b * ldc + col0;
        f32x4 gv[2][2];
#pragma unroll
        for (int bj = 0; bj < 2; ++bj)
#pragma unroll
            for (int n = 0; n < 2; ++n) gv[bj][n] = *(const f32x4*)(gp + bj * HALF + n * 16);
#pragma unroll
        for (int ai = 0; ai < 2; ++ai)
#pragma unroll
            for (int m = 0; m < 4; ++m) { const int r = row0 + ai * HALF + m * 16; const size_t off = (size_t)r * ldc + col0; float ss = 0.f;
#pragma unroll
                for (int bj = 0; bj < 2; ++bj)
#pragma unroll
                    for (int n = 0; n < 2; ++n) { const f32x4 bs = *(const f32x4*)(base + off + bj * HALF + n * 16); const f32x4 mv = *(const f32x4*)(mp + bj * HALF + n * 16);
                        const f32x4 v = bs + gv[bj][n] * acc[ai][bj][m][n]; *(f32x4*)(out + off + bj * HALF + n * 16) = v;
                        ss += (v[0] * v[0] + v[1] * v[1]) + (v[2] * v[2] + v[3] * v[3]);
                        const f32x4 y = v * mv; unsigned w0 = cvt_pk_bf16(y[0], y[1]), w1 = cvt_pk_bf16(y[2], y[3]);
                        typedef unsigned u32x2 __attribute__((ext_vector_type(2))); *(u32x2*)(xn + off + bj * HALF + n * 16) = (u32x2){w0, w1}; }
                ss += __shfl_xor(ss, 16); ss += __shfl_xor(ss, 32);
                if (fq == 0) rowss[(size_t)r * 32 + 4 * u.pn + wc] = ss;
                if (m & 1) asm volatile("" ::: "memory"); }
    }
};
struct EpiUp {
    static constexpr bool PERM = true, AFTER_DRAIN = false;
    bf16_t* O; int ldc; int split_cols; size_t split_stride; const float* bias; int bias_bstride; const PG8_LAS float* rs; int pm_cached; const float* rowss; float inv_d, eps;
    __device__ __forceinline__ void operator()(const f32x4 (&acc)[2][2][4][2], const Unit& u, int wr, int wc, int fr, int fq) const {
        const int row0 = u.pm * BM + wr * 64 + fr; int colt = u.pn * BM; bf16_t* base = O;
        { const int t = colt / split_cols; base += (size_t)t * split_stride; colt -= t * split_cols; }
        const int col0 = colt + wc * 32 + 8 * fq; const float* bp = bias + (size_t)((u.pm * BM) >> 13) * bias_bstride + u.pn * BM + wc * 32 + 8 * fq;
        f32x4 bv[2][2];
#pragma unroll
        for (int bj = 0; bj < 2; ++bj)
#pragma unroll
            for (int n = 0; n < 2; ++n) bv[bj][n] = *(const f32x4*)(bp + bj * HALF + 4 * n);
#pragma unroll
        for (int ai = 0; ai < 2; ++ai)
#pragma unroll
            for (int m = 0; m < 4; ++m) { const int rl = ai * HALF + wr * 64 + m * 16 + fr; const int r = u.pm * BM + rl; float rsv;
                if (u.pm == pm_cached) rsv = rs[rl];
                else { float t = 0.f; for (int i = 0; i < 32; ++i) t += rowss[(size_t)r * 32 + i]; rsv = rsqrtf(t * inv_d + eps); }
                bf16_t* rowp = base + (size_t)r * ldc + col0;
#pragma unroll
                for (int bj = 0; bj < 2; ++bj) { const f32x4 v0 = acc[ai][bj][m][0] * rsv + bv[bj][0], v1 = acc[ai][bj][m][1] * rsv + bv[bj][1];
                    u32x4 w; w.x = cvt_pk_bf16(v0[0], v0[1]); w.y = cvt_pk_bf16(v0[2], v0[3]); w.z = cvt_pk_bf16(v1[0], v1[1]); w.w = cvt_pk_bf16(v1[2], v1[3]);
                    *(u32x4*)(rowp + bj * HALF) = w; } }
    }
};
struct EpiNull {
    static constexpr bool PERM = true, AFTER_DRAIN = false;
    __device__ __forceinline__ void operator()(const f32x4 (&acc)[2][2][4][2], const Unit&, int, int, int, int) const {
#pragma unroll
        for (int ai = 0; ai < 2; ++ai)
#pragma unroll
            for (int bj = 0; bj < 2; ++bj)
#pragma unroll
                for (int m = 0; m < 4; ++m)
#pragma unroll
                    for (int n = 0; n < 2; ++n) asm volatile("" :: "v"(acc[ai][bj][m][n]));
    }
};
struct SameTileOrder : StaticOrder {
    __host__ __device__ bool next(int i, Unit& u) const { const long L = (long)i * G + c; if (L >= nwg) return false; u.pm = 0; u.pn = c % nN; return true; }
};
template <class Epi, class Sched, bool ALIGN_EPI = false, bool SP2 = false>
__device__ __forceinline__ void gemm_phase(PG8_LAS unsigned char* lds, const Gemm g, const Sched& S, const Epi& E) {
    const int tid = threadIdx.x, wid = __builtin_amdgcn_readfirstlane(tid >> 6), lane = tid & 63, wr = wid >> 2, wc = wid & 3, fr = lane & 15, fq = lane >> 4;
    const int K = g.K, nt = K / BK;
    unsigned voffA[2], voffB[2];
#pragma unroll
    for (int i = 0; i < 2; ++i) { int R, C; stage_rc(tid * 16 + i * 8192, R, C); const int Rb = Epi::PERM ? ((R & ~31) + perm32(R & 31)) : R;
        voffA[i] = (unsigned)(R * K + C) * 2u; voffB[i] = (unsigned)(Rb * K + C) * 2u; }
    const size_t kstep = (size_t)(BK * 2);
    const size_t hstep = (size_t)HALF * K * 2;
    const size_t tstep = 2 * hstep;
    const unsigned ldsw = (unsigned)wid * 1024u;
    const int aoff = lds_byte(wr * 64 + fr, fq * 8), boff = lds_byte(wc * 32 + fr, fq * 8);
#define PG8_SA(b, h) (((b) * 2 + (h)) * HTB)
#define PG8_SB(b, h) ((4 + (b) * 2 + (h)) * HTB)
#define PG8_STAGE(bufoff, gbase, voff) do { _Pragma("unroll") for (int _i = 0; _i < 2; ++_i) \
        __builtin_amdgcn_global_load_lds((const unsigned*)((const char*)(gbase) + (voff)[_i]), (PG8_LAS unsigned*)(lds + (bufoff) + ldsw + _i * 8192), 16, 0, 0); } while (0)
#define PG8_LDA(dst, b, h) do { _Pragma("unroll") for (int m = 0; m < 4; ++m) _Pragma("unroll") for (int k = 0; k < 2; ++k) dst[m][k] = *(const PG8_LAS bf16x8*)(lds + PG8_SA(b, h) + aoff + m * 2048 + k * 1024); } while (0)
#define PG8_LDB(dst, b, h) do { _Pragma("unroll") for (int n = 0; n < 2; ++n) _Pragma("unroll") for (int k = 0; k < 2; ++k) dst[n][k] = *(const PG8_LAS bf16x8*)(lds + PG8_SB(b, h) + boff + n * 2048 + k * 1024); } while (0)
#define PG8_MMA(ai, bj, At, Bt) do { __builtin_amdgcn_s_setprio(1); _Pragma("unroll") for (int m = 0; m < 4; ++m) _Pragma("unroll") for (int n = 0; n < 2; ++n) _Pragma("unroll") for (int k = 0; k < 2; ++k) \
        acc[ai][bj][m][n] = __builtin_amdgcn_mfma_f32_16x16x32_bf16(Bt[n][k], At[m][k], acc[ai][bj][m][n], 0, 0, 0); __builtin_amdgcn_s_setprio(0); } while (0)
#define PG8_WAIT_V(n) asm volatile("s_waitcnt vmcnt(" #n ")" ::: "memory")
#define PG8_WAIT_L(n) asm volatile("s_waitcnt lgkmcnt(" #n ")" ::: "memory")
#define PG8_BAR __builtin_amdgcn_s_barrier()
#define PG8_SCHED __builtin_amdgcn_sched_barrier(0)
    Unit cur, nxt; int ui = 0;
    if (!S.next(0, cur)) return;
    f32x4 acc[2][2][4][2];
#pragma unroll
    for (int a = 0; a < 2; ++a)
#pragma unroll
        for (int b = 0; b < 2; ++b)
#pragma unroll
            for (int m = 0; m < 4; ++m)
#pragma unroll
                for (int n = 0; n < 2; ++n) acc[a][b][m][n] = (f32x4){0.f, 0.f, 0.f, 0.f};
    bf16x8 At[4][2], B0[2][2], B1[2][2];
    const char* cA = (const char*)g.A + (size_t)cur.pm * tstep; const char* cB = (const char*)g.Bt + (size_t)cur.pn * tstep;
    S.a_ready(cur);
    if constexpr (SP2) {
        PG8_STAGE(PG8_SB(0, 0), cB, voffB); PG8_STAGE(PG8_SB(0, 1), cB + hstep, voffB); PG8_STAGE(PG8_SA(0, 0), cA, voffA); PG8_STAGE(PG8_SA(0, 1), cA + hstep, voffA);
        if (wr == 1) PG8_BAR;
        PG8_WAIT_V(2); PG8_BAR;
        PG8_STAGE(PG8_SB(1, 0), cB + kstep, voffB); PG8_STAGE(PG8_SA(1, 0), cA + kstep, voffA); PG8_STAGE(PG8_SB(1, 1), cB + hstep + kstep, voffB);
        PG8_WAIT_V(6); PG8_BAR;
    } else {
        PG8_STAGE(PG8_SB(0, 0), cB, voffB); PG8_STAGE(PG8_SA(0, 0), cA, voffA); PG8_STAGE(PG8_SB(0, 1), cB + hstep, voffB); PG8_STAGE(PG8_SA(0, 1), cA + hstep, voffA);
        if (wr == 1) PG8_BAR;
        PG8_WAIT_V(4); PG8_BAR;
        PG8_STAGE(PG8_SB(1, 0), cB + kstep, voffB); PG8_STAGE(PG8_SA(1, 0), cA + kstep, voffA); PG8_STAGE(PG8_SB(1, 1), cB + hstep + kstep, voffB);
        PG8_WAIT_V(6); PG8_BAR;
    }
    for (;;) {
        const bool has_next = S.next(ui + 1, nxt);
        const char* nA = has_next ? (const char*)g.A + (size_t)nxt.pm * tstep : cA; const char* nB = has_next ? (const char*)g.Bt + (size_t)nxt.pn * tstep : cB;
        for (int t = 0; t < nt; t += 2) {
            const bool last = (t == nt - 2);
            const char* a1 = cA + (size_t)(t + 1) * kstep;
            const char* a2 = last ? nA : cA + (size_t)(t + 2) * kstep; const char* b2 = last ? nB : cB + (size_t)(t + 2) * kstep;
            const char* a3 = a2 + kstep; const char* b3 = b2 + kstep;
            if (last && has_next) S.a_ready(nxt);
            if constexpr (SP2) {
            PG8_LDB(B0, 0, 0); PG8_LDB(B1, 0, 1); PG8_SCHED; PG8_LDA(At, 0, 0); PG8_STAGE(PG8_SA(1, 1), a1 + hstep, voffA);
            PG8_WAIT_V(8); PG8_WAIT_L(0); PG8_BAR; PG8_MMA(0, 0, At, B0); PG8_MMA(0, 1, At, B1); PG8_BAR; PG8_SCHED;
            PG8_LDA(At, 0, 1); PG8_STAGE(PG8_SB(0, 0), b2, voffB); PG8_STAGE(PG8_SB(0, 1), b2 + hstep, voffB); PG8_STAGE(PG8_SA(0, 0), a2, voffA);
            PG8_WAIT_V(8); PG8_WAIT_L(0); PG8_BAR; PG8_MMA(1, 0, At, B0); PG8_MMA(1, 1, At, B1); PG8_BAR; PG8_SCHED;
            PG8_LDB(B0, 1, 0); PG8_LDB(B1, 1, 1); PG8_SCHED; PG8_LDA(At, 1, 0); PG8_STAGE(PG8_SA(0, 1), a2 + hstep, voffA);
            PG8_WAIT_V(8); PG8_WAIT_L(0); PG8_BAR; PG8_MMA(0, 0, At, B0); PG8_MMA(0, 1, At, B1); PG8_BAR; PG8_SCHED;
            PG8_LDA(At, 1, 1); PG8_STAGE(PG8_SB(1, 0), b3, voffB); PG8_STAGE(PG8_SB(1, 1), b3 + hstep, voffB); PG8_STAGE(PG8_SA(1, 0), a3, voffA);
            PG8_WAIT_V(8); PG8_WAIT_L(0); PG8_BAR; PG8_MMA(1, 0, At, B0); PG8_MMA(1, 1, At, B1); PG8_BAR; PG8_SCHED;
            } else {
            PG8_LDB(B0, 0, 0); PG8_SCHED; PG8_LDA(At, 0, 0); PG8_STAGE(PG8_SA(1, 1), a1 + hstep, voffA);
            PG8_WAIT_L(8); PG8_BAR; PG8_WAIT_L(0); PG8_MMA(0, 0, At, B0); PG8_BAR; PG8_SCHED;
            PG8_LDB(B1, 0, 1); PG8_STAGE(PG8_SB(0, 0), b2, voffB);
            PG8_BAR; PG8_WAIT_L(0); PG8_MMA(0, 1, At, B1); PG8_BAR;
            PG8_LDA(At, 0, 1); PG8_STAGE(PG8_SA(0, 0), a2, voffA);
            PG8_BAR; PG8_WAIT_L(0); PG8_MMA(1, 0, At, B0); PG8_BAR; PG8_SCHED;
            PG8_STAGE(PG8_SB(0, 1), b2 + hstep, voffB);
            PG8_WAIT_V(6); PG8_BAR; PG8_MMA(1, 1, At, B1); PG8_BAR;
            PG8_LDB(B0, 1, 0); PG8_SCHED; PG8_LDA(At, 1, 0); PG8_STAGE(PG8_SA(0, 1), a2 + hstep, voffA);
            PG8_WAIT_L(8); PG8_BAR; PG8_WAIT_L(0); PG8_MMA(0, 0, At, B0); PG8_BAR; PG8_SCHED;
            PG8_LDB(B1, 1, 1); PG8_STAGE(PG8_SB(1, 0), b3, voffB);
            PG8_BAR; PG8_WAIT_L(0); PG8_MMA(0, 1, At, B1); PG8_BAR;
            PG8_LDA(At, 1, 1); PG8_STAGE(PG8_SA(1, 0), a3, voffA);
            PG8_BAR; PG8_WAIT_L(0); PG8_MMA(1, 0, At, B0); PG8_BAR; PG8_SCHED;
            PG8_STAGE(PG8_SB(1, 1), b3 + hstep, voffB);
            PG8_WAIT_V(6); PG8_BAR; PG8_MMA(1, 1, At, B1); PG8_BAR;
            }
        }
        if constexpr (ALIGN_EPI) { if (wr == 0) PG8_BAR; }
        if constexpr (!Epi::AFTER_DRAIN) { E(acc, cur, wr, wc, fr, fq); S.done(cur); }
        if (!has_next) break;
#pragma unroll
        for (int a = 0; a < 2; ++a)
#pragma unroll
            for (int b = 0; b < 2; ++b)
#pragma unroll
                for (int m = 0; m < 4; ++m)
#pragma unroll
                    for (int n = 0; n < 2; ++n) acc[a][b][m][n] = (f32x4){0.f, 0.f, 0.f, 0.f};
        cur = nxt; cA = nA; cB = nB; ++ui;
        if constexpr (ALIGN_EPI) { if (wr == 1) PG8_BAR; }
    }
    PG8_WAIT_V(0);
    if constexpr (!ALIGN_EPI) { if (wr == 0) PG8_BAR; }
    PG8_BAR;
#undef PG8_SA
#undef PG8_SB
#undef PG8_STAGE
#undef PG8_LDA
#undef PG8_LDB
#undef PG8_MMA
#undef PG8_WAIT_V
#undef PG8_WAIT_L
#undef PG8_BAR
#undef PG8_SCHED
}
}

constexpr int NWAVES = 8, NTHR = 512;
constexpr int BATCH = 2, SEQ = 8192, D = 2048, M = BATCH * SEQ, CTXL = 256, MC = BATCH * CTXL;
constexpr int RW = 1024, NH = 8, DH = 128, CCH = 1024, INW = 7168, DFF = 5632, NUP = 2 * DFF, NCHK = 64, CHK = 128;
constexpr int NMOD = 6 * D;
constexpr float EPS = 1e-6f;
constexpr float KSCALE = 0.08838834764831845f;
constexpr int NSL = 8;

constexpr size_t MiB = 1u << 20;
constexpr size_t WS_CTL = 0, CTL_ZERO_BYTES = 1 * MiB;
constexpr size_t WS_COS = 1 * MiB, WS_SIN = WS_COS + 16384, WS_PW = WS_COS + 32768, WS_MODF = WS_COS + 65536, WS_MUL2 = WS_COS + 212992, WS_BIAS2 = WS_COS + 229376, WS_MODP = WS_COS + 524288;
constexpr int PWS = 260;
constexpr size_t WS_WOUT = 4 * MiB, WS_WUP = 12 * MiB, WS_WDN = 56 * MiB, WS_XN = 78 * MiB, WS_HC = 142 * MiB, WS_KVC = 144 * MiB, WS_BIG = 146 * MiB;
constexpr size_t WS_P = WS_BIG, WS_CAT = WS_BIG + 224 * MiB, WS_WIN = WS_CAT  , WS_UA = WS_BIG, WS_UB = WS_BIG + 176 * MiB;
constexpr size_t WS_SPV = WS_BIG + 288 * MiB;
constexpr size_t WS_CTXS = WS_BIG + 352 * MiB;
constexpr size_t WS_ROWSS = WS_CTXS + 4 * MiB;
constexpr size_t WS_END = WS_ROWSS + 2 * MiB;
static_assert(WS_MODP + (size_t)NSL * 3 * NMOD * 4 <= WS_WOUT && WS_BIAS2 + 2 * (size_t)NUP * 4 <= WS_MODP && WS_MUL2 + 2 * D * 4 <= WS_BIAS2 && WS_MODF + 3 * (size_t)NMOD * 4 <= WS_MUL2, "tables");
constexpr int CW_BAR = 4096;

constexpr int LDS_BYTES = 147456;
constexpr int MISC_OFF = LDS_BYTES - 256;

#define GAS __attribute__((address_space(1)))
#define LAS __attribute__((address_space(3)))
typedef unsigned short bf16;
typedef unsigned v4u __attribute__((ext_vector_type(4)));
typedef unsigned v2u __attribute__((ext_vector_type(2)));
typedef float f32x4 __attribute__((ext_vector_type(4)));
typedef GAS unsigned gu32;
#define LDS_WAIT() asm volatile("s_waitcnt lgkmcnt(0)" ::: "memory")
#define VM_WAIT() asm volatile("s_waitcnt vmcnt(0)" ::: "memory")
__device__ __forceinline__ unsigned f2bf(float f) { unsigned u = __builtin_bit_cast(unsigned, f); return (u + 0x7fffu + ((u >> 16) & 1u)) >> 16; }
__device__ __forceinline__ unsigned pk2(float lo, float hi) { return f2bf(lo) | (f2bf(hi) << 16); }
__device__ __forceinline__ float bflo(unsigned w) { return __builtin_bit_cast(float, w << 16); }
__device__ __forceinline__ float bfhi(unsigned w) { return __builtin_bit_cast(float, w & 0xffff0000u); }
__device__ __forceinline__ float bf1(bf16 h) { return __builtin_bit_cast(float, ((unsigned)h) << 16); }
__device__ __forceinline__ float silu_f(float x) { return x / (1.f + __expf(-x)); }
__device__ __forceinline__ float wave_sum(float v) {
#pragma unroll
    for (int o = 1; o < 64; o <<= 1) v += __shfl_xor(v, o);
    return v;
}


typedef short s16x4 __attribute__((ext_vector_type(4)));
typedef short bf16x8 __attribute__((ext_vector_type(8)));
__device__ __forceinline__ unsigned off_b(unsigned row, unsigned ch) { return 256u * row + 16u * (ch ^ (((row & 3u) << 2) | ((row >> 2) & 3u))); }
__device__ __forceinline__ s16x4 tr_rd(LAS unsigned char* p) { return __builtin_bit_cast(s16x4, __builtin_amdgcn_ds_read_tr16_b64_v4i16((LAS s16x4*)p)); }
__device__ __forceinline__ bf16x8 tr_frag(LAS unsigned char* img, unsigned lane, unsigned Ra, unsigned Rb, unsigned c) {
    const unsigned q = (lane & 15u) >> 2, p = lane & 3u;
    const s16x4 lo = tr_rd(img + off_b(Ra + q, 2u * c + (p >> 1)) + 8u * (p & 1u));
    const s16x4 hi = tr_rd(img + off_b(Rb + q, 2u * c + (p >> 1)) + 8u * (p & 1u));
    return __builtin_shufflevector(lo, hi, 0, 1, 2, 3, 4, 5, 6, 7);
}
__device__ __forceinline__ bf16x8 row_frag(LAS unsigned char* img, unsigned lane, unsigned rb, unsigned s_) { return *(const LAS bf16x8*)(img + off_b(16u * rb + (lane & 15u), 4u * s_ + (lane >> 4))); }
__device__ __forceinline__ v4u scale_pk8(v4u q, float w) { v4u o; o.x = pk2(bflo(q.x) * w, bfhi(q.x) * w); o.y = pk2(bflo(q.y) * w, bfhi(q.y) * w); o.z = pk2(bflo(q.z) * w, bfhi(q.z) * w); o.w = pk2(bflo(q.w) * w, bfhi(q.w) * w); return o; }

#define XB_TMO      128
#define XB_XCNT(j)  (256  + 64 * (j))
#define XB_XSUB(j)  (1280 + 64 * (j))
#define XB_XGEN(j)  (2304 + 64 * (j))
#define XB_TOP      3328
#define XB_TOPGEN   3392
#define XCD_BAR_WORDS 3456
#define XB_SPIN_CAP (1u << 18)
__device__ __forceinline__ unsigned xb_ld(unsigned* p)              { return __hip_atomic_load(p, __ATOMIC_RELAXED, __HIP_MEMORY_SCOPE_AGENT); }
__device__ __forceinline__ unsigned xb_add(unsigned* p, unsigned v) { return __hip_atomic_fetch_add(p, v, __ATOMIC_RELAXED, __HIP_MEMORY_SCOPE_AGENT); }
__device__ __forceinline__ unsigned xb_xcc_id() { return (unsigned)__builtin_amdgcn_s_getreg((3 << 11) | 20) & 0xFu; }
#define XB_SPIN(cond, bar) do { unsigned _sp = 0; while (cond) { __builtin_amdgcn_s_sleep(1); \
    if ((++_sp & 255u) == 0u) { if (xb_ld(&(bar)[XB_TMO])) break; if (_sp > XB_SPIN_CAP) { atomicAdd(&(bar)[XB_TMO], 1u); break; } } } } while (0)
struct XcdBarrier { unsigned* bar; unsigned x; volatile LAS unsigned* st; };
__device__ __forceinline__ XcdBarrier xcd_barrier_post(unsigned* bar, volatile LAS unsigned* st) {
    XcdBarrier b; b.bar = bar; b.x = xb_xcc_id(); b.st = st;
    if (threadIdx.x == 0) (void)xb_add(&bar[XB_XCNT(b.x)], 1u);
    return b;
}
__device__ __forceinline__ void xcd_barrier_complete(unsigned* bar, unsigned x, unsigned& nloc, unsigned& nx) {
    const unsigned G = gridDim.x * gridDim.y * gridDim.z;
    unsigned sum, cnt, mine, sp = 0u;
    for (;;) {
        sum = 0u; cnt = 0u; mine = 0u;
#pragma unroll
        for (unsigned j = 0; j < 16; ++j) { const unsigned c = xb_ld(&bar[XB_XCNT(j)]); sum += c; cnt += (c > 0u) ? 1u : 0u; mine = (j == x) ? c : mine; }
        if (sum == G) break;
        __builtin_amdgcn_s_sleep(1);
        if ((++sp & 255u) == 0u) { if (xb_ld(&bar[XB_TMO])) break; if (sp > XB_SPIN_CAP) { atomicAdd(&bar[XB_TMO], 1u); break; } }
    }
    nloc = mine > 0u ? mine : 1u; nx = cnt > 0u ? cnt : 1u;
}
__device__ __forceinline__ void xcd_barrier(const XcdBarrier& b) {
    asm volatile("s_waitcnt vmcnt(0)" ::: "memory");
    __syncthreads();
    if (threadIdx.x == 0) {
        unsigned* bar = b.bar;
        __builtin_amdgcn_s_waitcnt(0);
        unsigned nloc = b.st[0], nx = b.st[1];
        if (nloc == 0u) { xcd_barrier_complete(bar, b.x, nloc, nx); b.st[0] = nloc; b.st[1] = nx; }
        const unsigned old = xb_add(&bar[XB_XSUB(b.x)], 1u);
        const unsigned gen = old / nloc;
        if (old + 1u == (gen + 1u) * nloc) {
            __builtin_amdgcn_fence(__ATOMIC_RELEASE, "agent");
            asm volatile("s_waitcnt vmcnt(0)" ::: "memory");
            const unsigned og = xb_add(&bar[XB_TOP], 1u);
            const unsigned tg = og / nx;
            if (og + 1u == (tg + 1u) * nx) xb_add(&bar[XB_TOPGEN], 1u);
            else XB_SPIN(xb_ld(&bar[XB_TOPGEN]) == tg, bar);
            __builtin_amdgcn_fence(__ATOMIC_ACQUIRE, "agent");
            xb_add(&bar[XB_XGEN(b.x)], 1u);
            asm volatile("s_waitcnt vmcnt(0)" ::: "memory");
        } else {
            XB_SPIN(xb_ld(&bar[XB_XGEN(b.x)]) == gen, bar);
            __builtin_amdgcn_fence(__ATOMIC_ACQUIRE, "agent");
            asm volatile("s_waitcnt vmcnt(0)" ::: "memory");
        }
    }
    __syncthreads();
}

struct Args { const float* in[18]; float* out; unsigned char* ws; int ph_lo, ph_hi; };
enum { IN_X = 0, IN_C, IN_CTX, IN_CCTX, IN_WMOD, IN_BMOD, IN_G1, IN_WIN, IN_DECF, IN_DECB, IN_CONVW, IN_WOUT, IN_G2, IN_WUP, IN_FCW, IN_FCB, IN_WDN, IN_GF };
enum { PH_PRO = 0, PH_NORM1, PH_GEMM_IN, PH_KV, PH_SCAN, PH_RETOUT, PH_GEMM_OUT, PH_NORM2, PH_GEMM_UP, PH_GATE, PH_GEMM_DN, PH_FNORM, NPH };

template <bool PERMQK>
__device__ __forceinline__ void p0_transpose_item(const float* W, int K, int N, bf16* WT, LAS float* scr, int item, int lane) {
    const int nblk = N / 64, kb = item / nblk, nb = item % nblk, k0 = 64 * kb, n0 = 64 * nb;
    f32x4 v[16];
#pragma unroll
    for (int i = 0; i < 16; ++i) v[i] = *(const f32x4*)(W + (size_t)(k0 + 4 * i + (lane >> 4)) * N + n0 + 4 * (lane & 15));
#pragma unroll
    for (int i = 0; i < 16; ++i) { LAS float* d = scr + (4 * i + (lane >> 4)) * 65 + 4 * (lane & 15); d[0] = v[i].x; d[1] = v[i].y; d[2] = v[i].z; d[3] = v[i].w; }
    LDS_WAIT(); asm volatile("" ::: "memory");
    const int c = lane & 7;
#pragma unroll
    for (int j = 0; j < 8; ++j) { const int n = (lane >> 3) + 8 * j; const LAS float* s = scr + (8 * c) * 65 + n;
        v4u o; o.x = pk2(s[0 * 65], s[1 * 65]); o.y = pk2(s[2 * 65], s[3 * 65]); o.z = pk2(s[4 * 65], s[5 * 65]); o.w = pk2(s[6 * 65], s[7 * 65]);
        int ng = n0 + n;
        if (PERMQK) { if (ng < 2 * RW) ng = (ng & ~63) + 2 * (ng & 31) + ((ng >> 5) & 1); }
        *(GAS v4u*)(WT + (size_t)ng * K + k0 + 8 * c) = o; }
    LDS_WAIT(); asm volatile("" ::: "memory");
}

__device__ __forceinline__ void norm_row_bf16(const float* xrow, bf16* orow, const LAS float* mulT, const LAS float* addT, int lane) {
    const GAS f32x4* xr = (const GAS f32x4*)xrow + lane;
    f32x4 v[8]; float s = 0.f;
#pragma unroll
    for (int j = 0; j < 8; ++j) { v[j] = xr[64 * j]; s += (v[j].x * v[j].x + v[j].y * v[j].y) + (v[j].z * v[j].z + v[j].w * v[j].w); }
    const float rstd = rsqrtf(wave_sum(s) * (1.f / D) + EPS);
    GAS v2u* o8 = (GAS v2u*)orow + lane;
#pragma unroll
    for (int j = 0; j < 8; ++j) { const f32x4 mu = *(const LAS f32x4*)(mulT + 4 * (lane + 64 * j)), ad = *(const LAS f32x4*)(addT + 4 * (lane + 64 * j));
        const f32x4 y = v[j] * rstd * mu + ad; v2u w; w.x = pk2(y.x, y.y); w.y = pk2(y.z, y.w); o8[64 * j] = w; }
}

__global__ void __launch_bounds__(NTHR, 2) fwd_kernel(Args args) {
    extern __shared__ __attribute__((aligned(16))) unsigned char lds_raw[];
    LAS unsigned char* lds = (LAS unsigned char*)lds_raw;
    volatile LAS unsigned* MISC = (volatile LAS unsigned*)(lds + MISC_OFF);
    const int tid = threadIdx.x, lane = tid & 63, wave = __builtin_amdgcn_readfirstlane(tid >> 6);
    const int G = gridDim.x, bx = blockIdx.x;
    const int gw = bx * NWAVES + wave, NGW = G * NWAVES;
    const int gtid = bx * NTHR + tid, NGT = G * NTHR;
    unsigned char* ws = args.ws;
    const float* x = args.in[IN_X]; float* out = args.out;
    float* COS = (float*)(ws + WS_COS); float* SIN = (float*)(ws + WS_SIN); float* PW = (float*)(ws + WS_PW);
    float* MODF = (float*)(ws + WS_MODF); float* MODP = (float*)(ws + WS_MODP); float* MUL2 = (float*)(ws + WS_MUL2); float* BIAS2 = (float*)(ws + WS_BIAS2); float* ROWSS = (float*)(ws + WS_ROWSS);
    bf16* WIN_T = (bf16*)(ws + WS_WIN); bf16* WOUT_T = (bf16*)(ws + WS_WOUT); bf16* WUP_T = (bf16*)(ws + WS_WUP); bf16* WDN_T = (bf16*)(ws + WS_WDN);
    bf16* XN = (bf16*)(ws + WS_XN); bf16* HC = (bf16*)(ws + WS_HC); bf16* KVC = (bf16*)(ws + WS_KVC);
    bf16* P = (bf16*)(ws + WS_P); bf16* CAT = (bf16*)(ws + WS_CAT); bf16* UA = (bf16*)(ws + WS_UA); bf16* UB = (bf16*)(ws + WS_UB);
    float* CTXS = (float*)(ws + WS_CTXS); bf16* SPV = (bf16*)(ws + WS_SPV);
    bf16* KVS = (bf16*)out;

    if (tid < 64) MISC[tid] = 0u;
    __syncthreads();
#if ONE_LAUNCH
    XcdBarrier bar = xcd_barrier_post((unsigned*)(ws + WS_CTL) + CW_BAR, MISC + 8);
#define GRID_BAR() xcd_barrier(bar)
#else
#define GRID_BAR() do {} while (0)
#endif
    const int lo = args.ph_lo, hi = args.ph_hi;
#ifndef PHMASK
#define PHMASK 0xFFF
#endif
#define IN(k) (((PHMASK >> (k)) & 1) && lo <= (k) && (k) < hi)
#define BOTH(k) (IN(k) && IN((k) + 1))
#ifndef REP_MASK
#define REP_MASK 0
#endif
#define REPS(k) ((((REP_MASK) >> (k)) & 1) + 1)
#ifndef GEMM_REP_SEL
#define GEMM_REP_SEL 0
#endif
#define GEMM_REP_ID 15

    if (IN(PH_PRO)) {
      for (int rep_ = 0; rep_ < REPS(PH_PRO); ++rep_) {
        LAS float* scr = (LAS float*)(lds + wave * 16640);
        constexpr int I_IN = (D / 64) * (INW / 64), I_OUT = (D / 64) * (D / 64), I_UP = (D / 64) * (NUP / 64), I_DN = (DFF / 64) * (D / 64), I_GV = NSL * (NMOD / 256);
        constexpr int NIT = I_IN + I_OUT + I_UP + I_DN + I_GV;
        for (int it = gw; it < NIT; it += NGW) {
            int r = it;
            if (r < I_IN) { p0_transpose_item<true>(args.in[IN_WIN], D, INW, WIN_T, scr, r, lane); continue; } r -= I_IN;
            if (r < I_OUT) { p0_transpose_item<false>(args.in[IN_WOUT], D, D, WOUT_T, scr, r, lane); continue; } r -= I_OUT;
            if (r < I_UP) { p0_transpose_item<false>(args.in[IN_WUP], D, NUP, WUP_T, scr, r, lane); continue; } r -= I_UP;
            if (r < I_DN) { p0_transpose_item<false>(args.in[IN_WDN], DFF, D, WDN_T, scr, r, lane); continue; } r -= I_DN;
            {
                const int s = r / (NMOD / 256), cgp = r % (NMOD / 256), col = cgp * 256 + lane * 4;
                f32x4 a0 = (f32x4){0.f, 0.f, 0.f, 0.f}, a1 = a0, a2 = a0;
                for (int kb = 0; kb < 4; ++kb) {
                    const int kbase = s * 256 + kb * 64;
                    const float c0 = silu_f(args.in[IN_C][kbase + lane]), c1 = silu_f(args.in[IN_C][D + kbase + lane]), c2 = silu_f(args.in[IN_CCTX][kbase + lane]);
                    const float* wp = args.in[IN_WMOD] + (size_t)kbase * NMOD + col;
#pragma unroll 8
                    for (int kk = 0; kk < 64; ++kk) {
                        const f32x4 w = *(const f32x4*)(wp + (size_t)kk * NMOD);
                        const float b0 = __shfl(c0, kk), b1 = __shfl(c1, kk), b2 = __shfl(c2, kk);
                        a0 += w * b0; a1 += w * b1; a2 += w * b2;
                    }
                }
                *(f32x4*)(MODP + ((size_t)(s * 3 + 0)) * NMOD + col) = a0;
                *(f32x4*)(MODP + ((size_t)(s * 3 + 1)) * NMOD + col) = a1;
                *(f32x4*)(MODP + ((size_t)(s * 3 + 2)) * NMOD + col) = a2;
            }
        }
        if (gtid < 4096) { const int pos = gtid >> 5, i = gtid & 31; const float fr = powf(10000.f, -(float)i / 32.f); const float ang = (float)pos * fr; COS[gtid] = cosf(ang); SIN[gtid] = sinf(ang); }
        else if (gtid < 4096 + 2 * NH * 257) { const int idx = gtid - 4096, dir = idx / (NH * 257), h = (idx / 257) % NH, k = idx % 257;
            const float lg0 = args.in[dir ? IN_DECB : IN_DECF][h]; const float lg = fminf(lg0, 0.f) - log1pf(expf(-fabsf(lg0)));
            PW[(dir * NH + h) * PWS + k] = expf(lg * (float)k); }
      }
        if (BOTH(PH_PRO)) GRID_BAR();
    }

    if (IN(PH_NORM1)) {
      for (int rep_ = 0; rep_ < REPS(PH_NORM1); ++rep_) {
        LAS float* mulT = (LAS float*)lds;
        LAS float* addT = (LAS float*)(lds + 3 * D * 4);
        for (int i = tid; i < 3 * D; i += NTHR) { const int r = i / D, k = i % D;
            float sh = args.in[IN_BMOD][k], sc = args.in[IN_BMOD][D + k];
#pragma unroll
            for (int s = 0; s < NSL; ++s) { sh += MODP[(size_t)(s * 3 + r) * NMOD + k]; sc += MODP[(size_t)(s * 3 + r) * NMOD + D + k]; }
            mulT[i] = args.in[IN_G1][k] * (1.f + sc); addT[i] = sh; }
        for (int i = gtid; i < 3 * NMOD; i += NGT) { const int r = i / NMOD, col = i % NMOD; float a = args.in[IN_BMOD][col];
#pragma unroll
            for (int s = 0; s < NSL; ++s) a += MODP[(size_t)(s * 3 + r) * NMOD + col];
            MODF[i] = a; }
        LAS float* sh2T = (LAS float*)(lds + 6 * D * 4);
        for (int i = tid; i < 2 * D; i += NTHR) { const int r = i / D, k = i % D; float sh = args.in[IN_BMOD][3 * D + k];
#pragma unroll
            for (int s = 0; s < NSL; ++s) sh += MODP[(size_t)(s * 3 + r) * NMOD + 3 * D + k];
            sh2T[i] = sh; }
        if (gtid < 2 * D) { const int r = gtid / D, k = gtid % D; float sc = args.in[IN_BMOD][4 * D + k];
#pragma unroll
            for (int s = 0; s < NSL; ++s) sc += MODP[(size_t)(s * 3 + r) * NMOD + 4 * D + k];
            MUL2[gtid] = args.in[IN_G2][k] * (1.f + sc); }
        __syncthreads();
        for (int col = gw; col < NUP; col += NGW) {
            const bf16* wrow = WUP_T + (size_t)col * D; float s0 = 0.f, s1 = 0.f;
#pragma unroll
            for (int j = 0; j < 4; ++j) { const int k0 = 8 * (lane + 64 * j); const v4u wq = *(const GAS v4u*)(wrow + k0);
                const float wv[8] = {bflo(wq.x), bfhi(wq.x), bflo(wq.y), bfhi(wq.y), bflo(wq.z), bfhi(wq.z), bflo(wq.w), bfhi(wq.w)};
                const f32x4 a0 = *(const LAS f32x4*)(sh2T + k0), a1 = *(const LAS f32x4*)(sh2T + k0 + 4), c0 = *(const LAS f32x4*)(sh2T + D + k0), c1 = *(const LAS f32x4*)(sh2T + D + k0 + 4);
                s0 += (wv[0] * a0.x + wv[1] * a0.y) + (wv[2] * a0.z + wv[3] * a0.w) + (wv[4] * a1.x + wv[5] * a1.y) + (wv[6] * a1.z + wv[7] * a1.w);
                s1 += (wv[0] * c0.x + wv[1] * c0.y) + (wv[2] * c0.z + wv[3] * c0.w) + (wv[4] * c1.x + wv[5] * c1.y) + (wv[6] * c1.z + wv[7] * c1.w); }
            s0 = wave_sum(s0); s1 = wave_sum(s1);
            if (lane == 0) { BIAS2[col] = s0; BIAS2[NUP + col] = s1; }
        }
        for (int m = gw; m < M + MC; m += NGW) {
            if (m < M) { const int b = m >> 13; norm_row_bf16(x + (size_t)m * D, XN + (size_t)m * D, mulT + b * D, addT + b * D, lane); }
            else { const int mc = m - M; norm_row_bf16(args.in[IN_CTX] + (size_t)mc * D, HC + (size_t)mc * D, mulT + 2 * D, addT + 2 * D, lane); }
        }
      }
        if (BOTH(PH_NORM1)) GRID_BAR();
    }

    if (IN(PH_GEMM_IN)) {
      {
        __syncthreads();
        { pg8::Gemm g{XN, WIN_T, M, INW, D}; pg8::StaticOrder S; S.init(M, INW, G, bx);
          pg8::EpiBf16R E{P, INW, 0, 0, COS, SIN, 8, 4, 8, KSCALE};
          pg8::gemm_phase<pg8::EpiBf16R, pg8::StaticOrder, GP_ALIGN, GP_SP2>(lds, g, S, E);
          if (REPS(GEMM_REP_ID) == 2 && GEMM_REP_SEL == __LINE__) pg8::gemm_phase<pg8::EpiBf16R, pg8::StaticOrder, GP_ALIGN, GP_SP2>(lds, g, S, E);
          if (GEMM_REP_SEL == 9001) { pg8::EpiNull EN; pg8::gemm_phase<pg8::EpiNull, pg8::StaticOrder, GP_ALIGN, GP_SP2>(lds, g, S, EN); }
          if (GEMM_REP_SEL == 9002) { pg8::EpiNull EN; pg8::SameTileOrder S2; S2.init(M, INW, G, bx); pg8::gemm_phase<pg8::EpiNull, pg8::SameTileOrder, GP_ALIGN, GP_SP2>(lds, g, S2, EN); } }
        { pg8::Gemm g{HC, WIN_T + (size_t)RW * D, MC, 2 * RW, D}; pg8::StaticOrder S; S.init(MC, 2 * RW, G, bx);
          pg8::EpiBf16R E{KVC, 2 * RW, 0, 0, COS, SIN, 0, 0, 4, KSCALE};
          pg8::gemm_phase<pg8::EpiBf16R, pg8::StaticOrder, GP_ALIGN, GP_SP2>(lds, g, S, E);
          if (REPS(GEMM_REP_ID) == 2 && GEMM_REP_SEL == __LINE__) pg8::gemm_phase<pg8::EpiBf16R, pg8::StaticOrder, GP_ALIGN, GP_SP2>(lds, g, S, E); }
      }
        if (BOTH(PH_GEMM_IN)) GRID_BAR();
    }

    if (IN(PH_KV)) {
      for (int rep_ = 0; rep_ < REPS(PH_KV); ++rep_) {
        __syncthreads();
        LAS unsigned char* Kimg = lds; LAS unsigned char* Vfimg = lds + 32768; LAS unsigned char* Vbimg = lds + 65536;
        for (int item = bx; item < BATCH * NH * NCHK + BATCH * NH * 2; item += G) {
            const bf16* kptr; const bf16* vptr; size_t stride; int wfo, wbo, h; size_t ooff; bool ctxi;
            if (item < BATCH * NH * NCHK) { const int b = item >> 9, ch = item & 63; h = (item >> 6) & 7;
                kptr = P + ((size_t)b * SEQ + (size_t)ch * CHK) * INW + RW + h * DH; vptr = kptr + RW; stride = INW; wfo = 127; wbo = 0;
                ooff = ((((size_t)b * NH + h) * NCHK + ch) * DH) * DH; ctxi = false; }
            else { const int r = item - BATCH * NH * NCHK, b = r >> 4, c = r & 1; h = (r >> 1) & 7;
                kptr = KVC + ((size_t)b * CTXL + (size_t)c * CHK) * (2 * RW) + h * DH; vptr = kptr + RW; stride = 2 * RW; wfo = CTXL - 1 - CHK * c; wbo = CHK * c;
                ooff = ((((size_t)b * NH + h) * 2 + c) * DH) * DH; ctxi = true; }
            const float* pwf = PW + (0 * NH + h) * PWS; const float* pwb = PW + (1 * NH + h) * PWS;
#pragma unroll
            for (int i = 0; i < 4; ++i) { const int p = tid + NTHR * i, row = p >> 4, c16 = p & 15;
                const v4u kq = *(const GAS v4u*)(kptr + (size_t)row * stride + c16 * 8);
                const v4u vq = *(const GAS v4u*)(vptr + (size_t)row * stride + c16 * 8);
                const float wf = pwf[wfo - row], wb = pwb[wbo + row];
                const unsigned o = off_b(row, c16);
                *(LAS v4u*)(Kimg + o) = kq; *(LAS v4u*)(Vfimg + o) = scale_pk8(vq, wf); *(LAS v4u*)(Vbimg + o) = scale_pk8(vq, wb); }
            __syncthreads();
            {
                const unsigned g4 = lane >> 4, fr = lane & 15; const int dkg = wave >> 1, dvh = wave & 1;
                f32x4 accf[4][2], accb[4][2];
#pragma unroll
                for (int mt = 0; mt < 4; ++mt)
#pragma unroll
                    for (int nt = 0; nt < 2; ++nt) { accf[mt][nt] = (f32x4){0.f, 0.f, 0.f, 0.f}; accb[mt][nt] = (f32x4){0.f, 0.f, 0.f, 0.f}; }
#pragma unroll
                for (int ks = 0; ks < 4; ++ks) {
                    bf16x8 kf[2];
#pragma unroll
                    for (int nt = 0; nt < 2; ++nt) kf[nt] = tr_frag(Kimg, lane, 32 * ks + 8 * g4, 32 * ks + 8 * g4 + 4, 2 * dkg + nt);
#pragma unroll
                    for (int mt = 0; mt < 4; ++mt) {
                        const bf16x8 vf = tr_frag(Vfimg, lane, 32 * ks + 8 * g4, 32 * ks + 8 * g4 + 4, 4 * dvh + mt);
                        const bf16x8 vb = tr_frag(Vbimg, lane, 32 * ks + 8 * g4, 32 * ks + 8 * g4 + 4, 4 * dvh + mt);
#pragma unroll
                        for (int nt = 0; nt < 2; ++nt) { accf[mt][nt] = __builtin_amdgcn_mfma_f32_16x16x32_bf16(vf, kf[nt], accf[mt][nt], 0, 0, 0); accb[mt][nt] = __builtin_amdgcn_mfma_f32_16x16x32_bf16(vb, kf[nt], accb[mt][nt], 0, 0, 0); }
                    }
                }
#pragma unroll
                for (int mt = 0; mt < 4; ++mt)
#pragma unroll
                    for (int nt = 0; nt < 2; ++nt) { const size_t o = ooff + (size_t)(16 * (2 * dkg + nt) + fr) * DH + 16 * (4 * dvh + mt) + 4 * g4;
                        if (ctxi) { *(f32x4*)(CTXS + o) = accf[mt][nt]; *(f32x4*)(CTXS + (size_t)BATCH * NH * 2 * DH * DH + o) = accb[mt][nt]; }
                        else { v2u wf_, wb_; wf_.x = pk2(accf[mt][nt].x, accf[mt][nt].y); wf_.y = pk2(accf[mt][nt].z, accf[mt][nt].w); wb_.x = pk2(accb[mt][nt].x, accb[mt][nt].y); wb_.y = pk2(accb[mt][nt].z, accb[mt][nt].w);
                            *(GAS v2u*)(KVS + o) = wf_; *(GAS v2u*)(KVS + (size_t)BATCH * NH * NCHK * DH * DH + o) = wb_; } }
            }
            __syncthreads();
        }
        for (int item = bx; item < M / 64; item += G) {
            const int c8 = tid & 127, tg = tid >> 7;
            const size_t n0 = (size_t)item * 64 + tg * 16;
            const float* cw = args.in[IN_CONVW];
            float w0[8], w1[8], w2[8];
#pragma unroll
            for (int e = 0; e < 8; ++e) { w0[e] = cw[c8 * 8 + e]; w1[e] = cw[CCH + c8 * 8 + e]; w2[e] = cw[2 * CCH + c8 * 8 + e]; }
            float pv[8], cv[8], nv[8];
            auto ldch = [&](size_t n, float* o) { const v4u cq = *(const GAS v4u*)(P + n * INW + 5 * RW + c8 * 8), hq = *(const GAS v4u*)(P + n * INW + 6 * RW + c8 * 8);
                o[0] = bflo(cq.x) * bflo(hq.x); o[1] = bfhi(cq.x) * bfhi(hq.x); o[2] = bflo(cq.y) * bflo(hq.y); o[3] = bfhi(cq.y) * bfhi(hq.y);
                o[4] = bflo(cq.z) * bflo(hq.z); o[5] = bfhi(cq.z) * bfhi(hq.z); o[6] = bflo(cq.w) * bflo(hq.w); o[7] = bfhi(cq.w) * bfhi(hq.w); };
            if (tg > 0) ldch(n0 - 1, pv); else {
#pragma unroll
                for (int e = 0; e < 8; ++e) pv[e] = 0.f; }
            ldch(n0, cv);
            for (int t = 0; t < 16; ++t) {
                const size_t n = n0 + t;
                if ((n & 63) != 63) ldch(n + 1, nv); else {
#pragma unroll
                    for (int e = 0; e < 8; ++e) nv[e] = 0.f; }
                const v4u bq = *(const GAS v4u*)(P + n * INW + 4 * RW + c8 * 8);
                float bb[8] = {bflo(bq.x), bfhi(bq.x), bflo(bq.y), bfhi(bq.y), bflo(bq.z), bfhi(bq.z), bflo(bq.w), bfhi(bq.w)};
                float o[8];
#pragma unroll
                for (int e = 0; e < 8; ++e) { o[e] = bb[e] * (w0[e] * pv[e] + w1[e] * cv[e] + w2[e] * nv[e]); pv[e] = cv[e]; cv[e] = nv[e]; }
                v4u w; w.x = pk2(o[0], o[1]); w.y = pk2(o[2], o[3]); w.z = pk2(o[4], o[5]); w.w = pk2(o[6], o[7]);
                *(GAS v4u*)(CAT + n * D + RW + c8 * 8) = w;
            }
        }
      }
        if (BOTH(PH_KV)) GRID_BAR();
    }

    if (IN(PH_SCAN)) {
      for (int rep_ = 0; rep_ < REPS(PH_SCAN); ++rep_) {
        for (int e4 = gtid; e4 < 2 * BATCH * NH * DH * DH / 4; e4 += NGT) {
            const int dv4 = e4 & 31, dk = (e4 >> 5) & 127, h = (e4 >> 12) & 7, b = (e4 >> 15) & 1, dir = e4 >> 16;
            const float* pw = PW + (dir * NH + h) * PWS;
            const float* c0 = CTXS + ((((size_t)(dir * BATCH + b) * NH + h) * 2 + 0) * DH) * DH + (size_t)dk * DH + dv4 * 4;
            f32x4 s = *(const f32x4*)c0 + *(const f32x4*)(c0 + (size_t)DH * DH);
            const float cd = pw[CHK];
            const size_t boff = (((size_t)(dir * BATCH + b) * NH + h) * NCHK) * DH * DH + (size_t)dk * DH + dv4 * 4;
#pragma unroll 8
            for (int i = 0; i < NCHK; ++i) {
                const int n = dir ? (NCHK - 1 - i) : i;
                const v2u tq = *(const GAS v2u*)(KVS + boff + (size_t)n * DH * DH); const f32x4 t = (f32x4){bflo(tq.x), bfhi(tq.x), bflo(tq.y), bfhi(tq.y)};
                v2u w; w.x = pk2(s.x, s.y); w.y = pk2(s.z, s.w);
                *(GAS v2u*)(SPV + boff + (size_t)n * DH * DH) = w;
                s = s * cd + t;
            }
        }
      }
        if (BOTH(PH_SCAN)) GRID_BAR();
    }

    if (IN(PH_RETOUT)) {
      for (int rep_ = 0; rep_ < REPS(PH_RETOUT); ++rep_) {
        __syncthreads();
        LAS unsigned char* Qi = lds; LAS unsigned char* Ki = lds + 32768; LAS unsigned char* Vi = lds + 65536; LAS unsigned char* Si = lds + 98304;
        LAS float* pwl = (LAS float*)(lds + 131072);
        for (int item = bx; item < BATCH * NH * NCHK; item += G) {
            const int b = item >> 9, h = (item >> 6) & 7, ch = item & 63;
            const size_t tok0 = (size_t)b * SEQ + (size_t)ch * CHK;
            const bf16* qptr = P + tok0 * INW + h * DH;
            const bf16* sfp = SPV + ((((size_t)(0 * BATCH + b) * NH + h) * NCHK + ch) * DH) * DH;
            const bf16* sbp = SPV + ((((size_t)(1 * BATCH + b) * NH + h) * NCHK + ch) * DH) * DH;
            v4u sbq[4];
#pragma unroll
            for (int i = 0; i < 4; ++i) { const int p = tid + NTHR * i, row = p >> 4, c16 = p & 15; const unsigned o = off_b(row, c16);
                *(LAS v4u*)(Qi + o) = *(const GAS v4u*)(qptr + (size_t)row * INW + c16 * 8);
                *(LAS v4u*)(Ki + o) = *(const GAS v4u*)(qptr + (size_t)row * INW + RW + c16 * 8);
                *(LAS v4u*)(Vi + o) = *(const GAS v4u*)(qptr + (size_t)row * INW + 2 * RW + c16 * 8);
                *(LAS v4u*)(Si + o) = *(const GAS v4u*)(sfp + (size_t)row * DH + c16 * 8);
                sbq[i] = *(const GAS v4u*)(sbp + (size_t)row * DH + c16 * 8); }
            if (tid < 2 * 129) { const int dir = tid / 129, k = tid % 129; pwl[dir * 132 + k] = PW[(dir * NH + h) * PWS + k]; }
            __syncthreads();
            const unsigned g4 = lane >> 4, fr = lane & 15; const int i_in = 16 * wave + (int)fr;
            bf16x8 qf[4];
#pragma unroll
            for (int ks = 0; ks < 4; ++ks) qf[ks] = row_frag(Qi, lane, wave, ks);
            f32x4 sc[8];
#pragma unroll
            for (int jt = 0; jt < 8; ++jt) { sc[jt] = (f32x4){0.f, 0.f, 0.f, 0.f};
#pragma unroll
                for (int ks = 0; ks < 4; ++ks) sc[jt] = __builtin_amdgcn_mfma_f32_16x16x32_bf16(row_frag(Ki, lane, jt, ks), qf[ks], sc[jt], 0, 0, 0); }
            __syncthreads();
#pragma unroll
            for (int i = 0; i < 4; ++i) { const int p = tid + NTHR * i, row = p >> 4, c16 = p & 15; *(LAS v4u*)(Ki + off_b(row, c16)) = sbq[i]; }
            bf16x8 pf[4];
#pragma unroll
            for (int ks = 0; ks < 4; ++ks) {
                float pv[8];
#pragma unroll
                for (int hf = 0; hf < 2; ++hf)
#pragma unroll
                    for (int rg = 0; rg < 4; ++rg) { const int j = 16 * (2 * ks + hf) + 4 * (int)g4 + rg;
                        const float dm = (j <= i_in) ? pwl[i_in - j] : pwl[132 + (j - i_in)];
                        pv[4 * hf + rg] = sc[2 * ks + hf][rg] * dm; }
                v4u w; w.x = pk2(pv[0], pv[1]); w.y = pk2(pv[2], pv[3]); w.z = pk2(pv[4], pv[5]); w.w = pk2(pv[6], pv[7]);
                pf[ks] = __builtin_bit_cast(bf16x8, w);
            }
            f32x4 o[8];
#pragma unroll
            for (int nt = 0; nt < 8; ++nt) { o[nt] = (f32x4){0.f, 0.f, 0.f, 0.f};
#pragma unroll
                for (int ks = 0; ks < 4; ++ks) o[nt] = __builtin_amdgcn_mfma_f32_16x16x32_bf16(tr_frag(Vi, lane, 32 * ks + 4 * g4, 32 * ks + 16 + 4 * g4, nt), pf[ks], o[nt], 0, 0, 0); }
            {
                const float qd = pwl[i_in + 1]; bf16x8 qs[4];
#pragma unroll
                for (int ks = 0; ks < 4; ++ks) qs[ks] = __builtin_bit_cast(bf16x8, scale_pk8(__builtin_bit_cast(v4u, qf[ks]), qd));
#pragma unroll
                for (int nt = 0; nt < 8; ++nt)
#pragma unroll
                    for (int ks = 0; ks < 4; ++ks) o[nt] = __builtin_amdgcn_mfma_f32_16x16x32_bf16(tr_frag(Si, lane, 32 * ks + 8 * g4, 32 * ks + 8 * g4 + 4, nt), qs[ks], o[nt], 0, 0, 0);
            }
            __syncthreads();
            {
                const float qd = pwl[132 + (CHK - i_in)]; bf16x8 qs[4];
#pragma unroll
                for (int ks = 0; ks < 4; ++ks) qs[ks] = __builtin_bit_cast(bf16x8, scale_pk8(__builtin_bit_cast(v4u, qf[ks]), qd));
#pragma unroll
                for (int nt = 0; nt < 8; ++nt)
#pragma unroll
                    for (int ks = 0; ks < 4; ++ks) o[nt] = __builtin_amdgcn_mfma_f32_16x16x32_bf16(tr_frag(Ki, lane, 32 * ks + 8 * g4, 32 * ks + 8 * g4 + 4, nt), qs[ks], o[nt], 0, 0, 0);
            }
            {
                float ss = 0.f;
#pragma unroll
                for (int nt = 0; nt < 8; ++nt) ss += (o[nt].x * o[nt].x + o[nt].y * o[nt].y) + (o[nt].z * o[nt].z + o[nt].w * o[nt].w);
                ss += __shfl_xor(ss, 16); ss += __shfl_xor(ss, 32);
                const float rstd = rsqrtf(ss * (1.f / DH) + EPS);
                const bf16* gp = P + (tok0 + i_in) * INW + 3 * RW + h * DH + 4 * g4;
                bf16* op = CAT + (tok0 + i_in) * D + h * DH + 4 * g4;
#pragma unroll
                for (int nt = 0; nt < 8; ++nt) { const v2u gq = *(const GAS v2u*)(gp + 16 * nt);
                    v2u w; w.x = pk2(o[nt].x * rstd * silu_f(bflo(gq.x)), o[nt].y * rstd * silu_f(bfhi(gq.x))); w.y = pk2(o[nt].z * rstd * silu_f(bflo(gq.y)), o[nt].w * rstd * silu_f(bfhi(gq.y)));
                    *(GAS v2u*)(op + 16 * nt) = w; }
            }
            __syncthreads();
        }
      }
        if (BOTH(PH_RETOUT)) GRID_BAR();
    }

    if (IN(PH_GEMM_OUT)) {
      {
        __syncthreads();
        pg8::Gemm g{CAT, WOUT_T, M, D, D}; pg8::StaticOrder S; S.init(M, D, G, bx);
        pg8::EpiResNorm E{x, out, D, MODF + 2 * D, NMOD, MUL2, XN, ROWSS};
        pg8::gemm_phase<pg8::EpiResNorm, pg8::StaticOrder, GP_ALIGN, GP_SP2>(lds, g, S, E);
        if (REPS(GEMM_REP_ID) == 2 && GEMM_REP_SEL == __LINE__) pg8::gemm_phase<pg8::EpiResNorm, pg8::StaticOrder, GP_ALIGN, GP_SP2>(lds, g, S, E);
      }
        if (BOTH(PH_GEMM_OUT)) GRID_BAR();
    }

    if (IN(PH_GEMM_UP)) {
      {
        __syncthreads();
        pg8::Gemm g{XN, WUP_T, M, NUP, D}; pg8::StaticOrder S; S.init(M, NUP, G, bx);
        LAS float* rsl = (LAS float*)(lds + 131072);
        pg8::Unit u0; int pm0 = -1; if (S.next(0, u0)) pm0 = u0.pm;
        if (pm0 >= 0 && tid < 256) { const float* rp = ROWSS + ((size_t)pm0 * 256 + tid) * 32; float t = 0.f;
#pragma unroll
            for (int i = 0; i < 8; ++i) { const f32x4 q = *(const f32x4*)(rp + 4 * i); t += (q.x + q.y) + (q.z + q.w); }
            rsl[tid] = rsqrtf(t * (1.f / D) + EPS); }
        __syncthreads();
        pg8::EpiUp E{UA, DFF, DFF, (size_t)(WS_UB - WS_UA) / 2, BIAS2, NUP, rsl, pm0, ROWSS, 1.f / D, EPS};
        pg8::gemm_phase<pg8::EpiUp, pg8::StaticOrder, GP_ALIGN, GP_SP2>(lds, g, S, E);
        if (REPS(GEMM_REP_ID) == 2 && GEMM_REP_SEL == __LINE__) pg8::gemm_phase<pg8::EpiUp, pg8::StaticOrder, GP_ALIGN, GP_SP2>(lds, g, S, E);
      }
        if (BOTH(PH_GEMM_UP)) GRID_BAR();
    }

    if (IN(PH_GATE)) {
      for (int rep_ = 0; rep_ < REPS(PH_GATE); ++rep_) {
        const float* fw = args.in[IN_FCW]; const float* fb = args.in[IN_FCB];
        for (int idx = gtid; idx < M * (DFF / 8); idx += NGT) {
            const int n = idx / (DFF / 8), c8 = idx % (DFF / 8), grow = (n & (SEQ - 1)) >> 6;
            const size_t off = (size_t)n * DFF + c8 * 8;
            const v4u z = (v4u){0u, 0u, 0u, 0u};
            const v4u a0 = grow > 0 ? *(const GAS v4u*)(UA + off - (size_t)64 * DFF) : z;
            const v4u a1 = *(const GAS v4u*)(UA + off);
            const v4u a2 = grow < 127 ? *(const GAS v4u*)(UA + off + (size_t)64 * DFF) : z;
            const v4u bq = *(const GAS v4u*)(UB + off);
            const float A0[8] = {bflo(a0.x), bfhi(a0.x), bflo(a0.y), bfhi(a0.y), bflo(a0.z), bfhi(a0.z), bflo(a0.w), bfhi(a0.w)};
            const float A1[8] = {bflo(a1.x), bfhi(a1.x), bflo(a1.y), bfhi(a1.y), bflo(a1.z), bfhi(a1.z), bflo(a1.w), bfhi(a1.w)};
            const float A2[8] = {bflo(a2.x), bfhi(a2.x), bflo(a2.y), bfhi(a2.y), bflo(a2.z), bfhi(a2.z), bflo(a2.w), bfhi(a2.w)};
            const float BB[8] = {bflo(bq.x), bfhi(bq.x), bflo(bq.y), bfhi(bq.y), bflo(bq.z), bfhi(bq.z), bflo(bq.w), bfhi(bq.w)};
            float o[8];
#pragma unroll
            for (int e = 0; e < 8; ++e) { const int c = c8 * 8 + e; const float av = fw[c] * A0[e] + fw[DFF + c] * A1[e] + fw[2 * DFF + c] * A2[e] + fb[c]; o[e] = silu_f(av) * BB[e]; }
            v4u w; w.x = pk2(o[0], o[1]); w.y = pk2(o[2], o[3]); w.z = pk2(o[4], o[5]); w.w = pk2(o[6], o[7]);
            *(GAS v4u*)(UB + off) = w;
        }
      }
        if (BOTH(PH_GATE)) GRID_BAR();
    }

    if (IN(PH_GEMM_DN)) {
      {
        __syncthreads();
        pg8::Gemm g{UB, WDN_T, M, D, DFF}; pg8::StaticOrder S; S.init(M, D, G, bx);
        pg8::EpiRes E{out, out, D, MODF + 5 * D, NMOD};
        pg8::gemm_phase<pg8::EpiRes, pg8::StaticOrder, GP_ALIGN, GP_SP2>(lds, g, S, E);
        if (REPS(GEMM_REP_ID) == 2 && GEMM_REP_SEL == __LINE__) pg8::gemm_phase<pg8::EpiRes, pg8::StaticOrder, GP_ALIGN, GP_SP2>(lds, g, S, E);
      }
        if (BOTH(PH_GEMM_DN)) GRID_BAR();
    }

    if (IN(PH_FNORM)) {
        const float* gfin = args.in[IN_GF];
        for (int m = gw; m < M; m += NGW) {
            GAS f32x4* xr = (GAS f32x4*)(out + (size_t)m * D) + lane;
            f32x4 v[8]; float s = 0.f;
#pragma unroll
            for (int j = 0; j < 8; ++j) { v[j] = xr[64 * j]; s += (v[j].x * v[j].x + v[j].y * v[j].y) + (v[j].z * v[j].z + v[j].w * v[j].w); }
            const float rstd = rsqrtf(wave_sum(s) * (1.f / D) + EPS);
#pragma unroll
            for (int j = 0; j < 8; ++j) { const f32x4 gg = *(const f32x4*)(gfin + 4 * (lane + 64 * j)); xr[64 * j] = v[j] * rstd * gg; }
        }
    }
#undef IN
#undef BOTH
}

extern "C" void kernel_launch(void* const* d_in, const int* in_sizes, int n_in, void* d_out, int out_size, void* d_ws, size_t ws_size, hipStream_t stream) {
    static int grid = 0;
    if (grid == 0) {
        if (n_in != 18 || in_sizes[0] != M * D || out_size != M * D || ws_size < WS_END) { fprintf(stderr, "kernel_launch: unexpected shapes/workspace (n_in %d, in0 %d, out %d, ws %zu, need %zu); nothing launched\n", n_in, n_in > 0 ? in_sizes[0] : -1, out_size, ws_size, (size_t)WS_END); grid = -1; return; }
        int dev = 0, cus = 0, per_cu = 0;
        if (hipGetDevice(&dev) != hipSuccess || hipDeviceGetAttribute(&cus, hipDeviceAttributeMultiprocessorCount, dev) != hipSuccess) { grid = -1; return; }
        if (hipFuncSetAttribute((const void*)fwd_kernel, hipFuncAttributeMaxDynamicSharedMemorySize, LDS_BYTES) != hipSuccess) { fprintf(stderr, "kernel_launch: hipFuncSetAttribute failed\n"); grid = -1; return; }
        if (hipOccupancyMaxActiveBlocksPerMultiprocessor(&per_cu, (const void*)fwd_kernel, NTHR, LDS_BYTES) != hipSuccess || per_cu < 1) { fprintf(stderr, "kernel_launch: occupancy query says %d\n", per_cu); per_cu = 1; }
        (void)hipGetLastError();
        grid = cus * (per_cu < 1 ? 1 : 1);
    }
    if (grid < 0) return;
    (void)hipMemsetAsync((char*)d_ws + WS_CTL, 0, CTL_ZERO_BYTES, stream);
    Args a{};
    for (int i = 0; i < 18; ++i) a.in[i] = (const float*)d_in[i];
    a.out = (float*)d_out; a.ws = (unsigned char*)d_ws;
#if ONE_LAUNCH
    a.ph_lo = 0; a.ph_hi = NPH;
    void* kargs[] = {&a};
    hipError_t e = hipLaunchCooperativeKernel((const void*)fwd_kernel, dim3(grid), dim3(NTHR), kargs, LDS_BYTES, stream);
    if (e != hipSuccess) fprintf(stderr, "kernel_launch: cooperative launch failed: %s (grid %d)\n", hipGetErrorString(e), grid);
#else
    for (int p = 0; p < NPH; ++p) { a.ph_lo = p; a.ph_hi = p + 1; hipLaunchKernelGGL(fwd_kernel, dim3(grid), dim3(NTHR), LDS_BYTES, stream, a); }
#endif
}
```

```cpp
#include <hip/hip_runtime.h>
#include <cstdio>
#include <cstdint>

#ifndef GP_ALIGN
#define GP_ALIGN true
#endif
#ifndef GP_SP2
#define GP_SP2 true
#endif
#ifndef ONE_LAUNCH
#define ONE_LAUNCH 1
#endif

namespace pg8 {
#define PG8_LAS __attribute__((address_space(3)))
typedef unsigned short bf16_t;
typedef short bf16x8 __attribute__((ext_vector_type(8)));
typedef float f32x4 __attribute__((ext_vector_type(4)));
typedef unsigned u32x4 __attribute__((ext_vector_type(4)));
constexpr int BM = 256, BK = 64, HALF = 128, HTB = HALF * BK * 2, STAGE_BYTES = 8 * HTB, NXCD = 8, WGM = 8;

__host__ __device__ __forceinline__ int lds_byte(int r, int c) { const int st = (r >> 4) * 2 + (c >> 5), rr = r & 15, cc = c & 31, ob = rr * 64 + cc * 2; return st * 1024 + (ob ^ (((ob >> 9) & 1) << 5)); }
__host__ __device__ __forceinline__ void stage_rc(int b, int& R, int& C) { const int st = b / 1024, sb = b % 1024, swz = sb ^ (((sb >> 9) & 1) << 5); R = (st >> 1) * 16 + swz / 64; C = (st & 1) * 32 + (swz % 64) / 2; }
__host__ __device__ __forceinline__ int perm32(int rho) { const int n = rho >> 4, i = rho & 15; return 8 * (i >> 2) + 4 * n + (i & 3); }

struct Unit { int pm, pn; };
struct Gemm { const bf16_t* A; const bf16_t* Bt; int M, N, K; };

struct StaticOrder {
    int nM, nN, nwg, G, c;
    __host__ __device__ void init(int M, int N, int G_, int c_) { nM = M / BM; nN = N / BM; nwg = nM * nN; G = G_; c = c_; }
    __host__ __device__ bool next(int i, Unit& u) const {
        const long L = (long)i * G + c; if (L >= nwg) return false;
        int wgid = (int)L; { const int q = nwg / NXCD, r = nwg % NXCD, xcd = wgid % NXCD, off = wgid / NXCD; wgid = (xcd < r ? xcd * (q + 1) : r * (q + 1) + (xcd - r) * q) + off; }
        const int nig = WGM * nN, gid = wgid / nig, fm = gid * WGM, gsz = (nM - fm) < WGM ? (nM - fm) : WGM;
        u.pm = fm + ((wgid % nig) % gsz); u.pn = (wgid % nig) / gsz; return true;
    }
    __device__ __forceinline__ void a_ready(const Unit&) const {}
    __device__ __forceinline__ void done(const Unit&) const {}
};

__device__ __forceinline__ unsigned cvt_pk_bf16(float lo, float hi) { unsigned r; asm volatile("v_cvt_pk_bf16_f32 %0, %1, %2" : "=v"(r) : "v"(lo), "v"(hi)); return r; }


struct EpiBf16R {
    static constexpr bool PERM = true, AFTER_DRAIN = false;
    bf16_t* O; int ldc; int split_cols; size_t split_stride;
    const float* cosT; const float* sinT; int rope_hi; int sc_lo, sc_hi; float sc;
    __device__ __forceinline__ void operator()(const f32x4 (&acc)[2][2][4][2], const Unit& u, int wr, int wc, int fr, int fq) const {
        const int row0 = u.pm * BM + wr * 64 + fr; int colt = u.pn * BM; bf16_t* base = O;
        if (split_cols) { const int t = colt / split_cols; base += (size_t)t * split_stride; colt -= t * split_cols; }
        const int col0 = colt + wc * 32 + 8 * fq;
        const bool rope = u.pn < rope_hi; const float s = (u.pn >= sc_lo && u.pn < sc_hi) ? sc : 1.f;
        const int ti = 16 * (wc & 1) + 4 * fq;
#pragma unroll
        for (int ai = 0; ai < 2; ++ai)
#pragma unroll
            for (int m = 0; m < 4; ++m) {
                const int r = row0 + ai * HALF + m * 16;
                f32x4 cs = (f32x4){1.f, 1.f, 1.f, 1.f}, sn = (f32x4){0.f, 0.f, 0.f, 0.f};
                if (rope) { const int ntok = r & 8191; const int pos = (wc >> 1) ? (ntok & 63) : (ntok >> 6); cs = *(const f32x4*)(cosT + pos * 32 + ti); sn = *(const f32x4*)(sinT + pos * 32 + ti); }
                bf16_t* rowp = base + (size_t)r * ldc + col0;
#pragma unroll
                for (int bj = 0; bj < 2; ++bj) {
                    const f32x4 v0 = acc[ai][bj][m][0], v1 = acc[ai][bj][m][1]; f32x4 o0, o1;
                    o0[0] = v0[0] * cs[0] - v0[1] * sn[0]; o0[1] = v0[0] * sn[0] + v0[1] * cs[0];
                    o0[2] = v0[2] * cs[1] - v0[3] * sn[1]; o0[3] = v0[2] * sn[1] + v0[3] * cs[1];
                    o1[0] = v1[0] * cs[2] - v1[1] * sn[2]; o1[1] = v1[0] * sn[2] + v1[1] * cs[2];
                    o1[2] = v1[2] * cs[3] - v1[3] * sn[3]; o1[3] = v1[2] * sn[3] + v1[3] * cs[3];
                    o0 = o0 * s; o1 = o1 * s;
                    u32x4 w; w.x = cvt_pk_bf16(o0[0], o0[1]); w.y = cvt_pk_bf16(o0[2], o0[3]); w.z = cvt_pk_bf16(o1[0], o1[1]); w.w = cvt_pk_bf16(o1[2], o1[3]);
                    *(u32x4*)(rowp + bj * HALF) = w; }
            }
    }
};
__device__ __forceinline__ float dpp_ror1(float x)  { return __builtin_bit_cast(float, __builtin_amdgcn_update_dpp(0, __builtin_bit_cast(int, x), 0x121, 0xF, 0xF, false)); }
__device__ __forceinline__ float dpp_ror15(float x) { return __builtin_bit_cast(float, __builtin_amdgcn_update_dpp(0, __builtin_bit_cast(int, x), 0x12F, 0xF, 0xF, false)); }
struct EpiIn {
    static constexpr bool PERM = true, AFTER_DRAIN = false;
    bf16_t* P; int ldp; bf16_t* CATc; int ldcat; bf16_t* GS; int ldg; const float* cosT; const float* sinT; const float* convw; int nconv; float ksc;
    __device__ __forceinline__ void operator()(const f32x4 (&acc)[2][2][4][2], const Unit& u, int wr, int wc, int fr, int fq) const {
        const int row0 = u.pm * BM + wr * 64 + fr;
        if (u.pn < 12) {
            const int col0 = u.pn * BM + wc * 32 + 8 * fq;
            const bool rope = u.pn < 8; const float s = (u.pn >= 4 && u.pn < 8) ? ksc : 1.f;
            const int ti = 16 * (wc & 1) + 4 * fq;
#pragma unroll
            for (int ai = 0; ai < 2; ++ai)
#pragma unroll
                for (int m = 0; m < 4; ++m) {
                    const int r = row0 + ai * HALF + m * 16;
                    f32x4 cs = (f32x4){1.f, 1.f, 1.f, 1.f}, sn = (f32x4){0.f, 0.f, 0.f, 0.f};
                    if (rope) { const int ntok = r & 8191; const int pos = (wc >> 1) ? (ntok & 63) : (ntok >> 6); cs = *(const f32x4*)(cosT + pos * 32 + ti); sn = *(const f32x4*)(sinT + pos * 32 + ti); }
                    bf16_t* rowp = P + (size_t)r * ldp + col0;
#pragma unroll
                    for (int bj = 0; bj < 2; ++bj) {
                        const f32x4 v0 = acc[ai][bj][m][0], v1 = acc[ai][bj][m][1]; f32x4 o0, o1;
                        o0[0] = v0[0] * cs[0] - v0[1] * sn[0]; o0[1] = v0[0] * sn[0] + v0[1] * cs[0];
                        o0[2] = v0[2] * cs[1] - v0[3] * sn[1]; o0[3] = v0[2] * sn[1] + v0[3] * cs[1];
                        o1[0] = v1[0] * cs[2] - v1[1] * sn[2]; o1[1] = v1[0] * sn[2] + v1[1] * cs[2];
                        o1[2] = v1[2] * cs[3] - v1[3] * sn[3]; o1[3] = v1[2] * sn[3] + v1[3] * cs[3];
                        o0 = o0 * s; o1 = o1 * s;
                        u32x4 w; w.x = cvt_pk_bf16(o0[0], o0[1]); w.y = cvt_pk_bf16(o0[2], o0[3]); w.z = cvt_pk_bf16(o1[0], o1[1]); w.w = cvt_pk_bf16(o1[2], o1[3]);
                        *(u32x4*)(rowp + bj * HALF) = w; }
                }
        } else {
            typedef unsigned u32x2 __attribute__((ext_vector_type(2)));
            const int ch0 = 64 * (u.pn - 12) + 16 * wc + 4 * fq;
            const f32x4 w0 = *(const f32x4*)(convw + ch0), w1 = *(const f32x4*)(convw + nconv + ch0), w2 = *(const f32x4*)(convw + 2 * nconv + ch0);
#pragma unroll
            for (int ai = 0; ai < 2; ++ai) {
                f32x4 cv[4], rr[4], ll[4];
#pragma unroll
                for (int m = 0; m < 4; ++m) { cv[m] = acc[ai][0][m][0] * acc[ai][0][m][1];
#pragma unroll
                    for (int e = 0; e < 4; ++e) { rr[m][e] = dpp_ror1(cv[m][e]); ll[m][e] = dpp_ror15(cv[m][e]); } }
#pragma unroll
                for (int m = 0; m < 4; ++m) {
                    const f32x4 z = (f32x4){0.f, 0.f, 0.f, 0.f};
                    const f32x4 prev = fr > 0 ? rr[m] : (m > 0 ? rr[m > 0 ? m - 1 : 0] : z), next = fr < 15 ? ll[m] : (m < 3 ? ll[m < 3 ? m + 1 : 3] : z);
                    const f32x4 o = acc[ai][1][m][0] * (w0 * prev + w1 * cv[m] + w2 * next);
                    const f32x4 gq = acc[ai][1][m][1]; f32x4 gs;
#pragma unroll
                    for (int e = 0; e < 4; ++e) gs[e] = gq[e] / (1.f + __expf(-gq[e]));
                    const size_t r = (size_t)(row0 + ai * HALF + m * 16);
                    *(u32x2*)(CATc + r * ldcat + ch0) = (u32x2){cvt_pk_bf16(o[0], o[1]), cvt_pk_bf16(o[2], o[3])};
                    *(u32x2*)(GS + r * ldg + ch0) = (u32x2){cvt_pk_bf16(gs[0], gs[1]), cvt_pk_bf16(gs[2], gs[3])};
                }
            }
        }
    }
};
struct EpiRes {
    static constexpr bool PERM = false, AFTER_DRAIN = false;
    const float* base; float* out; int ldc; const float* gate; int gate_bstride;
    __device__ __forceinline__ void operator()(const f32x4 (&acc)[2][2][4][2], const Unit& u, int wr, int wc, int fr, int fq) const {
        const int row0 = u.pm * BM + wr * 64 + fr, col0 = u.pn * BM + wc * 32 + 4 * fq;
        const float* gp = gate + (size_t)((u.pm * BM) >> 13) * gate_bstride + col0;
        f32x4 gv[2][2];
#pragma unroll
        for (int bj = 0; bj < 2; ++bj)
#pragma unroll
            for (int n = 0; n < 2; ++n) gv[bj][n] = *(const f32x4*)(gp + bj * HALF + n * 16);
#pragma unroll
        for (int ai = 0; ai < 2; ++ai)
#pragma unroll
            for (int m = 0; m < 4; ++m) { const size_t off = (size_t)(row0 + ai * HALF + m * 16) * ldc + col0;
#pragma unroll
                for (int bj = 0; bj < 2; ++bj)
#pragma unroll
                    for (int n = 0; n < 2; ++n) { const f32x4 bs = *(const f32x4*)(base + off + bj * HALF + n * 16); *(f32x4*)(out + off + bj * HALF + n * 16) = bs + gv[bj][n] * acc[ai][bj][m][n]; }
                if (m & 1) asm volatile("" ::: "memory"); }
    }
};

struct EpiResNorm {
    static constexpr bool PERM = false, AFTER_DRAIN = false;
    const float* base; float* out; int ldc; const float* gate; int gate_bstride; const float* mul; bf16_t* xn; float* rowss;
    __device__ __forceinline__ void operator()(const f32x4 (&acc)[2][2][4][2], const Unit& u, int wr, int wc, int fr, int fq) const {
        const int row0 = u.pm * BM + wr * 64 + fr, col0 = u.pn * BM + wc * 32 + 4 * fq, b = (u.pm * BM) >> 13;
        const float* gp = gate + (size_t)b * gate_bstride + col0; const float* mp = mul + (size_t)b * ldc + col0;
        f32x4 gv[2][2];
#pragma unroll
        for (int bj = 0; bj < 2; ++bj)
#pragma unroll
            for (int n = 0; n < 2; ++n) gv[bj][n] = *(const f32x4*)(gp + bj * HALF + n * 16);
#pragma unroll
        for (int ai = 0; ai < 2; ++ai)
#pragma unroll
            for (int m = 0; m < 4; ++m) { const int r = row0 + ai * HALF + m * 16; const size_t off = (size_t)r * ldc + col0; float ss = 0.f;
#pragma unroll
                for (int bj = 0; bj < 2; ++bj)
#pragma unroll
                    for (int n = 0; n < 2; ++n) { const f32x4 bs = *(const f32x4*)(base + off + bj * HALF + n * 16); const f32x4 mv = *(const f32x4*)(mp + bj * HALF + n * 16);
                        const f32x4 v = bs + gv[bj][n] * acc[ai][bj][m][n]; *(f32x4*)(out + off + bj * HALF + n * 16) = v;
                        ss += (v[0] * v[0] + v[1] * v[1]) + (v[2] * v[2] + v[3] * v[3]);
                        const f32x4 y = v * mv; unsigned w0 = cvt_pk_bf16(y[0], y[1]), w1 = cvt_pk_bf16(y[2], y[3]);
                        typedef unsigned u32x2 __attribute__((ext_vector_type(2))); *(u32x2*)(xn + off + bj * HALF + n * 16) = (u32x2){w0, w1}; }
                ss += __shfl_xor(ss, 16); ss += __shfl_xor(ss, 32);
                if (fq == 0) rowss[(size_t)r * 32 + 4 * u.pn + wc] = ss;
                if (m & 1) asm volatile("" ::: "memory"); }
    }
};
struct EpiUp {
    static constexpr bool PERM = true, AFTER_DRAIN = false;
    bf16_t* O; int ldc; int split_cols; size_t split_stride; const float* bias; int bias_bstride; const PG8_LAS float* rs; int pm_cached; const float* rowss; float inv_d, eps;
    __device__ __forceinline__ void operator()(const f32x4 (&acc)[2][2][4][2], const Unit& u, int wr, int wc, int fr, int fq) const {
        const int row0 = u.pm * BM + wr * 64 + fr; int colt = u.pn * BM; bf16_t* base = O;
        { const int t = colt / split_cols; base += (size_t)t * split_stride; colt -= t * split_cols; }
        const int col0 = colt + wc * 32 + 8 * fq; const float* bp = bias + (size_t)((u.pm * BM) >> 13) * bias_bstride + u.pn * BM + wc * 32 + 8 * fq;
        f32x4 bv[2][2];
#pragma unroll
        for (int bj = 0; bj < 2; ++bj)
#pragma unroll
            for (int n = 0; n < 2; ++n) bv[bj][n] = *(const f32x4*)(bp + bj * HALF + 4 * n);
#pragma unroll
        for (int ai = 0; ai < 2; ++ai)
#pragma unroll
            for (int m = 0; m < 4; ++m) { const int rl = ai * HALF + wr * 64 + m * 16 + fr; const int r = u.pm * BM + rl; float rsv;
                if (u.pm == pm_cached) rsv = rs[rl];
                else { float t = 0.f; for (int i = 0; i < 32; ++i) t += rowss[(size_t)r * 32 + i]; rsv = rsqrtf(t * inv_d + eps); }
                bf16_t* rowp = base + (size_t)r * ldc + col0;
#pragma unroll
                for (int bj = 0; bj < 2; ++bj) { const f32x4 v0 = acc[ai][bj][m][0] * rsv + bv[bj][0], v1 = acc[ai][bj][m][1] * rsv + bv[bj][1];
                    u32x4 w; w.x = cvt_pk_bf16(v0[0], v0[1]); w.y = cvt_pk_bf16(v0[2], v0[3]); w.z = cvt_pk_bf16(v1[0], v1[1]); w.w = cvt_pk_bf16(v1[2], v1[3]);
                    *(u32x4*)(rowp + bj * HALF) = w; } }
    }
};
struct EpiNull {
    static constexpr bool PERM = true, AFTER_DRAIN = false;
    __device__ __forceinline__ void operator()(const f32x4 (&acc)[2][2][4][2], const Unit&, int, int, int, int) const {
#pragma unroll
        for (int ai = 0; ai < 2; ++ai)
#pragma unroll
            for (int bj = 0; bj < 2; ++bj)
#pragma unroll
                for (int m = 0; m < 4; ++m)
#pragma unroll
                    for (int n = 0; n < 2; ++n) asm volatile("" :: "v"(acc[ai][bj][m][n]));
    }
};
struct SameTileOrder : StaticOrder {
    __host__ __device__ bool next(int i, Unit& u) const { const long L = (long)i * G + c; if (L >= nwg) return false; u.pm = 0; u.pn = c % nN; return true; }
};
template <class Epi, class Sched, bool ALIGN_EPI = false, bool SP2 = false>
__device__ __forceinline__ void gemm_phase(PG8_LAS unsigned char* lds, const Gemm g, const Sched& S, const Epi& E) {
    const int tid = threadIdx.x, wid = __builtin_amdgcn_readfirstlane(tid >> 6), lane = tid & 63, wr = wid >> 2, wc = wid & 3, fr = lane & 15, fq = lane >> 4;
    const int K = g.K, nt = K / BK;
    unsigned voffA[2], voffB[2];
#pragma unroll
    for (int i = 0; i < 2; ++i) { int R, C; stage_rc(tid * 16 + i * 8192, R, C); const int Rb = Epi::PERM ? ((R & ~31) + perm32(R & 31)) : R;
        voffA[i] = (unsigned)(R * K + C) * 2u; voffB[i] = (unsigned)(Rb * K + C) * 2u; }
    const size_t kstep = (size_t)(BK * 2);
    const size_t hstep = (size_t)HALF * K * 2;
    const size_t tstep = 2 * hstep;
    const unsigned ldsw = (unsigned)wid * 1024u;
    const int aoff = lds_byte(wr * 64 + fr, fq * 8), boff = lds_byte(wc * 32 + fr, fq * 8);
#define PG8_SA(b, h) (((b) * 2 + (h)) * HTB)
#define PG8_SB(b, h) ((4 + (b) * 2 + (h)) * HTB)
#define PG8_STAGE(bufoff, gbase, voff) do { _Pragma("unroll") for (int _i = 0; _i < 2; ++_i) \
        __builtin_amdgcn_global_load_lds((const unsigned*)((const char*)(gbase) + (voff)[_i]), (PG8_LAS unsigned*)(lds + (bufoff) + ldsw + _i * 8192), 16, 0, 0); } while (0)
#define PG8_LDA(dst, b, h) do { _Pragma("unroll") for (int m = 0; m < 4; ++m) _Pragma("unroll") for (int k = 0; k < 2; ++k) dst[m][k] = *(const PG8_LAS bf16x8*)(lds + PG8_SA(b, h) + aoff + m * 2048 + k * 1024); } while (0)
#define PG8_LDB(dst, b, h) do { _Pragma("unroll") for (int n = 0; n < 2; ++n) _Pragma("unroll") for (int k = 0; k < 2; ++k) dst[n][k] = *(const PG8_LAS bf16x8*)(lds + PG8_SB(b, h) + boff + n * 2048 + k * 1024); } while (0)
#define PG8_MMA(ai, bj, At, Bt) do { __builtin_amdgcn_s_setprio(1); _Pragma("unroll") for (int m = 0; m < 4; ++m) _Pragma("unroll") for (int n = 0; n < 2; ++n) _Pragma("unroll") for (int k = 0; k < 2; ++k) \
        acc[ai][bj][m][n] = __builtin_amdgcn_mfma_f32_16x16x32_bf16(Bt[n][k], At[m][k], acc[ai][bj][m][n], 0, 0, 0); __builtin_amdgcn_s_setprio(0); } while (0)
#define PG8_WAIT_V(n) asm volatile("s_waitcnt vmcnt(" #n ")" ::: "memory")
#define PG8_WAIT_L(n) asm volatile("s_waitcnt lgkmcnt(" #n ")" ::: "memory")
#define PG8_BAR __builtin_amdgcn_s_barrier()
#define PG8_SCHED __builtin_amdgcn_sched_barrier(0)
    Unit cur, nxt; int ui = 0;
    if (!S.next(0, cur)) return;
    f32x4 acc[2][2][4][2];
#pragma unroll
    for (int a = 0; a < 2; ++a)
#pragma unroll
        for (int b = 0; b < 2; ++b)
#pragma unroll
            for (int m = 0; m < 4; ++m)
#pragma unroll
                for (int n = 0; n < 2; ++n) acc[a][b][m][n] = (f32x4){0.f, 0.f, 0.f, 0.f};
    bf16x8 At[4][2], B0[2][2], B1[2][2];
    const char* cA = (const char*)g.A + (size_t)cur.pm * tstep; const char* cB = (const char*)g.Bt + (size_t)cur.pn * tstep;
    S.a_ready(cur);
    if constexpr (SP2) {
        PG8_STAGE(PG8_SB(0, 0), cB, voffB); PG8_STAGE(PG8_SB(0, 1), cB + hstep, voffB); PG8_STAGE(PG8_SA(0, 0), cA, voffA); PG8_STAGE(PG8_SA(0, 1), cA + hstep, voffA);
        if (wr == 1) PG8_BAR;
        PG8_WAIT_V(2); PG8_BAR;
        PG8_STAGE(PG8_SB(1, 0), cB + kstep, voffB); PG8_STAGE(PG8_SA(1, 0), cA + kstep, voffA); PG8_STAGE(PG8_SB(1, 1), cB + hstep + kstep, voffB);
        PG8_WAIT_V(6); PG8_BAR;
    } else {
        PG8_STAGE(PG8_SB(0, 0), cB, voffB); PG8_STAGE(PG8_SA(0, 0), cA, voffA); PG8_STAGE(PG8_SB(0, 1), cB + hstep, voffB); PG8_STAGE(PG8_SA(0, 1), cA + hstep, voffA);
        if (wr == 1) PG8_BAR;
        PG8_WAIT_V(4); PG8_BAR;
        PG8_STAGE(PG8_SB(1, 0), cB + kstep, voffB); PG8_STAGE(PG8_SA(1, 0), cA + kstep, voffA); PG8_STAGE(PG8_SB(1, 1), cB + hstep + kstep, voffB);
        PG8_WAIT_V(6); PG8_BAR;
    }
    for (;;) {
        const bool has_next = S.next(ui + 1, nxt);
        const char* nA = has_next ? (const char*)g.A + (size_t)nxt.pm * tstep : cA; const char* nB = has_next ? (const char*)g.Bt + (size_t)nxt.pn * tstep : cB;
        for (int t = 0; t < nt; t += 2) {
            const bool last = (t == nt - 2);
            const char* a1 = cA + (size_t)(t + 1) * kstep;
            const char* a2 = last ? nA : cA + (size_t)(t + 2) * kstep; const char* b2 = last ? nB : cB + (size_t)(t + 2) * kstep;
            const char* a3 = a2 + kstep; const char* b3 = b2 + kstep;
            if (last && has_next) S.a_ready(nxt);
            if constexpr (SP2) {
            PG8_LDB(B0, 0, 0); PG8_LDB(B1, 0, 1); PG8_SCHED; PG8_LDA(At, 0, 0); PG8_STAGE(PG8_SA(1, 1), a1 + hstep, voffA);
            PG8_WAIT_V(8); PG8_WAIT_L(0); PG8_BAR; PG8_MMA(0, 0, At, B0); PG8_MMA(0, 1, At, B1); PG8_BAR; PG8_SCHED;
            PG8_LDA(At, 0, 1); PG8_STAGE(PG8_SB(0, 0), b2, voffB); PG8_STAGE(PG8_SB(0, 1), b2 + hstep, voffB); PG8_STAGE(PG8_SA(0, 0), a2, voffA);
            PG8_WAIT_V(8); PG8_WAIT_L(0); PG8_BAR; PG8_MMA(1, 0, At, B0); PG8_MMA(1, 1, At, B1); PG8_BAR; PG8_SCHED;
            PG8_LDB(B0, 1, 0); PG8_LDB(B1, 1, 1); PG8_SCHED; PG8_LDA(At, 1, 0); PG8_STAGE(PG8_SA(0, 1), a2 + hstep, voffA);
            PG8_WAIT_V(8); PG8_WAIT_L(0); PG8_BAR; PG8_MMA(0, 0, At, B0); PG8_MMA(0, 1, At, B1); PG8_BAR; PG8_SCHED;
            PG8_LDA(At, 1, 1); PG8_STAGE(PG8_SB(1, 0), b3, voffB); PG8_STAGE(PG8_SB(1, 1), b3 + hstep, voffB); PG8_STAGE(PG8_SA(1, 0), a3, voffA);
            PG8_WAIT_V(8); PG8_WAIT_L(0); PG8_BAR; PG8_MMA(1, 0, At, B0); PG8_MMA(1, 1, At, B1); PG8_BAR; PG8_SCHED;
            } else {
            PG8_LDB(B0, 0, 0); PG8_SCHED; PG8_LDA(At, 0, 0); PG8_STAGE(PG8_SA(1, 1), a1 + hstep, voffA);
            PG8_WAIT_L(8); PG8_BAR; PG8_WAIT_L(0); PG8_MMA(0, 0, At, B0); PG8_BAR; PG8_SCHED;
            PG8_LDB(B1, 0, 1); PG8_STAGE(PG8_SB(0, 0), b2, voffB);
            PG8_BAR; PG8_WAIT_L(0); PG8_MMA(0, 1, At, B1); PG8_BAR;
            PG8_LDA(At, 0, 1); PG8_STAGE(PG8_SA(0, 0), a2, voffA);
            PG8_BAR; PG8_WAIT_L(0); PG8_MMA(1, 0, At, B0); PG8_BAR; PG8_SCHED;
            PG8_STAGE(PG8_SB(0, 1), b2 + hstep, voffB);
            PG8_WAIT_V(6); PG8_BAR; PG8_MMA(1, 1, At, B1); PG8_BAR;
            PG8_LDB(B0, 1, 0); PG8_SCHED; PG8_LDA(At, 1, 0); PG8_STAGE(PG8_SA(0, 1), a2 + hstep, voffA);
            PG8_WAIT_L(8); PG8_BAR; PG8_WAIT_L(0); PG8_MMA(0, 0, At, B0); PG8_BAR; PG8_SCHED;
            PG8_LDB(B1, 1, 1); PG8_STAGE(PG8_SB(1, 0), b3, voffB);
            PG8_BAR; PG8_WAIT_L(0); PG8_MMA(0, 1, At, B1); PG8_BAR;
            PG8_LDA(At, 1, 1); PG8_STAGE(PG8_SA(1, 0), a3, voffA);
            PG8_BAR; PG8_WAIT_L(0); PG8_MMA(1, 0, At, B0); PG8_BAR; PG8_SCHED;
            PG8_STAGE(PG8_SB(1, 1), b3 + hstep, voffB);
            PG8_WAIT_V(6); PG8_BAR; PG8_MMA(1, 1, At, B1); PG8_BAR;
            }
        }
        if constexpr (ALIGN_EPI) { if (wr == 0) PG8_BAR; }
        if constexpr (!Epi::AFTER_DRAIN) { E(acc, cur, wr, wc, fr, fq); S.done(cur); }
        if (!has_next) break;
#pragma unroll
        for (int a = 0; a < 2; ++a)
#pragma unroll
            for (int b = 0; b < 2; ++b)
#pragma unroll
                for (int m = 0; m < 4; ++m)
#pragma unroll
                    for (int n = 0; n < 2; ++n) acc[a][b][m][n] = (f32x4){0.f, 0.f, 0.f, 0.f};
        cur = nxt; cA = nA; cB = nB; ++ui;
        if constexpr (ALIGN_EPI) { if (wr == 1) PG8_BAR; }
    }
    PG8_WAIT_V(0);
    if constexpr (!ALIGN_EPI) { if (wr == 0) PG8_BAR; }
    PG8_BAR;
#undef PG8_SA
#undef PG8_SB
#undef PG8_STAGE
#undef PG8_LDA
#undef PG8_LDB
#undef PG8_MMA
#undef PG8_WAIT_V
#undef PG8_WAIT_L
#undef PG8_BAR
#undef PG8_SCHED
}
}

constexpr int NWAVES = 8, NTHR = 512;
constexpr int BATCH = 2, SEQ = 8192, D = 2048, M = BATCH * SEQ, CTXL = 256, MC = BATCH * CTXL;
constexpr int RW = 1024, NH = 8, DH = 128, CCH = 1024, INW = 7168, DFF = 5632, NUP = 2 * DFF, NCHK = 64, CHK = 128;
constexpr int NMOD = 6 * D;
constexpr int PLD = 3 * RW;
constexpr float EPS = 1e-6f;
constexpr float KSCALE = 0.08838834764831845f;
constexpr int NSL = 8;

constexpr size_t MiB = 1u << 20;
constexpr size_t WS_CTL = 0, CTL_ZERO_BYTES = 1 * MiB;
constexpr size_t WS_COS = 1 * MiB, WS_SIN = WS_COS + 16384, WS_PW = WS_COS + 32768, WS_MODF = WS_COS + 65536, WS_MUL2 = WS_COS + 212992, WS_BIAS2 = WS_COS + 229376, WS_MODP = WS_COS + 524288;
constexpr int PWS = 260;
constexpr size_t WS_WOUT = 4 * MiB, WS_WUP = 12 * MiB, WS_WDN = 56 * MiB, WS_XN = 78 * MiB, WS_HC = 142 * MiB, WS_KVC = 144 * MiB, WS_BIG = 146 * MiB;
constexpr size_t WS_P = WS_BIG, WS_GS = WS_BIG + 96 * MiB  , WS_CAT = WS_BIG + 224 * MiB, WS_WIN = WS_BIG + 128 * MiB  , WS_UA = WS_BIG, WS_UB = WS_BIG + 176 * MiB;
constexpr size_t WS_SPV = WS_BIG + 288 * MiB;
constexpr size_t WS_CTXS = WS_BIG + 352 * MiB;
constexpr size_t WS_ROWSS = WS_CTXS + 4 * MiB;
constexpr size_t WS_END = WS_ROWSS + 2 * MiB;
static_assert(WS_MODP + (size_t)NSL * 3 * NMOD * 4 <= WS_WOUT && WS_BIAS2 + 2 * (size_t)NUP * 4 <= WS_MODP && WS_MUL2 + 2 * D * 4 <= WS_BIAS2 && WS_MODF + 3 * (size_t)NMOD * 4 <= WS_MUL2, "tables");
constexpr int CW_BAR = 4096;

constexpr int LDS_BYTES = 147456;
constexpr int MISC_OFF = LDS_BYTES - 256;

#define GAS __attribute__((address_space(1)))
#define LAS __attribute__((address_space(3)))
typedef unsigned short bf16;
typedef unsigned v4u __attribute__((ext_vector_type(4)));
typedef unsigned v2u __attribute__((ext_vector_type(2)));
typedef float f32x4 __attribute__((ext_vector_type(4)));
typedef GAS unsigned gu32;
#define LDS_WAIT() asm volatile("s_waitcnt lgkmcnt(0)" ::: "memory")
#define VM_WAIT() asm volatile("s_waitcnt vmcnt(0)" ::: "memory")
__device__ __forceinline__ unsigned f2bf(float f) { unsigned u = __builtin_bit_cast(unsigned, f); return (u + 0x7fffu + ((u >> 16) & 1u)) >> 16; }
__device__ __forceinline__ unsigned pk2(float lo, float hi) { return f2bf(lo) | (f2bf(hi) << 16); }
__device__ __forceinline__ float bflo(unsigned w) { return __builtin_bit_cast(float, w << 16); }
__device__ __forceinline__ float bfhi(unsigned w) { return __builtin_bit_cast(float, w & 0xffff0000u); }
__device__ __forceinline__ float bf1(bf16 h) { return __builtin_bit_cast(float, ((unsigned)h) << 16); }
__device__ __forceinline__ float silu_f(float x) { return x / (1.f + __expf(-x)); }
__device__ __forceinline__ float wave_sum(float v) {
#pragma unroll
    for (int o = 1; o < 64; o <<= 1) v += __shfl_xor(v, o);
    return v;
}


typedef short s16x4 __attribute__((ext_vector_type(4)));
typedef short bf16x8 __attribute__((ext_vector_type(8)));
__device__ __forceinline__ unsigned off_b(unsigned row, unsigned ch) { return 256u * row + 16u * (ch ^ (((row & 3u) << 2) | ((row >> 2) & 3u))); }
__device__ __forceinline__ s16x4 tr_rd(LAS unsigned char* p) { return __builtin_bit_cast(s16x4, __builtin_amdgcn_ds_read_tr16_b64_v4i16((LAS s16x4*)p)); }
__device__ __forceinline__ bf16x8 tr_frag(LAS unsigned char* img, unsigned lane, unsigned Ra, unsigned Rb, unsigned c) {
    const unsigned q = (lane & 15u) >> 2, p = lane & 3u;
    const s16x4 lo = tr_rd(img + off_b(Ra + q, 2u * c + (p >> 1)) + 8u * (p & 1u));
    const s16x4 hi = tr_rd(img + off_b(Rb + q, 2u * c + (p >> 1)) + 8u * (p & 1u));
    return __builtin_shufflevector(lo, hi, 0, 1, 2, 3, 4, 5, 6, 7);
}
__device__ __forceinline__ bf16x8 row_frag(LAS unsigned char* img, unsigned lane, unsigned rb, unsigned s_) { return *(const LAS bf16x8*)(img + off_b(16u * rb + (lane & 15u), 4u * s_ + (lane >> 4))); }
__device__ __forceinline__ v4u scale_pk8(v4u q, float w) { v4u o; o.x = pk2(bflo(q.x) * w, bfhi(q.x) * w); o.y = pk2(bflo(q.y) * w, bfhi(q.y) * w); o.z = pk2(bflo(q.z) * w, bfhi(q.z) * w); o.w = pk2(bflo(q.w) * w, bfhi(q.w) * w); return o; }

#define XB_TMO      128
#define XB_XCNT(j)  (256  + 64 * (j))
#define XB_XSUB(j)  (1280 + 64 * (j))
#define XB_XGEN(j)  (2304 + 64 * (j))
#define XB_TOP      3328
#define XB_TOPGEN   3392
#define XCD_BAR_WORDS 3456
#define XB_SPIN_CAP (1u << 18)
__device__ __forceinline__ unsigned xb_ld(unsigned* p)              { return __hip_atomic_load(p, __ATOMIC_RELAXED, __HIP_MEMORY_SCOPE_AGENT); }
__device__ __forceinline__ unsigned xb_add(unsigned* p, unsigned v) { return __hip_atomic_fetch_add(p, v, __ATOMIC_RELAXED, __HIP_MEMORY_SCOPE_AGENT); }
__device__ __forceinline__ unsigned xb_xcc_id() { return (unsigned)__builtin_amdgcn_s_getreg((3 << 11) | 20) & 0xFu; }
#define XB_SPIN(cond, bar) do { unsigned _sp = 0; while (cond) { __builtin_amdgcn_s_sleep(1); \
    if ((++_sp & 255u) == 0u) { if (xb_ld(&(bar)[XB_TMO])) break; if (_sp > XB_SPIN_CAP) { atomicAdd(&(bar)[XB_TMO], 1u); break; } } } } while (0)
struct XcdBarrier { unsigned* bar; unsigned x; volatile LAS unsigned* st; };
__device__ __forceinline__ XcdBarrier xcd_barrier_post(unsigned* bar, volatile LAS unsigned* st) {
    XcdBarrier b; b.bar = bar; b.x = xb_xcc_id(); b.st = st;
    if (threadIdx.x == 0) (void)xb_add(&bar[XB_XCNT(b.x)], 1u);
    return b;
}
__device__ __forceinline__ void xcd_barrier_complete(unsigned* bar, unsigned x, unsigned& nloc, unsigned& nx) {
    const unsigned G = gridDim.x * gridDim.y * gridDim.z;
    unsigned sum, cnt, mine, sp = 0u;
    for (;;) {
        sum = 0u; cnt = 0u; mine = 0u;
#pragma unroll
        for (unsigned j = 0; j < 16; ++j) { const unsigned c = xb_ld(&bar[XB_XCNT(j)]); sum += c; cnt += (c > 0u) ? 1u : 0u; mine = (j == x) ? c : mine; }
        if (sum == G) break;
        __builtin_amdgcn_s_sleep(1);
        if ((++sp & 255u) == 0u) { if (xb_ld(&bar[XB_TMO])) break; if (sp > XB_SPIN_CAP) { atomicAdd(&bar[XB_TMO], 1u); break; } }
    }
    nloc = mine > 0u ? mine : 1u; nx = cnt > 0u ? cnt : 1u;
}
__device__ __forceinline__ void xcd_barrier(const XcdBarrier& b) {
    asm volatile("s_waitcnt vmcnt(0)" ::: "memory");
    __syncthreads();
    if (threadIdx.x == 0) {
        unsigned* bar = b.bar;
        __builtin_amdgcn_s_waitcnt(0);
        unsigned nloc = b.st[0], nx = b.st[1];
        if (nloc == 0u) { xcd_barrier_complete(bar, b.x, nloc, nx); b.st[0] = nloc; b.st[1] = nx; }
        const unsigned old = xb_add(&bar[XB_XSUB(b.x)], 1u);
        const unsigned gen = old / nloc;
        if (old + 1u == (gen + 1u) * nloc) {
            __builtin_amdgcn_fence(__ATOMIC_RELEASE, "agent");
            asm volatile("s_waitcnt vmcnt(0)" ::: "memory");
            const unsigned og = xb_add(&bar[XB_TOP], 1u);
            const unsigned tg = og / nx;
            if (og + 1u == (tg + 1u) * nx) xb_add(&bar[XB_TOPGEN], 1u);
            else XB_SPIN(xb_ld(&bar[XB_TOPGEN]) == tg, bar);
            __builtin_amdgcn_fence(__ATOMIC_ACQUIRE, "agent");
            xb_add(&bar[XB_XGEN(b.x)], 1u);
            asm volatile("s_waitcnt vmcnt(0)" ::: "memory");
        } else {
            XB_SPIN(xb_ld(&bar[XB_XGEN(b.x)]) == gen, bar);
            __builtin_amdgcn_fence(__ATOMIC_ACQUIRE, "agent");
            asm volatile("s_waitcnt vmcnt(0)" ::: "memory");
        }
    }
    __syncthreads();
}

struct Args { const float* in[18]; float* out; unsigned char* ws; int ph_lo, ph_hi; };
enum { IN_X = 0, IN_C, IN_CTX, IN_CCTX, IN_WMOD, IN_BMOD, IN_G1, IN_WIN, IN_DECF, IN_DECB, IN_CONVW, IN_WOUT, IN_G2, IN_WUP, IN_FCW, IN_FCB, IN_WDN, IN_GF };
enum { PH_PRO = 0, PH_NORM1, PH_GEMM_IN, PH_KV, PH_SCAN, PH_RETOUT, PH_GEMM_OUT, PH_NORM2, PH_GEMM_UP, PH_GATE, PH_GEMM_DN, PH_FNORM, NPH };

template <bool PERMQK>
__device__ __forceinline__ void p0_transpose_item(const float* W, int K, int N, bf16* WT, LAS float* scr, int item, int lane) {
    const int nblk = N / 64, kb = item / nblk, nb = item % nblk, k0 = 64 * kb, n0 = 64 * nb;
    f32x4 v[16];
#pragma unroll
    for (int i = 0; i < 16; ++i) v[i] = *(const f32x4*)(W + (size_t)(k0 + 4 * i + (lane >> 4)) * N + n0 + 4 * (lane & 15));
#pragma unroll
    for (int i = 0; i < 16; ++i) { LAS float* d = scr + (4 * i + (lane >> 4)) * 65 + 4 * (lane & 15); d[0] = v[i].x; d[1] = v[i].y; d[2] = v[i].z; d[3] = v[i].w; }
    LDS_WAIT(); asm volatile("" ::: "memory");
    const int c = lane & 7;
#pragma unroll
    for (int j = 0; j < 8; ++j) { const int n = (lane >> 3) + 8 * j; const LAS float* s = scr + (8 * c) * 65 + n;
        v4u o; o.x = pk2(s[0 * 65], s[1 * 65]); o.y = pk2(s[2 * 65], s[3 * 65]); o.z = pk2(s[4 * 65], s[5 * 65]); o.w = pk2(s[6 * 65], s[7 * 65]);
        int ng = n0 + n;
        if (PERMQK) {
            if (ng < 2 * RW) ng = (ng & ~63) + 2 * (ng & 31) + ((ng >> 5) & 1);
            else if (ng >= 3 * RW) {
                const int sec = (ng - 3 * RW) >> 10, c = (ng - 3 * RW) & 1023, t = c >> 6, r = c & 63;
                const int lanecol = 32 * (r >> 4) + 8 * ((r >> 2) & 3) + (r & 3);
                ng = 256 * (12 + t) + lanecol + (sec == 0 ? 128 + 4 : sec == 1 ? 128 : sec == 2 ? 0 : 4); }
        }
        *(GAS v4u*)(WT + (size_t)ng * K + k0 + 8 * c) = o; }
    LDS_WAIT(); asm volatile("" ::: "memory");
}

__device__ __forceinline__ void norm_row_bf16(const float* xrow, bf16* orow, const LAS float* mulT, const LAS float* addT, int lane) {
    const GAS f32x4* xr = (const GAS f32x4*)xrow + lane;
    f32x4 v[8]; float s = 0.f;
#pragma unroll
    for (int j = 0; j < 8; ++j) { v[j] = xr[64 * j]; s += (v[j].x * v[j].x + v[j].y * v[j].y) + (v[j].z * v[j].z + v[j].w * v[j].w); }
    const float rstd = rsqrtf(wave_sum(s) * (1.f / D) + EPS);
    GAS v2u* o8 = (GAS v2u*)orow + lane;
#pragma unroll
    for (int j = 0; j < 8; ++j) { const f32x4 mu = *(const LAS f32x4*)(mulT + 4 * (lane + 64 * j)), ad = *(const LAS f32x4*)(addT + 4 * (lane + 64 * j));
        const f32x4 y = v[j] * rstd * mu + ad; v2u w; w.x = pk2(y.x, y.y); w.y = pk2(y.z, y.w); o8[64 * j] = w; }
}

__global__ void __launch_bounds__(NTHR, 2) fwd_kernel(Args args) {
    extern __shared__ __attribute__((aligned(16))) unsigned char lds_raw[];
    LAS unsigned char* lds = (LAS unsigned char*)lds_raw;
    volatile LAS unsigned* MISC = (volatile LAS unsigned*)(lds + MISC_OFF);
    const int tid = threadIdx.x, lane = tid & 63, wave = __builtin_amdgcn_readfirstlane(tid >> 6);
    const int G = gridDim.x, bx = blockIdx.x;
    const int gw = bx * NWAVES + wave, NGW = G * NWAVES;
    const int gtid = bx * NTHR + tid, NGT = G * NTHR;
    unsigned char* ws = args.ws;
    const float* x = args.in[IN_X]; float* out = args.out;
    float* COS = (float*)(ws + WS_COS); float* SIN = (float*)(ws + WS_SIN); float* PW = (float*)(ws + WS_PW);
    float* MODF = (float*)(ws + WS_MODF); float* MODP = (float*)(ws + WS_MODP); float* MUL2 = (float*)(ws + WS_MUL2); float* BIAS2 = (float*)(ws + WS_BIAS2); float* ROWSS = (float*)(ws + WS_ROWSS);
    bf16* WIN_T = (bf16*)(ws + WS_WIN); bf16* WOUT_T = (bf16*)(ws + WS_WOUT); bf16* WUP_T = (bf16*)(ws + WS_WUP); bf16* WDN_T = (bf16*)(ws + WS_WDN);
    bf16* XN = (bf16*)(ws + WS_XN); bf16* HC = (bf16*)(ws + WS_HC); bf16* KVC = (bf16*)(ws + WS_KVC);
    bf16* P = (bf16*)(ws + WS_P); bf16* GS = (bf16*)(ws + WS_GS); bf16* CAT = (bf16*)(ws + WS_CAT); bf16* UA = (bf16*)(ws + WS_UA); bf16* UB = (bf16*)(ws + WS_UB);
    float* CTXS = (float*)(ws + WS_CTXS); bf16* SPV = (bf16*)(ws + WS_SPV);
    bf16* KVS = (bf16*)out;

    if (tid < 64) MISC[tid] = 0u;
    __syncthreads();
#if ONE_LAUNCH
    XcdBarrier bar = xcd_barrier_post((unsigned*)(ws + WS_CTL) + CW_BAR, MISC + 8);
#define GRID_BAR() xcd_barrier(bar)
#else
#define GRID_BAR() do {} while (0)
#endif
    const int lo = args.ph_lo, hi = args.ph_hi;
#ifndef PHMASK
#define PHMASK 0xFFF
#endif
#define IN(k) (((PHMASK >> (k)) & 1) && lo <= (k) && (k) < hi)
#define BOTH(k) (IN(k) && IN((k) + 1))
#ifndef REP_MASK
#define REP_MASK 0
#endif
#define REPS(k) ((((REP_MASK) >> (k)) & 1) + 1)
#ifndef TIME_PHASE
#define TIME_PHASE -1
#endif
    unsigned long long tp_a = 0, tp_b = 0;
#define TP_BEGIN(k) do { if (TIME_PHASE == (k)) tp_a = __builtin_amdgcn_s_memrealtime(); } while (0)
#define TP_END(k) do { if (TIME_PHASE == (k)) tp_b = __builtin_amdgcn_s_memrealtime(); } while (0)
#ifndef GEMM_REP_SEL
#define GEMM_REP_SEL 0
#endif
#define GEMM_REP_ID 15

    if (IN(PH_PRO)) { TP_BEGIN(PH_PRO);
      for (int rep_ = 0; rep_ < REPS(PH_PRO); ++rep_) {
        LAS float* scr = (LAS float*)(lds + wave * 16640);
        constexpr int I_IN = (D / 64) * (INW / 64), I_OUT = (D / 64) * (D / 64), I_UP = (D / 64) * (NUP / 64), I_DN = (DFF / 64) * (D / 64), I_GV = NSL * (NMOD / 64);
        constexpr int NIT = I_IN + I_OUT + I_UP + I_DN + I_GV;
        for (int it = gw; it < NIT; it += NGW) {
            int r = it;
            if (r < I_GV) {
                const int s = r / (NMOD / 64), col = (r % (NMOD / 64)) * 64 + lane;
                float a0 = 0.f, a1 = 0.f, a2 = 0.f;
                for (int kb = 0; kb < 4; ++kb) {
                    const int kbase = s * 256 + kb * 64;
                    const float c0 = silu_f(args.in[IN_C][kbase + lane]), c1 = silu_f(args.in[IN_C][D + kbase + lane]), c2 = silu_f(args.in[IN_CCTX][kbase + lane]);
                    const float* wp = args.in[IN_WMOD] + (size_t)kbase * NMOD + col;
#pragma unroll 16
                    for (int kk = 0; kk < 64; ++kk) {
                        const float w = wp[(size_t)kk * NMOD];
                        a0 += w * __shfl(c0, kk); a1 += w * __shfl(c1, kk); a2 += w * __shfl(c2, kk);
                    }
                }
                MODP[((size_t)(s * 3 + 0)) * NMOD + col] = a0; MODP[((size_t)(s * 3 + 1)) * NMOD + col] = a1; MODP[((size_t)(s * 3 + 2)) * NMOD + col] = a2;
                continue;
            }
            r -= I_GV;
            if (r < I_IN) { p0_transpose_item<true>(args.in[IN_WIN], D, INW, WIN_T, scr, r, lane); continue; } r -= I_IN;
            if (r < I_OUT) { p0_transpose_item<false>(args.in[IN_WOUT], D, D, WOUT_T, scr, r, lane); continue; } r -= I_OUT;
            if (r < I_UP) { p0_transpose_item<false>(args.in[IN_WUP], D, NUP, WUP_T, scr, r, lane); continue; } r -= I_UP;
            p0_transpose_item<false>(args.in[IN_WDN], DFF, D, WDN_T, scr, r, lane);
        }
        if (gtid < 4096) { const int pos = gtid >> 5, i = gtid & 31; const float fr = powf(10000.f, -(float)i / 32.f); const float ang = (float)pos * fr; COS[gtid] = cosf(ang); SIN[gtid] = sinf(ang); }
        else if (gtid < 4096 + 2 * NH * 257) { const int idx = gtid - 4096, dir = idx / (NH * 257), h = (idx / 257) % NH, k = idx % 257;
            const float lg0 = args.in[dir ? IN_DECB : IN_DECF][h]; const float lg = fminf(lg0, 0.f) - log1pf(expf(-fabsf(lg0)));
            PW[(dir * NH + h) * PWS + k] = expf(lg * (float)k); }
      }
        if (BOTH(PH_PRO)) GRID_BAR();
        TP_END(PH_PRO);
    }

    if (IN(PH_NORM1)) { TP_BEGIN(PH_NORM1);
      for (int rep_ = 0; rep_ < REPS(PH_NORM1); ++rep_) {
        LAS float* mulT = (LAS float*)lds;
        LAS float* addT = (LAS float*)(lds + 3 * D * 4);
        for (int i = tid; i < 3 * D; i += NTHR) { const int r = i / D, k = i % D;
            float sh = args.in[IN_BMOD][k], sc = args.in[IN_BMOD][D + k];
#pragma unroll
            for (int s = 0; s < NSL; ++s) { sh += MODP[(size_t)(s * 3 + r) * NMOD + k]; sc += MODP[(size_t)(s * 3 + r) * NMOD + D + k]; }
            mulT[i] = args.in[IN_G1][k] * (1.f + sc); addT[i] = sh; }
        for (int i = gtid; i < 3 * NMOD; i += NGT) { const int r = i / NMOD, col = i % NMOD; float a = args.in[IN_BMOD][col];
#pragma unroll
            for (int s = 0; s < NSL; ++s) a += MODP[(size_t)(s * 3 + r) * NMOD + col];
            MODF[i] = a; }
        LAS float* sh2T = (LAS float*)(lds + 6 * D * 4);
        for (int i = tid; i < 2 * D; i += NTHR) { const int r = i / D, k = i % D; float sh = args.in[IN_BMOD][3 * D + k];
#pragma unroll
            for (int s = 0; s < NSL; ++s) sh += MODP[(size_t)(s * 3 + r) * NMOD + 3 * D + k];
            sh2T[i] = sh; }
        if (gtid < 2 * D) { const int r = gtid / D, k = gtid % D; float sc = args.in[IN_BMOD][4 * D + k];
#pragma unroll
            for (int s = 0; s < NSL; ++s) sc += MODP[(size_t)(s * 3 + r) * NMOD + 4 * D + k];
            MUL2[gtid] = args.in[IN_G2][k] * (1.f + sc); }
        __syncthreads();
        for (int col = gw; col < NUP; col += NGW) {
            const bf16* wrow = WUP_T + (size_t)col * D; float s0 = 0.f, s1 = 0.f;
#pragma unroll
            for (int j = 0; j < 4; ++j) { const int k0 = 8 * (lane + 64 * j); const v4u wq = *(const GAS v4u*)(wrow + k0);
                const float wv[8] = {bflo(wq.x), bfhi(wq.x), bflo(wq.y), bfhi(wq.y), bflo(wq.z), bfhi(wq.z), bflo(wq.w), bfhi(wq.w)};
                const f32x4 a0 = *(const LAS f32x4*)(sh2T + k0), a1 = *(const LAS f32x4*)(sh2T + k0 + 4), c0 = *(const LAS f32x4*)(sh2T + D + k0), c1 = *(const LAS f32x4*)(sh2T + D + k0 + 4);
                s0 += (wv[0] * a0.x + wv[1] * a0.y) + (wv[2] * a0.z + wv[3] * a0.w) + (wv[4] * a1.x + wv[5] * a1.y) + (wv[6] * a1.z + wv[7] * a1.w);
                s1 += (wv[0] * c0.x + wv[1] * c0.y) + (wv[2] * c0.z + wv[3] * c0.w) + (wv[4] * c1.x + wv[5] * c1.y) + (wv[6] * c1.z + wv[7] * c1.w); }
            s0 = wave_sum(s0); s1 = wave_sum(s1);
            if (lane == 0) { BIAS2[col] = s0; BIAS2[NUP + col] = s1; }
        }
        for (int m = gw; m < M + MC; m += NGW) {
            if (m < M) { const int b = m >> 13; norm_row_bf16(x + (size_t)m * D, XN + (size_t)m * D, mulT + b * D, addT + b * D, lane); }
            else { const int mc = m - M; norm_row_bf16(args.in[IN_CTX] + (size_t)mc * D, HC + (size_t)mc * D, mulT + 2 * D, addT + 2 * D, lane); }
        }
      }
        if (BOTH(PH_NORM1)) GRID_BAR();
        TP_END(PH_NORM1);
    }

    if (IN(PH_GEMM_IN)) { TP_BEGIN(PH_GEMM_IN);
      {
        __syncthreads();
        { pg8::Gemm g{XN, WIN_T, M, INW, D}; pg8::StaticOrder S; S.init(M, INW, G, bx);
          pg8::EpiIn E{P, PLD, CAT + RW, D, GS, RW, COS, SIN, args.in[IN_CONVW], CCH, KSCALE};
          pg8::gemm_phase<pg8::EpiIn, pg8::StaticOrder, GP_ALIGN, GP_SP2>(lds, g, S, E);
          if (REPS(GEMM_REP_ID) == 2 && GEMM_REP_SEL == __LINE__) pg8::gemm_phase<pg8::EpiIn, pg8::StaticOrder, GP_ALIGN, GP_SP2>(lds, g, S, E);
          if (GEMM_REP_SEL == 9001) { pg8::EpiNull EN; pg8::gemm_phase<pg8::EpiNull, pg8::StaticOrder, GP_ALIGN, GP_SP2>(lds, g, S, EN); }
          if (GEMM_REP_SEL == 9002) { pg8::EpiNull EN; pg8::SameTileOrder S2; S2.init(M, INW, G, bx); pg8::gemm_phase<pg8::EpiNull, pg8::SameTileOrder, GP_ALIGN, GP_SP2>(lds, g, S2, EN); } }
        { pg8::Gemm g{HC, WIN_T + (size_t)RW * D, MC, 2 * RW, D}; pg8::StaticOrder S; S.init(MC, 2 * RW, G, bx);
          pg8::EpiBf16R E{KVC, 2 * RW, 0, 0, COS, SIN, 0, 0, 4, KSCALE};
          pg8::gemm_phase<pg8::EpiBf16R, pg8::StaticOrder, GP_ALIGN, GP_SP2>(lds, g, S, E);
          if (REPS(GEMM_REP_ID) == 2 && GEMM_REP_SEL == __LINE__) pg8::gemm_phase<pg8::EpiBf16R, pg8::StaticOrder, GP_ALIGN, GP_SP2>(lds, g, S, E); }
      }
        if (BOTH(PH_GEMM_IN)) GRID_BAR();
        TP_END(PH_GEMM_IN);
    }

    if (IN(PH_KV)) { TP_BEGIN(PH_KV);
      for (int rep_ = 0; rep_ < REPS(PH_KV); ++rep_) {
        __syncthreads();
        LAS unsigned char* Kimg = lds; LAS unsigned char* Vfimg = lds + 32768; LAS unsigned char* Vbimg = lds + 65536;
        for (int item = bx; item < BATCH * NH * NCHK + BATCH * NH * 2; item += G) {
            const bf16* kptr; const bf16* vptr; size_t stride; int wfo, wbo, h; size_t ooff; bool ctxi;
            if (item < BATCH * NH * NCHK) { const int b = item >> 9, ch = item & 63; h = (item >> 6) & 7;
                kptr = P + ((size_t)b * SEQ + (size_t)ch * CHK) * PLD + RW + h * DH; vptr = kptr + RW; stride = PLD; wfo = 127; wbo = 0;
                ooff = ((((size_t)b * NH + h) * NCHK + ch) * DH) * DH; ctxi = false; }
            else { const int r = item - BATCH * NH * NCHK, b = r >> 4, c = r & 1; h = (r >> 1) & 7;
                kptr = KVC + ((size_t)b * CTXL + (size_t)c * CHK) * (2 * RW) + h * DH; vptr = kptr + RW; stride = 2 * RW; wfo = CTXL - 1 - CHK * c; wbo = CHK * c;
                ooff = ((((size_t)b * NH + h) * 2 + c) * DH) * DH; ctxi = true; }
            const float* pwf = PW + (0 * NH + h) * PWS; const float* pwb = PW + (1 * NH + h) * PWS;
#pragma unroll
            for (int i = 0; i < 4; ++i) { const int p = tid + NTHR * i, row = p >> 4, c16 = p & 15;
                const v4u kq = *(const GAS v4u*)(kptr + (size_t)row * stride + c16 * 8);
                const v4u vq = *(const GAS v4u*)(vptr + (size_t)row * stride + c16 * 8);
                const float wf = pwf[wfo - row], wb = pwb[wbo + row];
                const unsigned o = off_b(row, c16);
                *(LAS v4u*)(Kimg + o) = kq; *(LAS v4u*)(Vfimg + o) = scale_pk8(vq, wf); *(LAS v4u*)(Vbimg + o) = scale_pk8(vq, wb); }
            __syncthreads();
            {
                const unsigned g4 = lane >> 4, fr = lane & 15; const int dkg = wave >> 1, dvh = wave & 1;
                f32x4 accf[4][2], accb[4][2];
#pragma unroll
                for (int mt = 0; mt < 4; ++mt)
#pragma unroll
                    for (int nt = 0; nt < 2; ++nt) { accf[mt][nt] = (f32x4){0.f, 0.f, 0.f, 0.f}; accb[mt][nt] = (f32x4){0.f, 0.f, 0.f, 0.f}; }
#pragma unroll
                for (int ks = 0; ks < 4; ++ks) {
                    bf16x8 kf[2];
#pragma unroll
                    for (int nt = 0; nt < 2; ++nt) kf[nt] = tr_frag(Kimg, lane, 32 * ks + 8 * g4, 32 * ks + 8 * g4 + 4, 2 * dkg + nt);
#pragma unroll
                    for (int mt = 0; mt < 4; ++mt) {
                        const bf16x8 vf = tr_frag(Vfimg, lane, 32 * ks + 8 * g4, 32 * ks + 8 * g4 + 4, 4 * dvh + mt);
                        const bf16x8 vb = tr_frag(Vbimg, lane, 32 * ks + 8 * g4, 32 * ks + 8 * g4 + 4, 4 * dvh + mt);
#pragma unroll
                        for (int nt = 0; nt < 2; ++nt) { accf[mt][nt] = __builtin_amdgcn_mfma_f32_16x16x32_bf16(vf, kf[nt], accf[mt][nt], 0, 0, 0); accb[mt][nt] = __builtin_amdgcn_mfma_f32_16x16x32_bf16(vb, kf[nt], accb[mt][nt], 0, 0, 0); }
                    }
                }
#pragma unroll
                for (int mt = 0; mt < 4; ++mt)
#pragma unroll
                    for (int nt = 0; nt < 2; ++nt) { const size_t o = ooff + (size_t)(16 * (2 * dkg + nt) + fr) * DH + 16 * (4 * dvh + mt) + 4 * g4;
                        if (ctxi) { *(f32x4*)(CTXS + o) = accf[mt][nt]; *(f32x4*)(CTXS + (size_t)BATCH * NH * 2 * DH * DH + o) = accb[mt][nt]; }
                        else { v2u wf_, wb_; wf_.x = pk2(accf[mt][nt].x, accf[mt][nt].y); wf_.y = pk2(accf[mt][nt].z, accf[mt][nt].w); wb_.x = pk2(accb[mt][nt].x, accb[mt][nt].y); wb_.y = pk2(accb[mt][nt].z, accb[mt][nt].w);
                            *(GAS v2u*)(KVS + o) = wf_; *(GAS v2u*)(KVS + (size_t)BATCH * NH * NCHK * DH * DH + o) = wb_; } }
            }
            __syncthreads();
        }
      }
        if (BOTH(PH_KV)) GRID_BAR();
        TP_END(PH_KV);
    }

    if (IN(PH_SCAN)) { TP_BEGIN(PH_SCAN);
      for (int rep_ = 0; rep_ < REPS(PH_SCAN); ++rep_) {
        for (int e4 = gtid; e4 < 2 * BATCH * NH * DH * DH / 4; e4 += NGT) {
            const int dv4 = e4 & 31, dk = (e4 >> 5) & 127, h = (e4 >> 12) & 7, b = (e4 >> 15) & 1, dir = e4 >> 16;
            const float* pw = PW + (dir * NH + h) * PWS;
            const float* c0 = CTXS + ((((size_t)(dir * BATCH + b) * NH + h) * 2 + 0) * DH) * DH + (size_t)dk * DH + dv4 * 4;
            f32x4 s = *(const f32x4*)c0 + *(const f32x4*)(c0 + (size_t)DH * DH);
            const float cd = pw[CHK];
            const size_t boff = (((size_t)(dir * BATCH + b) * NH + h) * NCHK) * DH * DH + (size_t)dk * DH + dv4 * 4;
#pragma unroll 8
            for (int i = 0; i < NCHK; ++i) {
                const int n = dir ? (NCHK - 1 - i) : i;
                const v2u tq = *(const GAS v2u*)(KVS + boff + (size_t)n * DH * DH); const f32x4 t = (f32x4){bflo(tq.x), bfhi(tq.x), bflo(tq.y), bfhi(tq.y)};
                v2u w; w.x = pk2(s.x, s.y); w.y = pk2(s.z, s.w);
                *(GAS v2u*)(SPV + boff + (size_t)n * DH * DH) = w;
                s = s * cd + t;
            }
        }
      }
        if (BOTH(PH_SCAN)) GRID_BAR();
        TP_END(PH_SCAN);
    }

    if (IN(PH_RETOUT)) { TP_BEGIN(PH_RETOUT);
      for (int rep_ = 0; rep_ < REPS(PH_RETOUT); ++rep_) {
        __syncthreads();
        LAS unsigned char* Qi = lds; LAS unsigned char* Ki = lds + 32768; LAS unsigned char* Vi = lds + 65536; LAS unsigned char* Si = lds + 98304;
        LAS float* pwl = (LAS float*)(lds + 131072);
        for (int item = bx; item < BATCH * NH * NCHK; item += G) {
            const int b = item >> 9, h = (item >> 6) & 7, ch = item & 63;
            const size_t tok0 = (size_t)b * SEQ + (size_t)ch * CHK;
            const bf16* qptr = P + tok0 * PLD + h * DH;
            const bf16* sfp = SPV + ((((size_t)(0 * BATCH + b) * NH + h) * NCHK + ch) * DH) * DH;
            const bf16* sbp = SPV + ((((size_t)(1 * BATCH + b) * NH + h) * NCHK + ch) * DH) * DH;
            v4u sbq[4];
#pragma unroll
            for (int i = 0; i < 4; ++i) { const int p = tid + NTHR * i, row = p >> 4, c16 = p & 15; const unsigned o = off_b(row, c16);
                *(LAS v4u*)(Qi + o) = *(const GAS v4u*)(qptr + (size_t)row * PLD + c16 * 8);
                *(LAS v4u*)(Ki + o) = *(const GAS v4u*)(qptr + (size_t)row * PLD + RW + c16 * 8);
                *(LAS v4u*)(Vi + o) = *(const GAS v4u*)(qptr + (size_t)row * PLD + 2 * RW + c16 * 8);
                *(LAS v4u*)(Si + o) = *(const GAS v4u*)(sfp + (size_t)row * DH + c16 * 8);
                sbq[i] = *(const GAS v4u*)(sbp + (size_t)row * DH + c16 * 8); }
            if (tid < 2 * 129) { const int dir = tid / 129, k = tid % 129; pwl[dir * 132 + k] = PW[(dir * NH + h) * PWS + k]; }
            __syncthreads();
            const unsigned g4 = lane >> 4, fr = lane & 15; const int i_in = 16 * wave + (int)fr;
            bf16x8 qf[4];
#pragma unroll
            for (int ks = 0; ks < 4; ++ks) qf[ks] = row_frag(Qi, lane, wave, ks);
            f32x4 sc[8];
#pragma unroll
            for (int jt = 0; jt < 8; ++jt) { sc[jt] = (f32x4){0.f, 0.f, 0.f, 0.f};
#pragma unroll
                for (int ks = 0; ks < 4; ++ks) sc[jt] = __builtin_amdgcn_mfma_f32_16x16x32_bf16(row_frag(Ki, lane, jt, ks), qf[ks], sc[jt], 0, 0, 0); }
            __syncthreads();
#pragma unroll
            for (int i = 0; i < 4; ++i) { const int p = tid + NTHR * i, row = p >> 4, c16 = p & 15; *(LAS v4u*)(Ki + off_b(row, c16)) = sbq[i]; }
            bf16x8 pf[4];
#pragma unroll
            for (int ks = 0; ks < 4; ++ks) {
                float pv[8];
#pragma unroll
                for (int hf = 0; hf < 2; ++hf)
#pragma unroll
                    for (int rg = 0; rg < 4; ++rg) { const int j = 16 * (2 * ks + hf) + 4 * (int)g4 + rg;
                        const float dm = (j <= i_in) ? pwl[i_in - j] : pwl[132 + (j - i_in)];
                        pv[4 * hf + rg] = sc[2 * ks + hf][rg] * dm; }
                v4u w; w.x = pk2(pv[0], pv[1]); w.y = pk2(pv[2], pv[3]); w.z = pk2(pv[4], pv[5]); w.w = pk2(pv[6], pv[7]);
                pf[ks] = __builtin_bit_cast(bf16x8, w);
            }
            f32x4 o[8];
#pragma unroll
            for (int nt = 0; nt < 8; ++nt) { o[nt] = (f32x4){0.f, 0.f, 0.f, 0.f};
#pragma unroll
                for (int ks = 0; ks < 4; ++ks) o[nt] = __builtin_amdgcn_mfma_f32_16x16x32_bf16(tr_frag(Vi, lane, 32 * ks + 4 * g4, 32 * ks + 16 + 4 * g4, nt), pf[ks], o[nt], 0, 0, 0); }
            {
                const float qd = pwl[i_in + 1]; bf16x8 qs[4];
#pragma unroll
                for (int ks = 0; ks < 4; ++ks) qs[ks] = __builtin_bit_cast(bf16x8, scale_pk8(__builtin_bit_cast(v4u, qf[ks]), qd));
#pragma unroll
                for (int nt = 0; nt < 8; ++nt)
#pragma unroll
                    for (int ks = 0; ks < 4; ++ks) o[nt] = __builtin_amdgcn_mfma_f32_16x16x32_bf16(tr_frag(Si, lane, 32 * ks + 8 * g4, 32 * ks + 8 * g4 + 4, nt), qs[ks], o[nt], 0, 0, 0);
            }
            __syncthreads();
            {
                const float qd = pwl[132 + (CHK - i_in)]; bf16x8 qs[4];
#pragma unroll
                for (int ks = 0; ks < 4; ++ks) qs[ks] = __builtin_bit_cast(bf16x8, scale_pk8(__builtin_bit_cast(v4u, qf[ks]), qd));
#pragma unroll
                for (int nt = 0; nt < 8; ++nt)
#pragma unroll
                    for (int ks = 0; ks < 4; ++ks) o[nt] = __builtin_amdgcn_mfma_f32_16x16x32_bf16(tr_frag(Ki, lane, 32 * ks + 8 * g4, 32 * ks + 8 * g4 + 4, nt), qs[ks], o[nt], 0, 0, 0);
            }
            {
                float ss = 0.f;
#pragma unroll
                for (int nt = 0; nt < 8; ++nt) ss += (o[nt].x * o[nt].x + o[nt].y * o[nt].y) + (o[nt].z * o[nt].z + o[nt].w * o[nt].w);
                ss += __shfl_xor(ss, 16); ss += __shfl_xor(ss, 32);
                const float rstd = rsqrtf(ss * (1.f / DH) + EPS);
                const bf16* gp = GS + (tok0 + i_in) * RW + h * DH + 4 * g4;
                bf16* op = CAT + (tok0 + i_in) * D + h * DH + 4 * g4;
#pragma unroll
                for (int nt = 0; nt < 8; ++nt) { const v2u gq = *(const GAS v2u*)(gp + 16 * nt);
                    v2u w; w.x = pk2(o[nt].x * rstd * bflo(gq.x), o[nt].y * rstd * bfhi(gq.x)); w.y = pk2(o[nt].z * rstd * bflo(gq.y), o[nt].w * rstd * bfhi(gq.y));
                    *(GAS v2u*)(op + 16 * nt) = w; }
            }
            __syncthreads();
        }
      }
        if (BOTH(PH_RETOUT)) GRID_BAR();
        TP_END(PH_RETOUT);
    }

    if (IN(PH_GEMM_OUT)) { TP_BEGIN(PH_GEMM_OUT);
      {
        __syncthreads();
        pg8::Gemm g{CAT, WOUT_T, M, D, D}; pg8::StaticOrder S; S.init(M, D, G, bx);
        pg8::EpiResNorm E{x, out, D, MODF + 2 * D, NMOD, MUL2, XN, ROWSS};
        pg8::gemm_phase<pg8::EpiResNorm, pg8::StaticOrder, GP_ALIGN, GP_SP2>(lds, g, S, E);
        if (REPS(GEMM_REP_ID) == 2 && GEMM_REP_SEL == __LINE__) pg8::gemm_phase<pg8::EpiResNorm, pg8::StaticOrder, GP_ALIGN, GP_SP2>(lds, g, S, E);
      }
        if (BOTH(PH_GEMM_OUT)) GRID_BAR();
        TP_END(PH_GEMM_OUT);
    }

    if (IN(PH_GEMM_UP)) { TP_BEGIN(PH_GEMM_UP);
      {
        __syncthreads();
        pg8::Gemm g{XN, WUP_T, M, NUP, D}; pg8::StaticOrder S; S.init(M, NUP, G, bx);
        LAS float* rsl = (LAS float*)(lds + 131072);
        pg8::Unit u0; int pm0 = -1; if (S.next(0, u0)) pm0 = u0.pm;
        if (pm0 >= 0 && tid < 256) { const float* rp = ROWSS + ((size_t)pm0 * 256 + tid) * 32; float t = 0.f;
#pragma unroll
            for (int i = 0; i < 8; ++i) { const f32x4 q = *(const f32x4*)(rp + 4 * i); t += (q.x + q.y) + (q.z + q.w); }
            rsl[tid] = rsqrtf(t * (1.f / D) + EPS); }
        __syncthreads();
        pg8::EpiUp E{UA, DFF, DFF, (size_t)(WS_UB - WS_UA) / 2, BIAS2, NUP, rsl, pm0, ROWSS, 1.f / D, EPS};
        pg8::gemm_phase<pg8::EpiUp, pg8::StaticOrder, GP_ALIGN, GP_SP2>(lds, g, S, E);
        if (REPS(GEMM_REP_ID) == 2 && GEMM_REP_SEL == __LINE__) pg8::gemm_phase<pg8::EpiUp, pg8::StaticOrder, GP_ALIGN, GP_SP2>(lds, g, S, E);
      }
        if (BOTH(PH_GEMM_UP)) GRID_BAR();
        TP_END(PH_GEMM_UP);
    }

    if (IN(PH_GATE)) { TP_BEGIN(PH_GATE);
      for (int rep_ = 0; rep_ < REPS(PH_GATE); ++rep_) {
        const float* fw = args.in[IN_FCW]; const float* fb = args.in[IN_FCB];
        for (int item = gtid; item < BATCH * 4 * 64 * (DFF / 8); item += NGT) {
            const int c8 = item % (DFF / 8), t = item / (DFF / 8), gc = t & 63, rq = (t >> 6) & 3, b = t >> 8;
            float w0[8], w1[8], w2[8], bs[8];
#pragma unroll
            for (int e = 0; e < 2; ++e) { const f32x4 q0 = *(const f32x4*)(fw + c8 * 8 + 4 * e), q1 = *(const f32x4*)(fw + DFF + c8 * 8 + 4 * e), q2 = *(const f32x4*)(fw + 2 * DFF + c8 * 8 + 4 * e), q3 = *(const f32x4*)(fb + c8 * 8 + 4 * e);
#pragma unroll
                for (int j = 0; j < 4; ++j) { w0[4 * e + j] = q0[j]; w1[4 * e + j] = q1[j]; w2[4 * e + j] = q2[j]; bs[4 * e + j] = q3[j]; } }
            const size_t off0 = ((size_t)b * SEQ + (size_t)(rq * 32) * 64 + gc) * DFF + c8 * 8;
            const v4u z = (v4u){0u, 0u, 0u, 0u};
            v4u ap = rq > 0 ? *(const GAS v4u*)(UA + off0 - (size_t)64 * DFF) : z;
            v4u ac = *(const GAS v4u*)(UA + off0);
#pragma unroll 4
            for (int r = 0; r < 32; ++r) {
                const size_t off = off0 + (size_t)r * 64 * DFF;
                const v4u an = (rq * 32 + r < 127) ? *(const GAS v4u*)(UA + off + (size_t)64 * DFF) : z;
                const v4u bq = *(const GAS v4u*)(UB + off);
                const float A0[8] = {bflo(ap.x), bfhi(ap.x), bflo(ap.y), bfhi(ap.y), bflo(ap.z), bfhi(ap.z), bflo(ap.w), bfhi(ap.w)};
                const float A1[8] = {bflo(ac.x), bfhi(ac.x), bflo(ac.y), bfhi(ac.y), bflo(ac.z), bfhi(ac.z), bflo(ac.w), bfhi(ac.w)};
                const float A2[8] = {bflo(an.x), bfhi(an.x), bflo(an.y), bfhi(an.y), bflo(an.z), bfhi(an.z), bflo(an.w), bfhi(an.w)};
                const float BB[8] = {bflo(bq.x), bfhi(bq.x), bflo(bq.y), bfhi(bq.y), bflo(bq.z), bfhi(bq.z), bflo(bq.w), bfhi(bq.w)};
                float o[8];
#pragma unroll
                for (int e = 0; e < 8; ++e) { const float av = w0[e] * A0[e] + w1[e] * A1[e] + w2[e] * A2[e] + bs[e]; o[e] = silu_f(av) * BB[e]; }
                v4u w; w.x = pk2(o[0], o[1]); w.y = pk2(o[2], o[3]); w.z = pk2(o[4], o[5]); w.w = pk2(o[6], o[7]);
                *(GAS v4u*)(UB + off) = w;
                ap = ac; ac = an;
            }
        }
      }
        if (BOTH(PH_GATE)) GRID_BAR();
        TP_END(PH_GATE);
    }

    if (IN(PH_GEMM_DN)) { TP_BEGIN(PH_GEMM_DN);
      {
        __syncthreads();
        pg8::Gemm g{UB, WDN_T, M, D, DFF}; pg8::StaticOrder S; S.init(M, D, G, bx);
        pg8::EpiRes E{out, out, D, MODF + 5 * D, NMOD};
        pg8::gemm_phase<pg8::EpiRes, pg8::StaticOrder, GP_ALIGN, GP_SP2>(lds, g, S, E);
        if (REPS(GEMM_REP_ID) == 2 && GEMM_REP_SEL == __LINE__) pg8::gemm_phase<pg8::EpiRes, pg8::StaticOrder, GP_ALIGN, GP_SP2>(lds, g, S, E);
      }
        if (BOTH(PH_GEMM_DN)) GRID_BAR();
        TP_END(PH_GEMM_DN);
    }

    if (IN(PH_FNORM)) { TP_BEGIN(PH_FNORM);
        const float* gfin = args.in[IN_GF];
        for (int m = gw; m < M; m += NGW) {
            GAS f32x4* xr = (GAS f32x4*)(out + (size_t)m * D) + lane;
            f32x4 v[8]; float s = 0.f;
#pragma unroll
            for (int j = 0; j < 8; ++j) { v[j] = xr[64 * j]; s += (v[j].x * v[j].x + v[j].y * v[j].y) + (v[j].z * v[j].z + v[j].w * v[j].w); }
            const float rstd = rsqrtf(wave_sum(s) * (1.f / D) + EPS);
#pragma unroll
            for (int j = 0; j < 8; ++j) { const f32x4 gg = *(const f32x4*)(gfin + 4 * (lane + 64 * j)); xr[64 * j] = v[j] * rstd * gg; }
        }
    }
    if (TIME_PHASE == PH_FNORM) { VM_WAIT(); tp_b = __builtin_amdgcn_s_memrealtime(); }
    if (TIME_PHASE >= 0 && bx == 0 && tid == 0) { const unsigned long long t0 = __builtin_amdgcn_s_memrealtime(), span = (tp_b - tp_a) * 8ull; while (__builtin_amdgcn_s_memrealtime() - t0 < span) __builtin_amdgcn_s_sleep(8); }
#undef IN
#undef BOTH
}

extern "C" void kernel_launch(void* const* d_in, const int* in_sizes, int n_in, void* d_out, int out_size, void* d_ws, size_t ws_size, hipStream_t stream) {
    static int grid = 0;
    if (grid == 0) {
        if (n_in != 18 || in_sizes[0] != M * D || out_size != M * D || ws_size < WS_END) { fprintf(stderr, "kernel_launch: unexpected shapes/workspace (n_in %d, in0 %d, out %d, ws %zu, need %zu); nothing launched\n", n_in, n_in > 0 ? in_sizes[0] : -1, out_size, ws_size, (size_t)WS_END); grid = -1; return; }
        int dev = 0, cus = 0, per_cu = 0;
        if (hipGetDevice(&dev) != hipSuccess || hipDeviceGetAttribute(&cus, hipDeviceAttributeMultiprocessorCount, dev) != hipSuccess) { grid = -1; return; }
        if (hipFuncSetAttribute((const void*)fwd_kernel, hipFuncAttributeMaxDynamicSharedMemorySize, LDS_BYTES) != hipSuccess) { fprintf(stderr, "kernel_launch: hipFuncSetAttribute failed\n"); grid = -1; return; }
        if (hipOccupancyMaxActiveBlocksPerMultiprocessor(&per_cu, (const void*)fwd_kernel, NTHR, LDS_BYTES) != hipSuccess || per_cu < 1) { fprintf(stderr, "kernel_launch: occupancy query says %d\n", per_cu); per_cu = 1; }
        (void)hipGetLastError();
        grid = cus * (per_cu < 1 ? 1 : 1);
    }
    if (grid < 0) return;
    (void)hipMemsetAsync((char*)d_ws + WS_CTL, 0, CTL_ZERO_BYTES, stream);
    Args a{};
    for (int i = 0; i < 18; ++i) a.in[i] = (const float*)d_in[i];
    a.out = (float*)d_out; a.ws = (unsigned char*)d_ws;
#if ONE_LAUNCH
    a.ph_lo = 0; a.ph_hi = NPH;
    void* kargs[] = {&a};
    hipError_t e = hipLaunchCooperativeKernel((const void*)fwd_kernel, dim3(grid), dim3(NTHR), kargs, LDS_BYTES, stream);
    if (e != hipSuccess) fprintf(stderr, "kernel_launch: cooperative launch failed: %s (grid %d)\n", hipGetErrorString(e), grid);
#else
    for (int p = 0; p < NPH; ++p) { a.ph_lo = p; a.ph_hi = p + 1; hipLaunchKernelGGL(fwd_kernel, dim3(grid), dim3(NTHR), LDS_BYTES, stream, a); }
#endif
}
```

```cpp
#include <hip/hip_runtime.h>
#include <cstdio>
#include <cstdint>

#ifndef GP_ALIGN
#define GP_ALIGN true
#endif
#ifndef GP_SP2
#define GP_SP2 true
#endif
#ifndef ONE_LAUNCH
#define ONE_LAUNCH 1
#endif

namespace pg8 {
#define PG8_LAS __attribute__((address_space(3)))
typedef unsigned short bf16_t;
typedef short bf16x8 __attribute__((ext_vector_type(8)));
typedef float f32x4 __attribute__((ext_vector_type(4)));
typedef unsigned u32x4 __attribute__((ext_vector_type(4)));
constexpr int BM = 256, BK = 64, HALF = 128, HTB = HALF * BK * 2, STAGE_BYTES = 8 * HTB, NXCD = 8, WGM = 8;

__host__ __device__ __forceinline__ int lds_byte(int r, int c) { const int st = (r >> 4) * 2 + (c >> 5), rr = r & 15, cc = c & 31, ob = rr * 64 + cc * 2; return st * 1024 + (ob ^ (((ob >> 9) & 1) << 5)); }
__host__ __device__ __forceinline__ void stage_rc(int b, int& R, int& C) { const int st = b / 1024, sb = b % 1024, swz = sb ^ (((sb >> 9) & 1) << 5); R = (st >> 1) * 16 + swz / 64; C = (st & 1) * 32 + (swz % 64) / 2; }
__host__ __device__ __forceinline__ int perm32(int rho) { const int n = rho >> 4, i = rho & 15; return 8 * (i >> 2) + 4 * n + (i & 3); }

struct Unit { int pm, pn; };
struct Gemm { const bf16_t* A; const bf16_t* Bt; int M, N, K; };

struct StaticOrder {
    int nM, nN, nwg, G, c;
    __host__ __device__ void init(int M, int N, int G_, int c_) { nM = M / BM; nN = N / BM; nwg = nM * nN; G = G_; c = c_; }
    __host__ __device__ bool next(int i, Unit& u) const {
        const long L = (long)i * G + c; if (L >= nwg) return false;
        int wgid = (int)L; { const int q = nwg / NXCD, r = nwg % NXCD, xcd = wgid % NXCD, off = wgid / NXCD; wgid = (xcd < r ? xcd * (q + 1) : r * (q + 1) + (xcd - r) * q) + off; }
        const int nig = WGM * nN, gid = wgid / nig, fm = gid * WGM, gsz = (nM - fm) < WGM ? (nM - fm) : WGM;
        u.pm = fm + ((wgid % nig) % gsz); u.pn = (wgid % nig) / gsz; return true;
    }
    __device__ __forceinline__ void a_ready(const Unit&) const {}
    __device__ __forceinline__ void done(const Unit&) const {}
};

__device__ __forceinline__ unsigned cvt_pk_bf16(float lo, float hi) { unsigned r; asm volatile("v_cvt_pk_bf16_f32 %0, %1, %2" : "=v"(r) : "v"(lo), "v"(hi)); return r; }


struct EpiBf16R {
    static constexpr bool PERM = true, AFTER_DRAIN = false, GRIDMAP = false;
    bf16_t* O; int ldc; int split_cols; size_t split_stride;
    const float* cosT; const float* sinT; int rope_hi; int sc_lo, sc_hi; float sc;
    __device__ __forceinline__ void operator()(const f32x4 (&acc)[2][2][4][2], const Unit& u, int wr, int wc, int fr, int fq) const {
        const int row0 = u.pm * BM + wr * 64 + fr; int colt = u.pn * BM; bf16_t* base = O;
        if (split_cols) { const int t = colt / split_cols; base += (size_t)t * split_stride; colt -= t * split_cols; }
        const int col0 = colt + wc * 32 + 8 * fq;
        const bool rope = u.pn < rope_hi; const float s = (u.pn >= sc_lo && u.pn < sc_hi) ? sc : 1.f;
        const int ti = 16 * (wc & 1) + 4 * fq;
#pragma unroll
        for (int ai = 0; ai < 2; ++ai)
#pragma unroll
            for (int m = 0; m < 4; ++m) {
                const int r = row0 + ai * HALF + m * 16;
                f32x4 cs = (f32x4){1.f, 1.f, 1.f, 1.f}, sn = (f32x4){0.f, 0.f, 0.f, 0.f};
                if (rope) { const int ntok = r & 8191; const int pos = (wc >> 1) ? (ntok & 63) : (ntok >> 6); cs = *(const f32x4*)(cosT + pos * 32 + ti); sn = *(const f32x4*)(sinT + pos * 32 + ti); }
                bf16_t* rowp = base + (size_t)r * ldc + col0;
#pragma unroll
                for (int bj = 0; bj < 2; ++bj) {
                    const f32x4 v0 = acc[ai][bj][m][0], v1 = acc[ai][bj][m][1]; f32x4 o0, o1;
                    o0[0] = v0[0] * cs[0] - v0[1] * sn[0]; o0[1] = v0[0] * sn[0] + v0[1] * cs[0];
                    o0[2] = v0[2] * cs[1] - v0[3] * sn[1]; o0[3] = v0[2] * sn[1] + v0[3] * cs[1];
                    o1[0] = v1[0] * cs[2] - v1[1] * sn[2]; o1[1] = v1[0] * sn[2] + v1[1] * cs[2];
                    o1[2] = v1[2] * cs[3] - v1[3] * sn[3]; o1[3] = v1[2] * sn[3] + v1[3] * cs[3];
                    o0 = o0 * s; o1 = o1 * s;
                    u32x4 w; w.x = cvt_pk_bf16(o0[0], o0[1]); w.y = cvt_pk_bf16(o0[2], o0[3]); w.z = cvt_pk_bf16(o1[0], o1[1]); w.w = cvt_pk_bf16(o1[2], o1[3]);
                    *(u32x4*)(rowp + bj * HALF) = w; }
            }
    }
};
__device__ __forceinline__ float dpp_ror1(float x)  { return __builtin_bit_cast(float, __builtin_amdgcn_update_dpp(0, __builtin_bit_cast(int, x), 0x121, 0xF, 0xF, false)); }
__device__ __forceinline__ float dpp_ror15(float x) { return __builtin_bit_cast(float, __builtin_amdgcn_update_dpp(0, __builtin_bit_cast(int, x), 0x12F, 0xF, 0xF, false)); }
struct EpiIn {
    static constexpr bool PERM = true, AFTER_DRAIN = false, GRIDMAP = false;
    bf16_t* P; int ldp; bf16_t* CATc; int ldcat; bf16_t* GS; int ldg; const float* cosT; const float* sinT; const float* convw; int nconv; float ksc;
    __device__ __forceinline__ void operator()(const f32x4 (&acc)[2][2][4][2], const Unit& u, int wr, int wc, int fr, int fq) const {
        const int row0 = u.pm * BM + wr * 64 + fr;
        if (u.pn < 12) {
            const int col0 = u.pn * BM + wc * 32 + 8 * fq;
            const bool rope = u.pn < 8; const float s = (u.pn >= 4 && u.pn < 8) ? ksc : 1.f;
            const int ti = 16 * (wc & 1) + 4 * fq;
#pragma unroll
            for (int ai = 0; ai < 2; ++ai)
#pragma unroll
                for (int m = 0; m < 4; ++m) {
                    const int r = row0 + ai * HALF + m * 16;
                    f32x4 cs = (f32x4){1.f, 1.f, 1.f, 1.f}, sn = (f32x4){0.f, 0.f, 0.f, 0.f};
                    if (rope) { const int ntok = r & 8191; const int pos = (wc >> 1) ? (ntok & 63) : (ntok >> 6); cs = *(const f32x4*)(cosT + pos * 32 + ti); sn = *(const f32x4*)(sinT + pos * 32 + ti); }
                    bf16_t* rowp = P + (size_t)r * ldp + col0;
#pragma unroll
                    for (int bj = 0; bj < 2; ++bj) {
                        const f32x4 v0 = acc[ai][bj][m][0], v1 = acc[ai][bj][m][1]; f32x4 o0, o1;
                        o0[0] = v0[0] * cs[0] - v0[1] * sn[0]; o0[1] = v0[0] * sn[0] + v0[1] * cs[0];
                        o0[2] = v0[2] * cs[1] - v0[3] * sn[1]; o0[3] = v0[2] * sn[1] + v0[3] * cs[1];
                        o1[0] = v1[0] * cs[2] - v1[1] * sn[2]; o1[1] = v1[0] * sn[2] + v1[1] * cs[2];
                        o1[2] = v1[2] * cs[3] - v1[3] * sn[3]; o1[3] = v1[2] * sn[3] + v1[3] * cs[3];
                        o0 = o0 * s; o1 = o1 * s;
                        u32x4 w; w.x = cvt_pk_bf16(o0[0], o0[1]); w.y = cvt_pk_bf16(o0[2], o0[3]); w.z = cvt_pk_bf16(o1[0], o1[1]); w.w = cvt_pk_bf16(o1[2], o1[3]);
                        *(u32x4*)(rowp + bj * HALF) = w; }
                }
        } else {
            typedef unsigned u32x2 __attribute__((ext_vector_type(2)));
            const int ch0 = 64 * (u.pn - 12) + 16 * wc + 4 * fq;
            const f32x4 w0 = *(const f32x4*)(convw + ch0), w1 = *(const f32x4*)(convw + nconv + ch0), w2 = *(const f32x4*)(convw + 2 * nconv + ch0);
#pragma unroll
            for (int ai = 0; ai < 2; ++ai) {
                f32x4 cv[4], rr[4], ll[4];
#pragma unroll
                for (int m = 0; m < 4; ++m) { cv[m] = acc[ai][0][m][0] * acc[ai][0][m][1];
#pragma unroll
                    for (int e = 0; e < 4; ++e) { rr[m][e] = dpp_ror1(cv[m][e]); ll[m][e] = dpp_ror15(cv[m][e]); } }
#pragma unroll
                for (int m = 0; m < 4; ++m) {
                    const f32x4 z = (f32x4){0.f, 0.f, 0.f, 0.f};
                    const f32x4 prev = fr > 0 ? rr[m] : (m > 0 ? rr[m > 0 ? m - 1 : 0] : z), next = fr < 15 ? ll[m] : (m < 3 ? ll[m < 3 ? m + 1 : 3] : z);
                    const f32x4 o = acc[ai][1][m][0] * (w0 * prev + w1 * cv[m] + w2 * next);
                    const f32x4 gq = acc[ai][1][m][1]; f32x4 gs;
#pragma unroll
                    for (int e = 0; e < 4; ++e) gs[e] = gq[e] * __builtin_amdgcn_rcpf(1.f + __expf(-gq[e]));
                    const size_t r = (size_t)(row0 + ai * HALF + m * 16);
                    *(u32x2*)(CATc + r * ldcat + ch0) = (u32x2){cvt_pk_bf16(o[0], o[1]), cvt_pk_bf16(o[2], o[3])};
                    *(u32x2*)(GS + r * ldg + ch0) = (u32x2){cvt_pk_bf16(gs[0], gs[1]), cvt_pk_bf16(gs[2], gs[3])};
                }
            }
        }
    }
};
struct EpiRes {
    static constexpr bool PERM = true, AFTER_DRAIN = false, GRIDMAP = false;
    const bf16_t* base; float* out; int ldc; const float* gate; int gate_bstride;
    __device__ __forceinline__ void operator()(const f32x4 (&acc)[2][2][4][2], const Unit& u, int wr, int wc, int fr, int fq) const {
        const int row0 = u.pm * BM + wr * 64 + fr, col0 = u.pn * BM + wc * 32 + 8 * fq;
        const float* gp = gate + (size_t)((u.pm * BM) >> 13) * gate_bstride + col0;
        f32x4 gv[2][2];
#pragma unroll
        for (int bj = 0; bj < 2; ++bj)
#pragma unroll
            for (int n = 0; n < 2; ++n) gv[bj][n] = *(const f32x4*)(gp + bj * HALF + 4 * n);
#pragma unroll
        for (int ai = 0; ai < 2; ++ai) {
            u32x4 bq[4][2];
#pragma unroll
            for (int m = 0; m < 4; ++m)
#pragma unroll
                for (int bj = 0; bj < 2; ++bj) bq[m][bj] = *(const u32x4*)(base + (size_t)(row0 + ai * HALF + m * 16) * ldc + col0 + bj * HALF);
            asm volatile("" ::: "memory");
#pragma unroll
            for (int m = 0; m < 4; ++m) { const size_t off = (size_t)(row0 + ai * HALF + m * 16) * ldc + col0;
#pragma unroll
                for (int bj = 0; bj < 2; ++bj) { const u32x4 q = bq[m][bj];
                    const f32x4 b0 = (f32x4){__builtin_bit_cast(float, q.x << 16), __builtin_bit_cast(float, q.x & 0xffff0000u), __builtin_bit_cast(float, q.y << 16), __builtin_bit_cast(float, q.y & 0xffff0000u)};
                    const f32x4 b1 = (f32x4){__builtin_bit_cast(float, q.z << 16), __builtin_bit_cast(float, q.z & 0xffff0000u), __builtin_bit_cast(float, q.w << 16), __builtin_bit_cast(float, q.w & 0xffff0000u)};
                    *(f32x4*)(out + off + bj * HALF) = b0 + gv[bj][0] * acc[ai][bj][m][0]; *(f32x4*)(out + off + bj * HALF + 4) = b1 + gv[bj][1] * acc[ai][bj][m][1]; } }
            asm volatile("" ::: "memory");
        }
    }
};
struct EpiResNorm {
    static constexpr bool PERM = true, AFTER_DRAIN = false, GRIDMAP = false;
    const float* base; bf16_t* out; int ldc; const float* gate; int gate_bstride; const float* mul; bf16_t* xn; float* rowss;
    __device__ __forceinline__ void operator()(const f32x4 (&acc)[2][2][4][2], const Unit& u, int wr, int wc, int fr, int fq) const {
        const int row0 = u.pm * BM + wr * 64 + fr, col0 = u.pn * BM + wc * 32 + 8 * fq, b = (u.pm * BM) >> 13;
        const float* gp = gate + (size_t)b * gate_bstride + col0; const float* mp = mul + (size_t)b * ldc + col0;
        f32x4 gv[2][2], mvv[2][2];
#pragma unroll
        for (int bj = 0; bj < 2; ++bj)
#pragma unroll
            for (int n = 0; n < 2; ++n) { gv[bj][n] = *(const f32x4*)(gp + bj * HALF + 4 * n); mvv[bj][n] = *(const f32x4*)(mp + bj * HALF + 4 * n); }
#pragma unroll
        for (int hq = 0; hq < 4; ++hq) { const int ai = hq >> 1, m0 = 2 * (hq & 1);
            f32x4 bsv[2][2][2];
#pragma unroll
            for (int mm = 0; mm < 2; ++mm)
#pragma unroll
                for (int bj = 0; bj < 2; ++bj)
#pragma unroll
                    for (int n = 0; n < 2; ++n) bsv[mm][bj][n] = *(const f32x4*)(base + (size_t)(row0 + ai * HALF + (m0 + mm) * 16) * ldc + col0 + bj * HALF + 4 * n);
            asm volatile("" ::: "memory");
#pragma unroll
            for (int mm = 0; mm < 2; ++mm) { const int m = m0 + mm; const int r = row0 + ai * HALF + m * 16; const size_t off = (size_t)r * ldc + col0; float ss = 0.f;
#pragma unroll
                for (int bj = 0; bj < 2; ++bj) {
                    const f32x4 v0 = bsv[mm][bj][0] + gv[bj][0] * acc[ai][bj][m][0], v1 = bsv[mm][bj][1] + gv[bj][1] * acc[ai][bj][m][1];
                    ss += ((v0[0] * v0[0] + v0[1] * v0[1]) + (v0[2] * v0[2] + v0[3] * v0[3])) + ((v1[0] * v1[0] + v1[1] * v1[1]) + (v1[2] * v1[2] + v1[3] * v1[3]));
                    const f32x4 y0 = v0 * mvv[bj][0], y1 = v1 * mvv[bj][1];
                    u32x4 wn; wn.x = cvt_pk_bf16(y0[0], y0[1]); wn.y = cvt_pk_bf16(y0[2], y0[3]); wn.z = cvt_pk_bf16(y1[0], y1[1]); wn.w = cvt_pk_bf16(y1[2], y1[3]);
                    u32x4 wm; wm.x = cvt_pk_bf16(v0[0], v0[1]); wm.y = cvt_pk_bf16(v0[2], v0[3]); wm.z = cvt_pk_bf16(v1[0], v1[1]); wm.w = cvt_pk_bf16(v1[2], v1[3]);
                    *(u32x4*)(xn + off + bj * HALF) = wn; *(u32x4*)(out + off + bj * HALF) = wm; }
                ss += __shfl_xor(ss, 16); ss += __shfl_xor(ss, 32);
                if (fq == 0) rowss[(size_t)r * 32 + 4 * u.pn + wc] = ss; }
            asm volatile("" ::: "memory");
        }
    }
};
struct EpiUp {
    static constexpr bool PERM = true, AFTER_DRAIN = false, GRIDMAP = false;
    bf16_t* O; int ldc; int split_cols; size_t split_stride; const float* bias; int bias_bstride; const PG8_LAS float* rs; int pm_cached; const float* rowss; float inv_d, eps;
    __device__ __forceinline__ void operator()(const f32x4 (&acc)[2][2][4][2], const Unit& u, int wr, int wc, int fr, int fq) const {
        const int row0 = u.pm * BM + wr * 64 + fr; int colt = u.pn * BM; bf16_t* base = O;
        { const int t = colt / split_cols; base += (size_t)t * split_stride; colt -= t * split_cols; }
        const int col0 = colt + wc * 32 + 8 * fq; const float* bp = bias + (size_t)((u.pm * BM) >> 13) * bias_bstride + u.pn * BM + wc * 32 + 8 * fq;
        f32x4 bv[2][2];
#pragma unroll
        for (int bj = 0; bj < 2; ++bj)
#pragma unroll
            for (int n = 0; n < 2; ++n) bv[bj][n] = *(const f32x4*)(bp + bj * HALF + 4 * n);
#pragma unroll
        for (int ai = 0; ai < 2; ++ai)
#pragma unroll
            for (int m = 0; m < 4; ++m) { const int rl = ai * HALF + wr * 64 + m * 16 + fr; const int r = u.pm * BM + rl; float rsv;
                if (u.pm == pm_cached) rsv = rs[rl];
                else { float t = 0.f; for (int i = 0; i < 32; ++i) t += rowss[(size_t)r * 32 + i]; rsv = rsqrtf(t * inv_d + eps); }
                bf16_t* rowp = base + (size_t)r * ldc + col0;
#pragma unroll
                for (int bj = 0; bj < 2; ++bj) { const f32x4 v0 = acc[ai][bj][m][0] * rsv + bv[bj][0], v1 = acc[ai][bj][m][1] * rsv + bv[bj][1];
                    u32x4 w; w.x = cvt_pk_bf16(v0[0], v0[1]); w.y = cvt_pk_bf16(v0[2], v0[3]); w.z = cvt_pk_bf16(v1[0], v1[1]); w.w = cvt_pk_bf16(v1[2], v1[3]);
                    *(u32x4*)(rowp + bj * HALF) = w; } }
    }
};
__device__ __forceinline__ float dpp_ror4(float x)  { return __builtin_bit_cast(float, __builtin_amdgcn_update_dpp(0, __builtin_bit_cast(int, x), 0x124, 0xF, 0xF, false)); }
__device__ __forceinline__ float dpp_ror12(float x) { return __builtin_bit_cast(float, __builtin_amdgcn_update_dpp(0, __builtin_bit_cast(int, x), 0x12C, 0xF, 0xF, false)); }
struct EpiGate {
    static constexpr bool PERM = true, AFTER_DRAIN = false, GRIDMAP = true;
    bf16_t* ACT; int lda; bf16_t* EDGE; const float* bias; int bias_bstride; const float* fcw; const float* fcb; int nch; const PG8_LAS float* rs; int pm_cached; const float* rowss; float inv_d, eps;
    __device__ __forceinline__ void operator()(f32x4 (&acc)[2][2][4][2], const Unit& u, int wr, int wc, int fr, int fq) const {
        asm volatile("" : "+v"(fr), "+v"(fq));
        const int b = u.pm >> 5, rblk = (u.pm >> 3) & 3, cblk = u.pm & 7;
        const int chl = 32 * wc + 8 * fq, ch = 128 * u.pn + chl;
        const int q = fr >> 2, lc = 4 * wr + (fr & 3);
        const size_t tok00 = (size_t)b * 8192 + (size_t)(32 * rblk) * 64 + 8 * cblk + lc;
        {
            const float* bp = bias + (size_t)b * bias_bstride + 256 * u.pn + chl;
            const f32x4 ba0 = *(const f32x4*)(bp), ba1 = *(const f32x4*)(bp + 4), bb0 = *(const f32x4*)(bp + 128), bb1 = *(const f32x4*)(bp + 132);
#pragma unroll
            for (int ai = 0; ai < 2; ++ai)
#pragma unroll
                for (int m = 0; m < 4; ++m) { const int rl = ai * HALF + wr * 64 + m * 16 + fr; const float rsv = rs[rl];
                    acc[ai][0][m][0] = acc[ai][0][m][0] * rsv + ba0; acc[ai][0][m][1] = acc[ai][0][m][1] * rsv + ba1; acc[ai][1][m][0] = acc[ai][1][m][0] * rsv + bb0; acc[ai][1][m][1] = acc[ai][1][m][1] * rsv + bb1; }
        }
        {
            const bool top = fr < 8; const f32x4 a0 = top ? acc[0][0][0][0] : acc[1][0][3][0], a1 = top ? acc[0][0][0][1] : acc[1][0][3][1], b0 = top ? acc[0][1][0][0] : acc[1][1][3][0], b1 = top ? acc[0][1][0][1] : acc[1][1][3][1];
            bf16_t* eb = EDGE + ((size_t)((b * 4 + rblk) * 6) * 64 + (size_t)(8 * cblk + lc)) * nch + ch; const size_t ss = (size_t)64 * nch;
            u32x4 w; w.x = cvt_pk_bf16(a0[0], a0[1]); w.y = cvt_pk_bf16(a0[2], a0[3]); w.z = cvt_pk_bf16(a1[0], a1[1]); w.w = cvt_pk_bf16(a1[2], a1[3]);
            *(u32x4*)(eb + (size_t)q * ss) = w;
            if (q == 0 || q == 3) { u32x4 v; v.x = cvt_pk_bf16(b0[0], b0[1]); v.y = cvt_pk_bf16(b0[2], b0[3]); v.z = cvt_pk_bf16(b1[0], b1[1]); v.w = cvt_pk_bf16(b1[2], b1[3]); *(u32x4*)(eb + (size_t)(q == 0 ? 4 : 5) * ss) = v; }
        }
#pragma unroll
        for (int n = 0; n < 2; ++n) {
            const f32x4 w0 = *(const f32x4*)(fcw + ch + 4 * n), w1 = *(const f32x4*)(fcw + nch + ch + 4 * n), w2 = *(const f32x4*)(fcw + 2 * nch + ch + 4 * n), cb = *(const f32x4*)(fcb + ch + 4 * n);
#pragma unroll
            for (int e = 0; e < 4; ++e) {
                float r4[2][4], r12[2][4];
#pragma unroll
                for (int ai = 0; ai < 2; ++ai)
#pragma unroll
                    for (int m = 0; m < 4; ++m) { r4[ai][m] = dpp_ror4(acc[ai][0][m][n][e]); r12[ai][m] = dpp_ror12(acc[ai][0][m][n][e]); }
#pragma unroll
                for (int ai = 0; ai < 2; ++ai)
#pragma unroll
                    for (int m = 0; m < 4; ++m) {
                        const float up = q > 0 ? r4[ai][m] : (m > 0 ? r4[ai][m > 0 ? m - 1 : 0] : (ai > 0 ? r4[0][3] : 0.f));
                        const float dn = q < 3 ? r12[ai][m] : (m < 3 ? r12[ai][m < 3 ? m + 1 : 3] : (ai < 1 ? r12[1][0] : 0.f));
                        const float cv = w0[e] * up + w1[e] * acc[ai][0][m][n][e] + w2[e] * dn + cb[e];
                        float res = cv * __builtin_amdgcn_rcpf(1.f + __expf(-cv)) * acc[ai][1][m][n][e];
                        asm volatile("" : "+v"(res));
                        acc[ai][0][m][n][e] = res;
                    }
                __builtin_amdgcn_sched_barrier(0);
            }
        }
#pragma unroll
        for (int ai = 0; ai < 2; ++ai)
#pragma unroll
            for (int m = 0; m < 4; ++m) { const int lr = 16 * ai + 4 * m + q;
                if (lr != 0 && lr != 31) { const f32x4 v0 = acc[ai][0][m][0], v1 = acc[ai][0][m][1];
                    u32x4 w; w.x = cvt_pk_bf16(v0[0], v0[1]); w.y = cvt_pk_bf16(v0[2], v0[3]); w.z = cvt_pk_bf16(v1[0], v1[1]); w.w = cvt_pk_bf16(v1[2], v1[3]);
                    *(u32x4*)(ACT + (tok00 + (size_t)lr * 64) * lda + ch) = w; } }
    }
};
struct EpiNull {
    static constexpr bool PERM = true, AFTER_DRAIN = false, GRIDMAP = false;
    __device__ __forceinline__ void operator()(const f32x4 (&acc)[2][2][4][2], const Unit&, int, int, int, int) const {
#pragma unroll
        for (int ai = 0; ai < 2; ++ai)
#pragma unroll
            for (int bj = 0; bj < 2; ++bj)
#pragma unroll
                for (int m = 0; m < 4; ++m)
#pragma unroll
                    for (int n = 0; n < 2; ++n) asm volatile("" :: "v"(acc[ai][bj][m][n]));
    }
};
struct SameTileOrder : StaticOrder {
    __host__ __device__ bool next(int i, Unit& u) const { const long L = (long)i * G + c; if (L >= nwg) return false; u.pm = 0; u.pn = c % nN; return true; }
};
template <class Epi, class Sched, bool ALIGN_EPI = false, bool SP2 = false>
__device__ __forceinline__ void gemm_phase(PG8_LAS unsigned char* lds, const Gemm g, const Sched& S, const Epi& E) {
    const int tid = threadIdx.x, wid = __builtin_amdgcn_readfirstlane(tid >> 6), lane = tid & 63, wr = wid >> 2, wc = wid & 3, fr = lane & 15, fq = lane >> 4;
    const int K = g.K, nt = K / BK;
    unsigned voffA[2], voffB[2];
#pragma unroll
    for (int i = 0; i < 2; ++i) { int R, C; stage_rc(tid * 16 + i * 8192, R, C); const int Rb = Epi::PERM ? ((R & ~31) + perm32(R & 31)) : R;
        const int Ra = Epi::GRIDMAP ? ((4 * ((R >> 4) & 3) + ((R & 15) >> 2)) * 64 + 4 * (R >> 6) + (R & 3)) : R;
        voffA[i] = (unsigned)(Ra * K + C) * 2u; voffB[i] = (unsigned)(Rb * K + C) * 2u; }
    const size_t kstep = (size_t)(BK * 2);
    const size_t hstep = (size_t)HALF * K * 2;
    const size_t tstep = 2 * hstep;
    const size_t hstepA = Epi::GRIDMAP ? (size_t)1024 * K * 2 : hstep;
#define PG8_ABASE(pm_) ((const char*)g.A + (Epi::GRIDMAP ? (size_t)(((pm_) >> 5) * 8192 + (((pm_) >> 3) & 3) * 2048 + ((pm_) & 7) * 8) * K * 2 : (size_t)(pm_) * tstep))
    const unsigned ldsw = (unsigned)wid * 1024u;
    const int aoff = lds_byte(wr * 64 + fr, fq * 8), boff = lds_byte(wc * 32 + fr, fq * 8);
#define PG8_SA(b, h) (((b) * 2 + (h)) * HTB)
#define PG8_SB(b, h) ((4 + (b) * 2 + (h)) * HTB)
#define PG8_STAGE(bufoff, gbase, voff) do { _Pragma("unroll") for (int _i = 0; _i < 2; ++_i) \
        __builtin_amdgcn_global_load_lds((const unsigned*)((const char*)(gbase) + (voff)[_i]), (PG8_LAS unsigned*)(lds + (bufoff) + ldsw + _i * 8192), 16, 0, 0); } while (0)
#define PG8_LDA(dst, b, h) do { _Pragma("unroll") for (int m = 0; m < 4; ++m) _Pragma("unroll") for (int k = 0; k < 2; ++k) dst[m][k] = *(const PG8_LAS bf16x8*)(lds + PG8_SA(b, h) + aoff + m * 2048 + k * 1024); } while (0)
#define PG8_LDB(dst, b, h) do { _Pragma("unroll") for (int n = 0; n < 2; ++n) _Pragma("unroll") for (int k = 0; k < 2; ++k) dst[n][k] = *(const PG8_LAS bf16x8*)(lds + PG8_SB(b, h) + boff + n * 2048 + k * 1024); } while (0)
#define PG8_MMA(ai, bj, At, Bt) do { __builtin_amdgcn_s_setprio(1); _Pragma("unroll") for (int m = 0; m < 4; ++m) _Pragma("unroll") for (int n = 0; n < 2; ++n) _Pragma("unroll") for (int k = 0; k < 2; ++k) \
        acc[ai][bj][m][n] = __builtin_amdgcn_mfma_f32_16x16x32_bf16(Bt[n][k], At[m][k], acc[ai][bj][m][n], 0, 0, 0); __builtin_amdgcn_s_setprio(0); } while (0)
#define PG8_WAIT_V(n) asm volatile("s_waitcnt vmcnt(" #n ")" ::: "memory")
#define PG8_WAIT_L(n) asm volatile("s_waitcnt lgkmcnt(" #n ")" ::: "memory")
#define PG8_BAR __builtin_amdgcn_s_barrier()
#define PG8_SCHED __builtin_amdgcn_sched_barrier(0)
    Unit cur, nxt; int ui = 0;
    if (!S.next(0, cur)) return;
    f32x4 acc[2][2][4][2];
#pragma unroll
    for (int a = 0; a < 2; ++a)
#pragma unroll
        for (int b = 0; b < 2; ++b)
#pragma unroll
            for (int m = 0; m < 4; ++m)
#pragma unroll
                for (int n = 0; n < 2; ++n) acc[a][b][m][n] = (f32x4){0.f, 0.f, 0.f, 0.f};
    bf16x8 At[4][2], B0[2][2], B1[2][2];
    const char* cA = PG8_ABASE(cur.pm); const char* cB = (const char*)g.Bt + (size_t)cur.pn * tstep;
    S.a_ready(cur);
    if constexpr (SP2) {
        PG8_STAGE(PG8_SB(0, 0), cB, voffB); PG8_STAGE(PG8_SB(0, 1), cB + hstep, voffB); PG8_STAGE(PG8_SA(0, 0), cA, voffA); PG8_STAGE(PG8_SA(0, 1), cA + hstepA, voffA);
        if (wr == 1) PG8_BAR;
        PG8_WAIT_V(2); PG8_BAR;
        PG8_STAGE(PG8_SB(1, 0), cB + kstep, voffB); PG8_STAGE(PG8_SA(1, 0), cA + kstep, voffA); PG8_STAGE(PG8_SB(1, 1), cB + hstep + kstep, voffB);
        PG8_WAIT_V(6); PG8_BAR;
    } else {
        PG8_STAGE(PG8_SB(0, 0), cB, voffB); PG8_STAGE(PG8_SA(0, 0), cA, voffA); PG8_STAGE(PG8_SB(0, 1), cB + hstep, voffB); PG8_STAGE(PG8_SA(0, 1), cA + hstepA, voffA);
        if (wr == 1) PG8_BAR;
        PG8_WAIT_V(4); PG8_BAR;
        PG8_STAGE(PG8_SB(1, 0), cB + kstep, voffB); PG8_STAGE(PG8_SA(1, 0), cA + kstep, voffA); PG8_STAGE(PG8_SB(1, 1), cB + hstep + kstep, voffB);
        PG8_WAIT_V(6); PG8_BAR;
    }
    for (;;) {
        const bool has_next = S.next(ui + 1, nxt);
        const char* nA = has_next ? PG8_ABASE(nxt.pm) : cA; const char* nB = has_next ? (const char*)g.Bt + (size_t)nxt.pn * tstep : cB;
        for (int t = 0; t < nt; t += 2) {
            const bool last = (t == nt - 2);
            const char* a1 = cA + (size_t)(t + 1) * kstep;
            const char* a2 = last ? nA : cA + (size_t)(t + 2) * kstep; const char* b2 = last ? nB : cB + (size_t)(t + 2) * kstep;
            const char* a3 = a2 + kstep; const char* b3 = b2 + kstep;
            if (last && has_next) S.a_ready(nxt);
            if constexpr (SP2) {
            PG8_LDB(B0, 0, 0); PG8_LDB(B1, 0, 1); PG8_SCHED; PG8_LDA(At, 0, 0); PG8_STAGE(PG8_SA(1, 1), a1 + hstepA, voffA);
            PG8_WAIT_V(8); PG8_WAIT_L(0); PG8_BAR; PG8_MMA(0, 0, At, B0); PG8_MMA(0, 1, At, B1); PG8_BAR; PG8_SCHED;
            PG8_LDA(At, 0, 1); PG8_STAGE(PG8_SB(0, 0), b2, voffB); PG8_STAGE(PG8_SB(0, 1), b2 + hstep, voffB); PG8_STAGE(PG8_SA(0, 0), a2, voffA);
            PG8_WAIT_V(8); PG8_WAIT_L(0); PG8_BAR; PG8_MMA(1, 0, At, B0); PG8_MMA(1, 1, At, B1); PG8_BAR; PG8_SCHED;
            PG8_LDB(B0, 1, 0); PG8_LDB(B1, 1, 1); PG8_SCHED; PG8_LDA(At, 1, 0); PG8_STAGE(PG8_SA(0, 1), a2 + hstepA, voffA);
            PG8_WAIT_V(8); PG8_WAIT_L(0); PG8_BAR; PG8_MMA(0, 0, At, B0); PG8_MMA(0, 1, At, B1); PG8_BAR; PG8_SCHED;
            PG8_LDA(At, 1, 1); PG8_STAGE(PG8_SB(1, 0), b3, voffB); PG8_STAGE(PG8_SB(1, 1), b3 + hstep, voffB); PG8_STAGE(PG8_SA(1, 0), a3, voffA);
            PG8_WAIT_V(8); PG8_WAIT_L(0); PG8_BAR; PG8_MMA(1, 0, At, B0); PG8_MMA(1, 1, At, B1); PG8_BAR; PG8_SCHED;
            } else {
            PG8_LDB(B0, 0, 0); PG8_SCHED; PG8_LDA(At, 0, 0); PG8_STAGE(PG8_SA(1, 1), a1 + hstepA, voffA);
            PG8_WAIT_L(8); PG8_BAR; PG8_WAIT_L(0); PG8_MMA(0, 0, At, B0); PG8_BAR; PG8_SCHED;
            PG8_LDB(B1, 0, 1); PG8_STAGE(PG8_SB(0, 0), b2, voffB);
            PG8_BAR; PG8_WAIT_L(0); PG8_MMA(0, 1, At, B1); PG8_BAR;
            PG8_LDA(At, 0, 1); PG8_STAGE(PG8_SA(0, 0), a2, voffA);
            PG8_BAR; PG8_WAIT_L(0); PG8_MMA(1, 0, At, B0); PG8_BAR; PG8_SCHED;
            PG8_STAGE(PG8_SB(0, 1), b2 + hstep, voffB);
            PG8_WAIT_V(6); PG8_BAR; PG8_MMA(1, 1, At, B1); PG8_BAR;
            PG8_LDB(B0, 1, 0); PG8_SCHED; PG8_LDA(At, 1, 0); PG8_STAGE(PG8_SA(0, 1), a2 + hstepA, voffA);
            PG8_WAIT_L(8); PG8_BAR; PG8_WAIT_L(0); PG8_MMA(0, 0, At, B0); PG8_BAR; PG8_SCHED;
            PG8_LDB(B1, 1, 1); PG8_STAGE(PG8_SB(1, 0), b3, voffB);
            PG8_BAR; PG8_WAIT_L(0); PG8_MMA(0, 1, At, B1); PG8_BAR;
            PG8_LDA(At, 1, 1); PG8_STAGE(PG8_SA(1, 0), a3, voffA);
            PG8_BAR; PG8_WAIT_L(0); PG8_MMA(1, 0, At, B0); PG8_BAR; PG8_SCHED;
            PG8_STAGE(PG8_SB(1, 1), b3 + hstep, voffB);
            PG8_WAIT_V(6); PG8_BAR; PG8_MMA(1, 1, At, B1); PG8_BAR;
            }
        }
        if constexpr (ALIGN_EPI) { if (wr == 0) PG8_BAR; }
        if constexpr (!Epi::AFTER_DRAIN) { E(acc, cur, wr, wc, fr, fq); S.done(cur); }
        if (!has_next) break;
#pragma unroll
        for (int a = 0; a < 2; ++a)
#pragma unroll
            for (int b = 0; b < 2; ++b)
#pragma unroll
                for (int m = 0; m < 4; ++m)
#pragma unroll
                    for (int n = 0; n < 2; ++n) acc[a][b][m][n] = (f32x4){0.f, 0.f, 0.f, 0.f};
        cur = nxt; cA = nA; cB = nB; ++ui;
        if constexpr (ALIGN_EPI) { if (wr == 1) PG8_BAR; }
    }
    PG8_WAIT_V(0);
    if constexpr (!ALIGN_EPI) { if (wr == 0) PG8_BAR; }
    PG8_BAR;
#undef PG8_ABASE
#undef PG8_SA
#undef PG8_SB
#undef PG8_STAGE
#undef PG8_LDA
#undef PG8_LDB
#undef PG8_MMA
#undef PG8_WAIT_V
#undef PG8_WAIT_L
#undef PG8_BAR
#undef PG8_SCHED
}
}

constexpr int NWAVES = 8, NTHR = 512;
constexpr int BATCH = 2, SEQ = 8192, D = 2048, M = BATCH * SEQ, CTXL = 256, MC = BATCH * CTXL;
constexpr int RW = 1024, NH = 8, DH = 128, CCH = 1024, INW = 7168, DFF = 5632, NUP = 2 * DFF, NCHK = 64, CHK = 128;
constexpr int NMOD = 6 * D;
constexpr int PLD = 3 * RW;
constexpr float EPS = 1e-6f;
constexpr float KSCALE = 0.08838834764831845f;
constexpr int NSL = 8;

constexpr size_t MiB = 1u << 20;
constexpr size_t WS_CTL = 0, CTL_ZERO_BYTES = 1 * MiB;
constexpr size_t WS_COS = 1 * MiB, WS_SIN = WS_COS + 16384, WS_PW = WS_COS + 32768, WS_MODF = WS_COS + 65536, WS_MUL2 = WS_COS + 212992, WS_BIAS2 = WS_COS + 229376, WS_MODP = WS_COS + 524288;
constexpr int PWS = 260;
constexpr size_t WS_WOUT = 4 * MiB, WS_WUP = 12 * MiB, WS_WDN = 56 * MiB, WS_XN = 78 * MiB, WS_HC = 142 * MiB, WS_KVC = 144 * MiB, WS_BIG = 146 * MiB;
constexpr size_t WS_P = WS_BIG, WS_GS = WS_BIG + 96 * MiB  , WS_CAT = WS_BIG + 224 * MiB, WS_WIN = WS_BIG + 128 * MiB  , WS_UA = WS_BIG, WS_UB = WS_BIG + 176 * MiB;
constexpr size_t WS_SPV = WS_BIG + 288 * MiB;
constexpr size_t WS_CTXS = WS_BIG + 352 * MiB;
constexpr size_t WS_ROWSS = WS_CTXS + 4 * MiB;
constexpr size_t WS_END = WS_ROWSS + 2 * MiB;
static_assert(WS_MODP + (size_t)NSL * 3 * NMOD * 4 <= WS_WOUT && WS_BIAS2 + 2 * (size_t)NUP * 4 <= WS_MODP && WS_MUL2 + 2 * D * 4 <= WS_BIAS2 && WS_MODF + 3 * (size_t)NMOD * 4 <= WS_MUL2, "tables");
constexpr int CW_BAR = 4096;

constexpr int LDS_BYTES = 147456;
constexpr int MISC_OFF = LDS_BYTES - 256;

#define GAS __attribute__((address_space(1)))
#define LAS __attribute__((address_space(3)))
typedef unsigned short bf16;
typedef unsigned v4u __attribute__((ext_vector_type(4)));
typedef unsigned v2u __attribute__((ext_vector_type(2)));
typedef float f32x4 __attribute__((ext_vector_type(4)));
typedef GAS unsigned gu32;
#define LDS_WAIT() asm volatile("s_waitcnt lgkmcnt(0)" ::: "memory")
#define VM_WAIT() asm volatile("s_waitcnt vmcnt(0)" ::: "memory")
__device__ __forceinline__ unsigned f2bf(float f) { unsigned u = __builtin_bit_cast(unsigned, f); return (u + 0x7fffu + ((u >> 16) & 1u)) >> 16; }
__device__ __forceinline__ unsigned pk2(float lo, float hi) { return f2bf(lo) | (f2bf(hi) << 16); }
__device__ __forceinline__ float bflo(unsigned w) { return __builtin_bit_cast(float, w << 16); }
__device__ __forceinline__ float bfhi(unsigned w) { return __builtin_bit_cast(float, w & 0xffff0000u); }
__device__ __forceinline__ float bf1(bf16 h) { return __builtin_bit_cast(float, ((unsigned)h) << 16); }
__device__ __forceinline__ float silu_f(float x) { return x * __builtin_amdgcn_rcpf(1.f + __expf(-x)); }
__device__ __forceinline__ float wave_sum(float v) {
#pragma unroll
    for (int o = 1; o < 64; o <<= 1) v += __shfl_xor(v, o);
    return v;
}


typedef short s16x4 __attribute__((ext_vector_type(4)));
typedef short bf16x8 __attribute__((ext_vector_type(8)));
__device__ __forceinline__ unsigned off_b(unsigned row, unsigned ch) { return 256u * row + 16u * (ch ^ (((row & 3u) << 2) | ((row >> 2) & 3u))); }
__device__ __forceinline__ s16x4 tr_rd(LAS unsigned char* p) { return __builtin_bit_cast(s16x4, __builtin_amdgcn_ds_read_tr16_b64_v4i16((LAS s16x4*)p)); }
__device__ __forceinline__ bf16x8 tr_frag(LAS unsigned char* img, unsigned lane, unsigned Ra, unsigned Rb, unsigned c) {
    const unsigned q = (lane & 15u) >> 2, p = lane & 3u;
    const s16x4 lo = tr_rd(img + off_b(Ra + q, 2u * c + (p >> 1)) + 8u * (p & 1u));
    const s16x4 hi = tr_rd(img + off_b(Rb + q, 2u * c + (p >> 1)) + 8u * (p & 1u));
    return __builtin_shufflevector(lo, hi, 0, 1, 2, 3, 4, 5, 6, 7);
}
__device__ __forceinline__ bf16x8 row_frag(LAS unsigned char* img, unsigned lane, unsigned rb, unsigned s_) { return *(const LAS bf16x8*)(img + off_b(16u * rb + (lane & 15u), 4u * s_ + (lane >> 4))); }
__device__ __forceinline__ v4u scale_pk8(v4u q, float w) { v4u o; o.x = pk2(bflo(q.x) * w, bfhi(q.x) * w); o.y = pk2(bflo(q.y) * w, bfhi(q.y) * w); o.z = pk2(bflo(q.z) * w, bfhi(q.z) * w); o.w = pk2(bflo(q.w) * w, bfhi(q.w) * w); return o; }

#define XB_TMO      128
#define XB_XCNT(j)  (256  + 64 * (j))
#define XB_XSUB(j)  (1280 + 64 * (j))
#define XB_XGEN(j)  (2304 + 64 * (j))
#define XB_TOP      3328
#define XB_TOPGEN   3392
#define XCD_BAR_WORDS 3456
#define XB_SPIN_CAP (1u << 18)
__device__ __forceinline__ unsigned xb_ld(unsigned* p)              { return __hip_atomic_load(p, __ATOMIC_RELAXED, __HIP_MEMORY_SCOPE_AGENT); }
__device__ __forceinline__ unsigned xb_add(unsigned* p, unsigned v) { return __hip_atomic_fetch_add(p, v, __ATOMIC_RELAXED, __HIP_MEMORY_SCOPE_AGENT); }
__device__ __forceinline__ unsigned xb_xcc_id() { return (unsigned)__builtin_amdgcn_s_getreg((3 << 11) | 20) & 0xFu; }
#define XB_SPIN(cond, bar) do { unsigned _sp = 0; while (cond) { __builtin_amdgcn_s_sleep(1); \
    if ((++_sp & 255u) == 0u) { if (xb_ld(&(bar)[XB_TMO])) break; if (_sp > XB_SPIN_CAP) { atomicAdd(&(bar)[XB_TMO], 1u); break; } } } } while (0)
struct XcdBarrier { unsigned* bar; unsigned x; volatile LAS unsigned* st; };
__device__ __forceinline__ XcdBarrier xcd_barrier_post(unsigned* bar, volatile LAS unsigned* st) {
    XcdBarrier b; b.bar = bar; b.x = xb_xcc_id(); b.st = st;
    if (threadIdx.x == 0) (void)xb_add(&bar[XB_XCNT(b.x)], 1u);
    return b;
}
__device__ __forceinline__ void xcd_barrier_complete(unsigned* bar, unsigned x, unsigned& nloc, unsigned& nx) {
    const unsigned G = gridDim.x * gridDim.y * gridDim.z;
    unsigned sum, cnt, mine, sp = 0u;
    for (;;) {
        sum = 0u; cnt = 0u; mine = 0u;
#pragma unroll
        for (unsigned j = 0; j < 16; ++j) { const unsigned c = xb_ld(&bar[XB_XCNT(j)]); sum += c; cnt += (c > 0u) ? 1u : 0u; mine = (j == x) ? c : mine; }
        if (sum == G) break;
        __builtin_amdgcn_s_sleep(1);
        if ((++sp & 255u) == 0u) { if (xb_ld(&bar[XB_TMO])) break; if (sp > XB_SPIN_CAP) { atomicAdd(&bar[XB_TMO], 1u); break; } }
    }
    nloc = mine > 0u ? mine : 1u; nx = cnt > 0u ? cnt : 1u;
}
__device__ __forceinline__ void xcd_barrier(const XcdBarrier& b) {
    asm volatile("s_waitcnt vmcnt(0)" ::: "memory");
    __syncthreads();
    if (threadIdx.x == 0) {
        unsigned* bar = b.bar;
        __builtin_amdgcn_s_waitcnt(0);
        unsigned nloc = b.st[0], nx = b.st[1];
        if (nloc == 0u) { xcd_barrier_complete(bar, b.x, nloc, nx); b.st[0] = nloc; b.st[1] = nx; }
        const unsigned old = xb_add(&bar[XB_XSUB(b.x)], 1u);
        const unsigned gen = old / nloc;
        if (old + 1u == (gen + 1u) * nloc) {
            __builtin_amdgcn_fence(__ATOMIC_RELEASE, "agent");
            asm volatile("s_waitcnt vmcnt(0)" ::: "memory");
            const unsigned og = xb_add(&bar[XB_TOP], 1u);
            const unsigned tg = og / nx;
            if (og + 1u == (tg + 1u) * nx) xb_add(&bar[XB_TOPGEN], 1u);
            else XB_SPIN(xb_ld(&bar[XB_TOPGEN]) == tg, bar);
            __builtin_amdgcn_fence(__ATOMIC_ACQUIRE, "agent");
            xb_add(&bar[XB_XGEN(b.x)], 1u);
            asm volatile("s_waitcnt vmcnt(0)" ::: "memory");
        } else {
            XB_SPIN(xb_ld(&bar[XB_XGEN(b.x)]) == gen, bar);
            __builtin_amdgcn_fence(__ATOMIC_ACQUIRE, "agent");
            asm volatile("s_waitcnt vmcnt(0)" ::: "memory");
        }
    }
    __syncthreads();
}

struct Args { const float* in[18]; float* out; unsigned char* ws; int ph_lo, ph_hi; };
enum { IN_X = 0, IN_C, IN_CTX, IN_CCTX, IN_WMOD, IN_BMOD, IN_G1, IN_WIN, IN_DECF, IN_DECB, IN_CONVW, IN_WOUT, IN_G2, IN_WUP, IN_FCW, IN_FCB, IN_WDN, IN_GF };
enum { PH_PRO = 0, PH_NORM1, PH_GEMM_IN, PH_KV, PH_SCAN, PH_RETOUT, PH_GEMM_OUT, PH_NORM2, PH_GEMM_UP, PH_GATE, PH_GEMM_DN, PH_FNORM, NPH };

template <int PERMQK  >
__device__ __forceinline__ void p0_transpose_item(const float* W, int K, int N, bf16* WT, LAS float* scr, int item, int lane) {
    const int nkb = K / 64, kb = item % nkb, nb = item / nkb, k0 = 64 * kb, n0 = 64 * nb;
    f32x4 v[16];
#pragma unroll
    for (int i = 0; i < 16; ++i) v[i] = *(const f32x4*)(W + (size_t)(k0 + 4 * i + (lane >> 4)) * N + n0 + 4 * (lane & 15));
#pragma unroll
    for (int i = 0; i < 16; ++i) { LAS float* d = scr + (4 * i + (lane >> 4)) * 65 + 4 * (lane & 15); d[0] = v[i].x; d[1] = v[i].y; d[2] = v[i].z; d[3] = v[i].w; }
    LDS_WAIT(); asm volatile("" ::: "memory");
    const int c = lane & 7;
#pragma unroll
    for (int j = 0; j < 8; ++j) { const int n = (lane >> 3) + 8 * j; const LAS float* s = scr + (8 * c) * 65 + n;
        v4u o; o.x = pk2(s[0 * 65], s[1 * 65]); o.y = pk2(s[2 * 65], s[3 * 65]); o.z = pk2(s[4 * 65], s[5 * 65]); o.w = pk2(s[6 * 65], s[7 * 65]);
        int ng = n0 + n;
        if (PERMQK == 2) { const int c = ng < DFF ? ng : ng - DFF; ng = 256 * (c >> 7) + (ng < DFF ? 0 : 128) + (c & 127); }
        if (PERMQK == 1) {
            if (ng < 2 * RW) ng = (ng & ~63) + 2 * (ng & 31) + ((ng >> 5) & 1);
            else if (ng >= 3 * RW) {
                const int sec = (ng - 3 * RW) >> 10, c = (ng - 3 * RW) & 1023, t = c >> 6, r = c & 63;
                const int lanecol = 32 * (r >> 4) + 8 * ((r >> 2) & 3) + (r & 3);
                ng = 256 * (12 + t) + lanecol + (sec == 0 ? 128 + 4 : sec == 1 ? 128 : sec == 2 ? 0 : 4); }
        }
        *(GAS v4u*)(WT + (size_t)ng * K + k0 + 8 * c) = o; }
    LDS_WAIT(); asm volatile("" ::: "memory");
}

__device__ __forceinline__ void norm_row_bf16(const float* xrow, bf16* orow, const LAS float* mulT, const LAS float* addT, int lane) {
    const GAS f32x4* xr = (const GAS f32x4*)xrow + lane;
    f32x4 v[8]; float s = 0.f;
#pragma unroll
    for (int j = 0; j < 8; ++j) { v[j] = xr[64 * j]; s += (v[j].x * v[j].x + v[j].y * v[j].y) + (v[j].z * v[j].z + v[j].w * v[j].w); }
    const float rstd = rsqrtf(wave_sum(s) * (1.f / D) + EPS);
    GAS v2u* o8 = (GAS v2u*)orow + lane;
#pragma unroll
    for (int j = 0; j < 8; ++j) { const f32x4 mu = *(const LAS f32x4*)(mulT + 4 * (lane + 64 * j)), ad = *(const LAS f32x4*)(addT + 4 * (lane + 64 * j));
        const f32x4 y = v[j] * rstd * mu + ad; v2u w; w.x = pk2(y.x, y.y); w.y = pk2(y.z, y.w); o8[64 * j] = w; }
}

__global__ void __launch_bounds__(NTHR, 2) fwd_kernel(Args args) {
    extern __shared__ __attribute__((aligned(16))) unsigned char lds_raw[];
    LAS unsigned char* lds = (LAS unsigned char*)lds_raw;
    volatile LAS unsigned* MISC = (volatile LAS unsigned*)(lds + MISC_OFF);
    const int tid = threadIdx.x, lane = tid & 63, wave = __builtin_amdgcn_readfirstlane(tid >> 6);
    const int G = gridDim.x, bx = blockIdx.x;
    const int gw = bx * NWAVES + wave, NGW = G * NWAVES;
    const int gtid = bx * NTHR + tid, NGT = G * NTHR;
    unsigned char* ws = args.ws;
    const float* x = args.in[IN_X]; float* out = args.out;
    float* COS = (float*)(ws + WS_COS); float* SIN = (float*)(ws + WS_SIN); float* PW = (float*)(ws + WS_PW);
    float* MODF = (float*)(ws + WS_MODF); float* MODP = (float*)(ws + WS_MODP); float* MUL2 = (float*)(ws + WS_MUL2); float* BIAS2 = (float*)(ws + WS_BIAS2); float* ROWSS = (float*)(ws + WS_ROWSS);
    bf16* WIN_T = (bf16*)(ws + WS_WIN); bf16* WOUT_T = (bf16*)(ws + WS_WOUT); bf16* WUP_T = (bf16*)(ws + WS_WUP); bf16* WDN_T = (bf16*)(ws + WS_WDN);
    bf16* XN = (bf16*)(ws + WS_XN); bf16* HC = (bf16*)(ws + WS_HC); bf16* KVC = (bf16*)(ws + WS_KVC);
    bf16* ACT = (bf16*)(ws + WS_UA); bf16* EDGE = (bf16*)(ws + WS_UB);
    bf16* P = (bf16*)(ws + WS_P); bf16* GS = (bf16*)(ws + WS_GS); bf16* CAT = (bf16*)(ws + WS_CAT); bf16* UA = (bf16*)(ws + WS_UA); bf16* UB = (bf16*)(ws + WS_UB);
    float* CTXS = (float*)(ws + WS_CTXS); bf16* SPV = (bf16*)(ws + WS_SPV); bf16* XM = (bf16*)(ws + WS_SPV);
    bf16* KVS = (bf16*)out;

    if (tid < 64) MISC[tid] = 0u;
    __syncthreads();
#if ONE_LAUNCH
    XcdBarrier bar = xcd_barrier_post((unsigned*)(ws + WS_CTL) + CW_BAR, MISC + 8);
#define GRID_BAR() xcd_barrier(bar)
#else
#define GRID_BAR() do {} while (0)
#endif
    const int lo = args.ph_lo, hi = args.ph_hi;
#ifndef PHMASK
#define PHMASK 0xFFF
#endif
#define IN(k) (((PHMASK >> (k)) & 1) && lo <= (k) && (k) < hi)
#define BOTH(k) (IN(k) && IN((k) + 1))
#ifndef REP_MASK
#define REP_MASK 0
#endif
#define REPS(k) ((((REP_MASK) >> (k)) & 1) + 1)
#ifndef TIME_PHASE
#define TIME_PHASE -1
#endif
    unsigned long long tp_a = 0, tp_b = 0;
#define TP_BEGIN(k) do { if (TIME_PHASE == (k)) tp_a = __builtin_amdgcn_s_memrealtime(); } while (0)
#define TP_END(k) do { if (TIME_PHASE == (k)) tp_b = __builtin_amdgcn_s_memrealtime(); } while (0)
#ifndef GEMM_REP_SEL
#define GEMM_REP_SEL 0
#endif
#define GEMM_REP_ID 15

    if (IN(PH_PRO)) { TP_BEGIN(PH_PRO);
      for (int rep_ = 0; rep_ < REPS(PH_PRO); ++rep_) {
        LAS float* scr = (LAS float*)(lds + wave * 16640);
        constexpr int I_IN = (D / 64) * (INW / 64), I_OUT = (D / 64) * (D / 64), I_UP = (D / 64) * (NUP / 64), I_DN = (DFF / 64) * (D / 64), I_GV = NSL * (NMOD / 64);
        constexpr int NIT = I_IN + I_OUT + I_UP + I_DN + I_GV;
        for (int it = gw; it < NIT; it += NGW) {
            int r = it;
            if (r < I_GV) {
                const int s = r / (NMOD / 64), col = (r % (NMOD / 64)) * 64 + lane;
                float a0 = 0.f, a1 = 0.f, a2 = 0.f;
                for (int kb = 0; kb < 4; ++kb) {
                    const int kbase = s * 256 + kb * 64;
                    const float c0 = silu_f(args.in[IN_C][kbase + lane]), c1 = silu_f(args.in[IN_C][D + kbase + lane]), c2 = silu_f(args.in[IN_CCTX][kbase + lane]);
                    const float* wp = args.in[IN_WMOD] + (size_t)kbase * NMOD + col;
                    float wv[64];
#pragma unroll
                    for (int kk = 0; kk < 64; ++kk) wv[kk] = wp[(size_t)kk * NMOD];
#pragma unroll
                    for (int kk = 0; kk < 64; ++kk) {
                        a0 += wv[kk] * __builtin_bit_cast(float, __builtin_amdgcn_readlane(__builtin_bit_cast(int, c0), kk));
                        a1 += wv[kk] * __builtin_bit_cast(float, __builtin_amdgcn_readlane(__builtin_bit_cast(int, c1), kk));
                        a2 += wv[kk] * __builtin_bit_cast(float, __builtin_amdgcn_readlane(__builtin_bit_cast(int, c2), kk));
                    }
                }
                MODP[((size_t)(s * 3 + 0)) * NMOD + col] = a0; MODP[((size_t)(s * 3 + 1)) * NMOD + col] = a1; MODP[((size_t)(s * 3 + 2)) * NMOD + col] = a2;
                continue;
            }
            r -= I_GV;
            if (r < I_IN) { p0_transpose_item<1>(args.in[IN_WIN], D, INW, WIN_T, scr, r, lane); continue; } r -= I_IN;
            if (r < I_OUT) { p0_transpose_item<0>(args.in[IN_WOUT], D, D, WOUT_T, scr, r, lane); continue; } r -= I_OUT;
            if (r < I_UP) { p0_transpose_item<2>(args.in[IN_WUP], D, NUP, WUP_T, scr, r, lane); continue; } r -= I_UP;
            p0_transpose_item<0>(args.in[IN_WDN], DFF, D, WDN_T, scr, r, lane);
        }
        if (gtid < 4096) { const int pos = gtid >> 5, i = gtid & 31; const float fr = powf(10000.f, -(float)i / 32.f); const float ang = (float)pos * fr; COS[gtid] = cosf(ang); SIN[gtid] = sinf(ang); }
        else if (gtid < 4096 + 2 * NH * 257) { const int idx = gtid - 4096, dir = idx / (NH * 257), h = (idx / 257) % NH, k = idx % 257;
            const float lg0 = args.in[dir ? IN_DECB : IN_DECF][h]; const float lg = fminf(lg0, 0.f) - log1pf(expf(-fabsf(lg0)));
            PW[(dir * NH + h) * PWS + k] = expf(lg * (float)k); }
      }
        if (BOTH(PH_PRO)) GRID_BAR();
        TP_END(PH_PRO);
    }

    if (IN(PH_NORM1)) { TP_BEGIN(PH_NORM1);
      for (int rep_ = 0; rep_ < REPS(PH_NORM1); ++rep_) {
        LAS float* mulT = (LAS float*)lds;
        LAS float* addT = (LAS float*)(lds + 3 * D * 4);
        for (int i = tid; i < 3 * D; i += NTHR) { const int r = i / D, k = i % D;
            float sh = args.in[IN_BMOD][k], sc = args.in[IN_BMOD][D + k];
#pragma unroll
            for (int s = 0; s < NSL; ++s) { sh += MODP[(size_t)(s * 3 + r) * NMOD + k]; sc += MODP[(size_t)(s * 3 + r) * NMOD + D + k]; }
            mulT[i] = args.in[IN_G1][k] * (1.f + sc); addT[i] = sh; }
        for (int i = gtid; i < 3 * NMOD; i += NGT) { const int r = i / NMOD, col = i % NMOD; float a = args.in[IN_BMOD][col];
#pragma unroll
            for (int s = 0; s < NSL; ++s) a += MODP[(size_t)(s * 3 + r) * NMOD + col];
            MODF[i] = a; }
        LAS float* sh2T = (LAS float*)(lds + 6 * D * 4);
        for (int i = tid; i < 2 * D; i += NTHR) { const int r = i / D, k = i % D; float sh = args.in[IN_BMOD][3 * D + k];
#pragma unroll
            for (int s = 0; s < NSL; ++s) sh += MODP[(size_t)(s * 3 + r) * NMOD + 3 * D + k];
            sh2T[i] = sh; }
        if (gtid < 2 * D) { const int r = gtid / D, k = gtid % D; float sc = args.in[IN_BMOD][4 * D + k];
#pragma unroll
            for (int s = 0; s < NSL; ++s) sc += MODP[(size_t)(s * 3 + r) * NMOD + 4 * D + k];
            MUL2[gtid] = args.in[IN_G2][k] * (1.f + sc); }
        __syncthreads();
        for (int col = gw; col < NUP; col += NGW) {
            const bf16* wrow = WUP_T + (size_t)col * D; float s0 = 0.f, s1 = 0.f;
#pragma unroll
            for (int j = 0; j < 4; ++j) { const int k0 = 8 * (lane + 64 * j); const v4u wq = *(const GAS v4u*)(wrow + k0);
                const float wv[8] = {bflo(wq.x), bfhi(wq.x), bflo(wq.y), bfhi(wq.y), bflo(wq.z), bfhi(wq.z), bflo(wq.w), bfhi(wq.w)};
                const f32x4 a0 = *(const LAS f32x4*)(sh2T + k0), a1 = *(const LAS f32x4*)(sh2T + k0 + 4), c0 = *(const LAS f32x4*)(sh2T + D + k0), c1 = *(const LAS f32x4*)(sh2T + D + k0 + 4);
                s0 += (wv[0] * a0.x + wv[1] * a0.y) + (wv[2] * a0.z + wv[3] * a0.w) + (wv[4] * a1.x + wv[5] * a1.y) + (wv[6] * a1.z + wv[7] * a1.w);
                s1 += (wv[0] * c0.x + wv[1] * c0.y) + (wv[2] * c0.z + wv[3] * c0.w) + (wv[4] * c1.x + wv[5] * c1.y) + (wv[6] * c1.z + wv[7] * c1.w); }
            s0 = wave_sum(s0); s1 = wave_sum(s1);
            if (lane == 0) { BIAS2[col] = s0; BIAS2[NUP + col] = s1; }
        }
        for (int m = gw; m < M + MC; m += NGW) {
            if (m < M) { const int b = m >> 13; norm_row_bf16(x + (size_t)m * D, XN + (size_t)m * D, mulT + b * D, addT + b * D, lane); }
            else { const int mc = m - M; norm_row_bf16(args.in[IN_CTX] + (size_t)mc * D, HC + (size_t)mc * D, mulT + 2 * D, addT + 2 * D, lane); }
        }
      }
        if (BOTH(PH_NORM1)) GRID_BAR();
        TP_END(PH_NORM1);
    }

    if (IN(PH_GEMM_IN)) { TP_BEGIN(PH_GEMM_IN);
      {
        __syncthreads();
        { pg8::Gemm g{XN, WIN_T, M, INW, D}; pg8::StaticOrder S; S.init(M, INW, G, bx);
          pg8::EpiIn E{P, PLD, CAT + RW, D, GS, RW, COS, SIN, args.in[IN_CONVW], CCH, KSCALE};
          pg8::gemm_phase<pg8::EpiIn, pg8::StaticOrder, GP_ALIGN, GP_SP2>(lds, g, S, E);
          if (REPS(GEMM_REP_ID) == 2 && GEMM_REP_SEL == __LINE__) pg8::gemm_phase<pg8::EpiIn, pg8::StaticOrder, GP_ALIGN, GP_SP2>(lds, g, S, E);
          if (GEMM_REP_SEL == 9001) { pg8::EpiNull EN; pg8::gemm_phase<pg8::EpiNull, pg8::StaticOrder, GP_ALIGN, GP_SP2>(lds, g, S, EN); }
          if (GEMM_REP_SEL == 9002) { pg8::EpiNull EN; pg8::SameTileOrder S2; S2.init(M, INW, G, bx); pg8::gemm_phase<pg8::EpiNull, pg8::SameTileOrder, GP_ALIGN, GP_SP2>(lds, g, S2, EN); } }
        { pg8::Gemm g{HC, WIN_T + (size_t)RW * D, MC, 2 * RW, D}; pg8::StaticOrder S; S.init(MC, 2 * RW, G, bx);
          pg8::EpiBf16R E{KVC, 2 * RW, 0, 0, COS, SIN, 0, 0, 4, KSCALE};
          pg8::gemm_phase<pg8::EpiBf16R, pg8::StaticOrder, GP_ALIGN, GP_SP2>(lds, g, S, E);
          if (REPS(GEMM_REP_ID) == 2 && GEMM_REP_SEL == __LINE__) pg8::gemm_phase<pg8::EpiBf16R, pg8::StaticOrder, GP_ALIGN, GP_SP2>(lds, g, S, E); }
      }
        if (BOTH(PH_GEMM_IN)) GRID_BAR();
        TP_END(PH_GEMM_IN);
    }

    if (IN(PH_KV)) { TP_BEGIN(PH_KV);
      for (int rep_ = 0; rep_ < REPS(PH_KV); ++rep_) {
        __syncthreads();
        LAS unsigned char* Kimg = lds; LAS unsigned char* Vfimg = lds + 32768; LAS unsigned char* Vbimg = lds + 65536;
        for (int item = bx; item < BATCH * NH * NCHK + BATCH * NH * 2; item += G) {
            const bf16* kptr; const bf16* vptr; size_t stride; int wfo, wbo, h; size_t ooff; bool ctxi;
            if (item < BATCH * NH * NCHK) { const int b = item >> 9, ch = item & 63; h = (item >> 6) & 7;
                kptr = P + ((size_t)b * SEQ + (size_t)ch * CHK) * PLD + RW + h * DH; vptr = kptr + RW; stride = PLD; wfo = 127; wbo = 0;
                ooff = ((((size_t)b * NH + h) * NCHK + ch) * DH) * DH; ctxi = false; }
            else { const int r = item - BATCH * NH * NCHK, b = r >> 4, c = r & 1; h = (r >> 1) & 7;
                kptr = KVC + ((size_t)b * CTXL + (size_t)c * CHK) * (2 * RW) + h * DH; vptr = kptr + RW; stride = 2 * RW; wfo = CTXL - 1 - CHK * c; wbo = CHK * c;
                ooff = ((((size_t)b * NH + h) * 2 + c) * DH) * DH; ctxi = true; }
            const float* pwf = PW + (0 * NH + h) * PWS; const float* pwb = PW + (1 * NH + h) * PWS;
#pragma unroll
            for (int i = 0; i < 4; ++i) { const int p = tid + NTHR * i, row = p >> 4, c16 = p & 15;
                const v4u kq = *(const GAS v4u*)(kptr + (size_t)row * stride + c16 * 8);
                const v4u vq = *(const GAS v4u*)(vptr + (size_t)row * stride + c16 * 8);
                const float wf = pwf[wfo - row], wb = pwb[wbo + row];
                const unsigned o = off_b(row, c16);
                *(LAS v4u*)(Kimg + o) = kq; *(LAS v4u*)(Vfimg + o) = scale_pk8(vq, wf); *(LAS v4u*)(Vbimg + o) = scale_pk8(vq, wb); }
            __syncthreads();
            {
                const unsigned g4 = lane >> 4, fr = lane & 15; const int dkg = wave >> 1, dvh = wave & 1;
                f32x4 accf[4][2], accb[4][2];
#pragma unroll
                for (int mt = 0; mt < 4; ++mt)
#pragma unroll
                    for (int nt = 0; nt < 2; ++nt) { accf[mt][nt] = (f32x4){0.f, 0.f, 0.f, 0.f}; accb[mt][nt] = (f32x4){0.f, 0.f, 0.f, 0.f}; }
#pragma unroll
                for (int ks = 0; ks < 4; ++ks) {
                    bf16x8 kf[2];
#pragma unroll
                    for (int nt = 0; nt < 2; ++nt) kf[nt] = tr_frag(Kimg, lane, 32 * ks + 8 * g4, 32 * ks + 8 * g4 + 4, 2 * dkg + nt);
#pragma unroll
                    for (int mt = 0; mt < 4; ++mt) {
                        const bf16x8 vf = tr_frag(Vfimg, lane, 32 * ks + 8 * g4, 32 * ks + 8 * g4 + 4, 4 * dvh + mt);
                        const bf16x8 vb = tr_frag(Vbimg, lane, 32 * ks + 8 * g4, 32 * ks + 8 * g4 + 4, 4 * dvh + mt);
#pragma unroll
                        for (int nt = 0; nt < 2; ++nt) { accf[mt][nt] = __builtin_amdgcn_mfma_f32_16x16x32_bf16(vf, kf[nt], accf[mt][nt], 0, 0, 0); accb[mt][nt] = __builtin_amdgcn_mfma_f32_16x16x32_bf16(vb, kf[nt], accb[mt][nt], 0, 0, 0); }
                    }
                }
#pragma unroll
                for (int mt = 0; mt < 4; ++mt)
#pragma unroll
                    for (int nt = 0; nt < 2; ++nt) { const size_t o = ooff + (size_t)(16 * (2 * dkg + nt) + fr) * DH + 16 * (4 * dvh + mt) + 4 * g4;
                        if (ctxi) { *(f32x4*)(CTXS + o) = accf[mt][nt]; *(f32x4*)(CTXS + (size_t)BATCH * NH * 2 * DH * DH + o) = accb[mt][nt]; }
                        else { v2u wf_, wb_; wf_.x = pk2(accf[mt][nt].x, accf[mt][nt].y); wf_.y = pk2(accf[mt][nt].z, accf[mt][nt].w); wb_.x = pk2(accb[mt][nt].x, accb[mt][nt].y); wb_.y = pk2(accb[mt][nt].z, accb[mt][nt].w);
                            *(GAS v2u*)(KVS + o) = wf_; *(GAS v2u*)(KVS + (size_t)BATCH * NH * NCHK * DH * DH + o) = wb_; } }
            }
            __syncthreads();
        }
      }
        if (BOTH(PH_KV)) GRID_BAR();
        TP_END(PH_KV);
    }

    if (IN(PH_SCAN)) { TP_BEGIN(PH_SCAN);
      for (int rep_ = 0; rep_ < REPS(PH_SCAN); ++rep_) {
        for (int e4 = gtid; e4 < 2 * BATCH * NH * DH * DH / 4; e4 += NGT) {
            const int dv4 = e4 & 31, dk = (e4 >> 5) & 127, h = (e4 >> 12) & 7, b = (e4 >> 15) & 1, dir = e4 >> 16;
            const float* pw = PW + (dir * NH + h) * PWS;
            const float* c0 = CTXS + ((((size_t)(dir * BATCH + b) * NH + h) * 2 + 0) * DH) * DH + (size_t)dk * DH + dv4 * 4;
            f32x4 s = *(const f32x4*)c0 + *(const f32x4*)(c0 + (size_t)DH * DH);
            const float cd = pw[CHK];
            const size_t boff = (((size_t)(dir * BATCH + b) * NH + h) * NCHK) * DH * DH + (size_t)dk * DH + dv4 * 4;
#pragma unroll 16
            for (int i = 0; i < NCHK; ++i) {
                const int n = dir ? (NCHK - 1 - i) : i;
                const v2u tq = *(const GAS v2u*)(KVS + boff + (size_t)n * DH * DH); const f32x4 t = (f32x4){bflo(tq.x), bfhi(tq.x), bflo(tq.y), bfhi(tq.y)};
                v2u w; w.x = pk2(s.x, s.y); w.y = pk2(s.z, s.w);
                *(GAS v2u*)(SPV + boff + (size_t)n * DH * DH) = w;
                s = s * cd + t;
            }
        }
      }
        if (BOTH(PH_SCAN)) GRID_BAR();
        TP_END(PH_SCAN);
    }

    if (IN(PH_RETOUT)) { TP_BEGIN(PH_RETOUT);
      for (int rep_ = 0; rep_ < REPS(PH_RETOUT); ++rep_) {
        __syncthreads();
        LAS unsigned char* Qi = lds; LAS unsigned char* Ki = lds + 32768; LAS unsigned char* Vi = lds + 65536; LAS unsigned char* Si = lds + 98304;
        LAS float* pwl = (LAS float*)(lds + 131072);
        v4u rq[4], rk[4], rv[4], rf[4], rb[4];
#define P5_PTRS(it_) const int b_ = (it_) >> 9, h_ = ((it_) >> 6) & 7, ch_ = (it_) & 63; const size_t tk_ = (size_t)b_ * SEQ + (size_t)ch_ * CHK; const bf16* qp_ = P + tk_ * PLD + h_ * DH; \
        const bf16* sfp_ = SPV + ((((size_t)(0 * BATCH + b_) * NH + h_) * NCHK + ch_) * DH) * DH; const bf16* sbp_ = SPV + ((((size_t)(1 * BATCH + b_) * NH + h_) * NCHK + ch_) * DH) * DH; \
        const bf16* gp_ = GS + (tk_ + 16 * wave + (lane & 15)) * RW + h_ * DH + 4 * (lane >> 4); (void)qp_; (void)sfp_; (void)sbp_; (void)gp_;
#define P5_LOAD_QK() do { _Pragma("unroll") for (int i = 0; i < 4; ++i) { const int p = tid + NTHR * i, row = p >> 4, c16 = p & 15; \
            rq[i] = *(const GAS v4u*)(qp_ + (size_t)row * PLD + c16 * 8); rk[i] = *(const GAS v4u*)(qp_ + (size_t)row * PLD + RW + c16 * 8); } } while (0)
#define P5_LOAD_VFB() do { _Pragma("unroll") for (int i = 0; i < 4; ++i) { const int p = tid + NTHR * i, row = p >> 4, c16 = p & 15; \
            rv[i] = *(const GAS v4u*)(qp_ + (size_t)row * PLD + 2 * RW + c16 * 8); rf[i] = *(const GAS v4u*)(sfp_ + (size_t)row * DH + c16 * 8); rb[i] = *(const GAS v4u*)(sbp_ + (size_t)row * DH + c16 * 8); } } while (0)
#define P5_LOAD_G() do { _Pragma("unroll") for (int nt = 0; nt < 8; ++nt) rg[nt] = *(const GAS v2u*)(gp_ + 16 * nt); } while (0)
        if (bx < BATCH * NH * NCHK) { P5_PTRS(bx) P5_LOAD_QK(); }
        for (int item = bx; item < BATCH * NH * NCHK; item += G) {
            const int b = item >> 9, h = (item >> 6) & 7, ch = item & 63;
            const size_t tok0 = (size_t)b * SEQ + (size_t)ch * CHK;
            const int nitem = item + G; const bool hasn = nitem < BATCH * NH * NCHK;
            int tid_o = threadIdx.x; asm volatile("" : "+v"(tid_o));
            const int tid = tid_o, lane = tid_o & 63;
#pragma unroll
            for (int i = 0; i < 4; ++i) { const int p = tid + NTHR * i, row = p >> 4, c16 = p & 15; const unsigned o = off_b(row, c16);
                *(LAS v4u*)(Qi + o) = rq[i]; *(LAS v4u*)(Ki + o) = rk[i]; }
            { P5_PTRS(item) P5_LOAD_VFB(); }
            if (tid < 2 * 129) { const int dir = tid / 129, k = tid % 129; pwl[dir * 132 + k] = PW[(dir * NH + h) * PWS + k]; }
            __syncthreads();
            const unsigned g4 = lane >> 4, fr = lane & 15; const int i_in = 16 * wave + (int)fr;
            bf16x8 qf[4];
#pragma unroll
            for (int ks = 0; ks < 4; ++ks) qf[ks] = row_frag(Qi, lane, wave, ks);
            f32x4 sc[8];
#pragma unroll
            for (int jt = 0; jt < 8; ++jt) { sc[jt] = (f32x4){0.f, 0.f, 0.f, 0.f};
#pragma unroll
                for (int ks = 0; ks < 4; ++ks) sc[jt] = __builtin_amdgcn_mfma_f32_16x16x32_bf16(row_frag(Ki, lane, jt, ks), qf[ks], sc[jt], 0, 0, 0); }
            __syncthreads();
#pragma unroll
            for (int i = 0; i < 4; ++i) { const int p = tid + NTHR * i, row = p >> 4, c16 = p & 15; const unsigned o = off_b(row, c16); *(LAS v4u*)(Vi + o) = rv[i]; *(LAS v4u*)(Si + o) = rf[i]; *(LAS v4u*)(Ki + o) = rb[i]; }
            if (hasn) { P5_PTRS(nitem) P5_LOAD_QK(); }
            __syncthreads();
            bf16x8 pf[4];
#pragma unroll
            for (int ks = 0; ks < 4; ++ks) {
                float pv[8];
#pragma unroll
                for (int hf = 0; hf < 2; ++hf)
#pragma unroll
                    for (int rg = 0; rg < 4; ++rg) { const int j = 16 * (2 * ks + hf) + 4 * (int)g4 + rg;
                        const float dm = (j <= i_in) ? pwl[i_in - j] : pwl[132 + (j - i_in)];
                        pv[4 * hf + rg] = sc[2 * ks + hf][rg] * dm; }
                v4u w; w.x = pk2(pv[0], pv[1]); w.y = pk2(pv[2], pv[3]); w.z = pk2(pv[4], pv[5]); w.w = pk2(pv[6], pv[7]);
                pf[ks] = __builtin_bit_cast(bf16x8, w);
            }
            f32x4 o[8];
#pragma unroll
            for (int nt = 0; nt < 8; ++nt) { o[nt] = (f32x4){0.f, 0.f, 0.f, 0.f};
#pragma unroll
                for (int ks = 0; ks < 4; ++ks) o[nt] = __builtin_amdgcn_mfma_f32_16x16x32_bf16(tr_frag(Vi, lane, 32 * ks + 4 * g4, 32 * ks + 16 + 4 * g4, nt), pf[ks], o[nt], 0, 0, 0); }
            {
                const float qd = pwl[i_in + 1]; bf16x8 qs[4];
#pragma unroll
                for (int ks = 0; ks < 4; ++ks) qs[ks] = __builtin_bit_cast(bf16x8, scale_pk8(__builtin_bit_cast(v4u, qf[ks]), qd));
#pragma unroll
                for (int nt = 0; nt < 8; ++nt)
#pragma unroll
                    for (int ks = 0; ks < 4; ++ks) o[nt] = __builtin_amdgcn_mfma_f32_16x16x32_bf16(tr_frag(Si, lane, 32 * ks + 8 * g4, 32 * ks + 8 * g4 + 4, nt), qs[ks], o[nt], 0, 0, 0);
            }
            {
                const float qd = pwl[132 + (CHK - i_in)]; bf16x8 qs[4];
#pragma unroll
                for (int ks = 0; ks < 4; ++ks) qs[ks] = __builtin_bit_cast(bf16x8, scale_pk8(__builtin_bit_cast(v4u, qf[ks]), qd));
#pragma unroll
                for (int nt = 0; nt < 8; ++nt)
#pragma unroll
                    for (int ks = 0; ks < 4; ++ks) o[nt] = __builtin_amdgcn_mfma_f32_16x16x32_bf16(tr_frag(Ki, lane, 32 * ks + 8 * g4, 32 * ks + 8 * g4 + 4, nt), qs[ks], o[nt], 0, 0, 0);
            }
            v2u rg[8]; { P5_PTRS(item) P5_LOAD_G(); }
            {
                float ss = 0.f;
#pragma unroll
                for (int nt = 0; nt < 8; ++nt) ss += (o[nt].x * o[nt].x + o[nt].y * o[nt].y) + (o[nt].z * o[nt].z + o[nt].w * o[nt].w);
                ss += __shfl_xor(ss, 16); ss += __shfl_xor(ss, 32);
                const float rstd = rsqrtf(ss * (1.f / DH) + EPS);
                bf16* op = CAT + (tok0 + i_in) * D + h * DH + 4 * g4;
#pragma unroll
                for (int nt = 0; nt < 8; ++nt) { const v2u gq = rg[nt];
                    v2u w; w.x = pk2(o[nt].x * rstd * bflo(gq.x), o[nt].y * rstd * bfhi(gq.x)); w.y = pk2(o[nt].z * rstd * bflo(gq.y), o[nt].w * rstd * bfhi(gq.y));
                    *(GAS v2u*)(op + 16 * nt) = w; }
            }
            __syncthreads();
        }
#undef P5_PTRS
#undef P5_LOAD_QK
#undef P5_LOAD_VFB
#undef P5_LOAD_G
      }
        if (BOTH(PH_RETOUT)) GRID_BAR();
        TP_END(PH_RETOUT);
    }

    if (IN(PH_GEMM_OUT)) { TP_BEGIN(PH_GEMM_OUT);
      {
        __syncthreads();
        pg8::Gemm g{CAT, WOUT_T, M, D, D}; pg8::StaticOrder S; S.init(M, D, G, bx);
        pg8::EpiResNorm E{x, XM, D, MODF + 2 * D, NMOD, MUL2, XN, ROWSS};
        pg8::gemm_phase<pg8::EpiResNorm, pg8::StaticOrder, GP_ALIGN, GP_SP2>(lds, g, S, E);
        if (REPS(GEMM_REP_ID) == 2 && GEMM_REP_SEL == __LINE__) pg8::gemm_phase<pg8::EpiResNorm, pg8::StaticOrder, GP_ALIGN, GP_SP2>(lds, g, S, E);
      }
        if (BOTH(PH_GEMM_OUT)) GRID_BAR();
        TP_END(PH_GEMM_OUT);
    }

    if (IN(PH_GEMM_UP)) { TP_BEGIN(PH_GEMM_UP);
      {
        __syncthreads();
        pg8::Gemm g{XN, WUP_T, M, NUP, D}; pg8::StaticOrder S; S.init(M, NUP, G, bx);
        LAS float* rsl = (LAS float*)(lds + 131072);
        pg8::Unit u0; int pm0 = -1; if (S.next(0, u0)) pm0 = u0.pm;
        if (pm0 >= 0 && tid < 256) { const int lr = 16 * (tid >> 7) + 4 * ((tid >> 4) & 3) + ((tid & 15) >> 2), lc = 4 * ((tid >> 6) & 1) + (tid & 3);
            const size_t tok = (size_t)(pm0 >> 5) * 8192 + (size_t)(32 * ((pm0 >> 3) & 3) + lr) * 64 + 8 * (pm0 & 7) + lc;
            const float* rp = ROWSS + tok * 32; float t = 0.f;
#pragma unroll
            for (int i = 0; i < 8; ++i) { const f32x4 q = *(const f32x4*)(rp + 4 * i); t += (q.x + q.y) + (q.z + q.w); }
            rsl[tid] = rsqrtf(t * (1.f / D) + EPS); }
        __syncthreads();
        pg8::EpiGate E{ACT, DFF, EDGE, BIAS2, NUP, args.in[IN_FCW], args.in[IN_FCB], DFF, rsl, pm0, ROWSS, 1.f / D, EPS};
        pg8::gemm_phase<pg8::EpiGate, pg8::StaticOrder, GP_ALIGN, GP_SP2>(lds, g, S, E);
      }
        if (BOTH(PH_GEMM_UP)) GRID_BAR();
        TP_END(PH_GEMM_UP);
    }

    if (IN(PH_GATE)) { TP_BEGIN(PH_GATE);
      for (int rep_ = 0; rep_ < REPS(PH_GATE); ++rep_) {
        const float* fw = args.in[IN_FCW]; const float* fb = args.in[IN_FCB];
        for (int item = gtid; item < BATCH * 4 * 2 * 64 * (DFF / 8); item += NGT) {
            const int c8 = item % (DFF / 8), t = item / (DFF / 8), gc = t & 63, eb = (t >> 6) & 1, rblk = (t >> 7) & 3, b = t >> 9;
            auto eptr = [&](int rb, int slot) { return EDGE + ((size_t)((b * 4 + rb) * 6 + slot) * 64 + gc) * DFF + c8 * 8; };
            const v4u z = (v4u){0u, 0u, 0u, 0u};
            const v4u a0 = eb == 0 ? (rblk > 0 ? *(const GAS v4u*)eptr(rblk - 1, 3) : z) : *(const GAS v4u*)eptr(rblk, 2);
            const v4u a1 = *(const GAS v4u*)eptr(rblk, eb == 0 ? 0 : 3);
            const v4u a2 = eb == 0 ? *(const GAS v4u*)eptr(rblk, 1) : (rblk < 3 ? *(const GAS v4u*)eptr(rblk + 1, 0) : z);
            const v4u bq = *(const GAS v4u*)eptr(rblk, eb == 0 ? 4 : 5);
            const float A0[8] = {bflo(a0.x), bfhi(a0.x), bflo(a0.y), bfhi(a0.y), bflo(a0.z), bfhi(a0.z), bflo(a0.w), bfhi(a0.w)};
            const float A1[8] = {bflo(a1.x), bfhi(a1.x), bflo(a1.y), bfhi(a1.y), bflo(a1.z), bfhi(a1.z), bflo(a1.w), bfhi(a1.w)};
            const float A2[8] = {bflo(a2.x), bfhi(a2.x), bflo(a2.y), bfhi(a2.y), bflo(a2.z), bfhi(a2.z), bflo(a2.w), bfhi(a2.w)};
            const float BB[8] = {bflo(bq.x), bfhi(bq.x), bflo(bq.y), bfhi(bq.y), bflo(bq.z), bfhi(bq.z), bflo(bq.w), bfhi(bq.w)};
            float o[8];
#pragma unroll
            for (int e = 0; e < 8; ++e) { const int c = c8 * 8 + e; const float av = fw[c] * A0[e] + fw[DFF + c] * A1[e] + fw[2 * DFF + c] * A2[e] + fb[c]; o[e] = silu_f(av) * BB[e]; }
            v4u w; w.x = pk2(o[0], o[1]); w.y = pk2(o[2], o[3]); w.z = pk2(o[4], o[5]); w.w = pk2(o[6], o[7]);
            const size_t tok = (size_t)b * SEQ + (size_t)(32 * rblk + (eb ? 31 : 0)) * 64 + gc;
            *(GAS v4u*)(ACT + tok * DFF + c8 * 8) = w;
        }
      }
        if (BOTH(PH_GATE)) GRID_BAR();
        TP_END(PH_GATE);
    }

    if (IN(PH_GEMM_DN)) { TP_BEGIN(PH_GEMM_DN);
      {
        __syncthreads();
        pg8::Gemm g{ACT, WDN_T, M, D, DFF}; pg8::StaticOrder S; S.init(M, D, G, bx);
        pg8::EpiRes E{XM, out, D, MODF + 5 * D, NMOD};
        pg8::gemm_phase<pg8::EpiRes, pg8::StaticOrder, GP_ALIGN, GP_SP2>(lds, g, S, E);
        if (REPS(GEMM_REP_ID) == 2 && GEMM_REP_SEL == __LINE__) pg8::gemm_phase<pg8::EpiRes, pg8::StaticOrder, GP_ALIGN, GP_SP2>(lds, g, S, E);
      }
        if (BOTH(PH_GEMM_DN)) GRID_BAR();
        TP_END(PH_GEMM_DN);
    }

    if (IN(PH_FNORM)) { TP_BEGIN(PH_FNORM);
        const float* gfin = args.in[IN_GF];
        for (int m = gw; m < M; m += NGW) {
            GAS f32x4* xr = (GAS f32x4*)(out + (size_t)m * D) + lane;
            f32x4 v[8]; float s = 0.f;
#pragma unroll
            for (int j = 0; j < 8; ++j) { v[j] = xr[64 * j]; s += (v[j].x * v[j].x + v[j].y * v[j].y) + (v[j].z * v[j].z + v[j].w * v[j].w); }
            const float rstd = rsqrtf(wave_sum(s) * (1.f / D) + EPS);
#pragma unroll
            for (int j = 0; j < 8; ++j) { const f32x4 gg = *(const f32x4*)(gfin + 4 * (lane + 64 * j)); xr[64 * j] = v[j] * rstd * gg; }
        }
    }
    if (TIME_PHASE == PH_FNORM) { VM_WAIT(); tp_b = __builtin_amdgcn_s_memrealtime(); }
    if (TIME_PHASE >= 0 && bx == 0 && tid == 0) { const unsigned long long t0 = __builtin_amdgcn_s_memrealtime(), span = (tp_b - tp_a) * 8ull; while (__builtin_amdgcn_s_memrealtime() - t0 < span) __builtin_amdgcn_s_sleep(8); }
#undef IN
#undef BOTH
}

extern "C" void kernel_launch(void* const* d_in, const int* in_sizes, int n_in, void* d_out, int out_size, void* d_ws, size_t ws_size, hipStream_t stream) {
    static int grid = 0;
    if (grid == 0) {
        if (n_in != 18 || in_sizes[0] != M * D || out_size != M * D || ws_size < WS_END) { fprintf(stderr, "kernel_launch: unexpected shapes/workspace (n_in %d, in0 %d, out %d, ws %zu, need %zu); nothing launched\n", n_in, n_in > 0 ? in_sizes[0] : -1, out_size, ws_size, (size_t)WS_END); grid = -1; return; }
        int dev = 0, cus = 0, per_cu = 0;
        if (hipGetDevice(&dev) != hipSuccess || hipDeviceGetAttribute(&cus, hipDeviceAttributeMultiprocessorCount, dev) != hipSuccess) { grid = -1; return; }
        if (hipFuncSetAttribute((const void*)fwd_kernel, hipFuncAttributeMaxDynamicSharedMemorySize, LDS_BYTES) != hipSuccess) { fprintf(stderr, "kernel_launch: hipFuncSetAttribute failed\n"); grid = -1; return; }
        if (hipOccupancyMaxActiveBlocksPerMultiprocessor(&per_cu, (const void*)fwd_kernel, NTHR, LDS_BYTES) != hipSuccess || per_cu < 1) { fprintf(stderr, "kernel_launch: occupancy query says %d\n", per_cu); per_cu = 1; }
        (void)hipGetLastError();
        grid = cus * (per_cu < 1 ? 1 : 1);
    }
    if (grid < 0) return;
    (void)hipMemsetAsync((char*)d_ws + WS_CTL + (size_t)CW_BAR * 4, 0, 16384, stream);
    Args a{};
    for (int i = 0; i < 18; ++i) a.in[i] = (const float*)d_in[i];
    a.out = (float*)d_out; a.ws = (unsigned char*)d_ws;
#if ONE_LAUNCH
    a.ph_lo = 0; a.ph_hi = NPH;
    void* kargs[] = {&a};
    hipError_t e = hipLaunchCooperativeKernel((const void*)fwd_kernel, dim3(grid), dim3(NTHR), kargs, LDS_BYTES, stream);
    if (e != hipSuccess) fprintf(stderr, "kernel_launch: cooperative launch failed: %s (grid %d)\n", hipGetErrorString(e), grid);
#else
    for (int p = 0; p < NPH; ++p) { a.ph_lo = p; a.ph_hi = p + 1; hipLaunchKernelGGL(fwd_kernel, dim3(grid), dim3(NTHR), LDS_BYTES, stream, a); }
#endif
}
```

```cpp
#include <hip/hip_runtime.h>
#include <cstdio>
#include <cstdint>

#ifndef GP_ALIGN
#define GP_ALIGN true
#endif
#ifndef GP_SP2
#define GP_SP2 true
#endif
#ifndef ONE_LAUNCH
#define ONE_LAUNCH 1
#endif

namespace pg8 {
#define PG8_LAS __attribute__((address_space(3)))
typedef unsigned short bf16_t;
typedef short bf16x8 __attribute__((ext_vector_type(8)));
typedef float f32x4 __attribute__((ext_vector_type(4)));
typedef unsigned u32x4 __attribute__((ext_vector_type(4)));
constexpr int BM = 256, BK = 64, HALF = 128, HTB = HALF * BK * 2, STAGE_BYTES = 8 * HTB, NXCD = 8, WGM = 8;

__host__ __device__ __forceinline__ int lds_byte(int r, int c) { const int st = (r >> 4) * 2 + (c >> 5), rr = r & 15, cc = c & 31, ob = rr * 64 + cc * 2; return st * 1024 + (ob ^ (((ob >> 9) & 1) << 5)); }
__host__ __device__ __forceinline__ void stage_rc(int b, int& R, int& C) { const int st = b / 1024, sb = b % 1024, swz = sb ^ (((sb >> 9) & 1) << 5); R = (st >> 1) * 16 + swz / 64; C = (st & 1) * 32 + (swz % 64) / 2; }
__host__ __device__ __forceinline__ int perm32(int rho) { const int n = rho >> 4, i = rho & 15; return 8 * (i >> 2) + 4 * n + (i & 3); }

struct Unit { int pm, pn; };
struct Gemm { const bf16_t* A; const bf16_t* Bt; int M, N, K; };

struct StaticOrder {
    int nM, nN, nwg, G, c;
    __host__ __device__ void init(int M, int N, int G_, int c_) { nM = M / BM; nN = N / BM; nwg = nM * nN; G = G_; c = c_; }
    __host__ __device__ bool next(int i, Unit& u) const {
        const long L = (long)i * G + c; if (L >= nwg) return false;
        int wgid = (int)L; { const int q = nwg / NXCD, r = nwg % NXCD, xcd = wgid % NXCD, off = wgid / NXCD; wgid = (xcd < r ? xcd * (q + 1) : r * (q + 1) + (xcd - r) * q) + off; }
        const int nig = WGM * nN, gid = wgid / nig, fm = gid * WGM, gsz = (nM - fm) < WGM ? (nM - fm) : WGM;
        u.pm = fm + ((wgid % nig) % gsz); u.pn = (wgid % nig) / gsz; return true;
    }
    __device__ __forceinline__ void a_ready(const Unit&) const {}
    __device__ __forceinline__ void done(const Unit&) const {}
};

__device__ __forceinline__ unsigned cvt_pk_bf16(float lo, float hi) { unsigned r; asm volatile("v_cvt_pk_bf16_f32 %0, %1, %2" : "=v"(r) : "v"(lo), "v"(hi)); return r; }


struct EpiBf16R {
    static constexpr bool PERM = true, AFTER_DRAIN = false, GRIDMAP = false;
    bf16_t* O; int ldc; int split_cols; size_t split_stride;
    const float* cosT; const float* sinT; int rope_hi; int sc_lo, sc_hi; float sc;
    __device__ __forceinline__ void operator()(const f32x4 (&acc)[2][2][4][2], const Unit& u, int wr, int wc, int fr, int fq) const {
        const int row0 = u.pm * BM + wr * 64 + fr; int colt = u.pn * BM; bf16_t* base = O;
        if (split_cols) { const int t = colt / split_cols; base += (size_t)t * split_stride; colt -= t * split_cols; }
        const int col0 = colt + wc * 32 + 8 * fq;
        const bool rope = u.pn < rope_hi; const float s = (u.pn >= sc_lo && u.pn < sc_hi) ? sc : 1.f;
        const int ti = 16 * (wc & 1) + 4 * fq;
#pragma unroll
        for (int ai = 0; ai < 2; ++ai)
#pragma unroll
            for (int m = 0; m < 4; ++m) {
                const int r = row0 + ai * HALF + m * 16;
                f32x4 cs = (f32x4){1.f, 1.f, 1.f, 1.f}, sn = (f32x4){0.f, 0.f, 0.f, 0.f};
                if (rope) { const int ntok = r & 8191; const int pos = (wc >> 1) ? (ntok & 63) : (ntok >> 6); cs = *(const f32x4*)(cosT + pos * 32 + ti); sn = *(const f32x4*)(sinT + pos * 32 + ti); }
                bf16_t* rowp = base + (size_t)r * ldc + col0;
#pragma unroll
                for (int bj = 0; bj < 2; ++bj) {
                    const f32x4 v0 = acc[ai][bj][m][0], v1 = acc[ai][bj][m][1]; f32x4 o0, o1;
                    o0[0] = v0[0] * cs[0] - v0[1] * sn[0]; o0[1] = v0[0] * sn[0] + v0[1] * cs[0];
                    o0[2] = v0[2] * cs[1] - v0[3] * sn[1]; o0[3] = v0[2] * sn[1] + v0[3] * cs[1];
                    o1[0] = v1[0] * cs[2] - v1[1] * sn[2]; o1[1] = v1[0] * sn[2] + v1[1] * cs[2];
                    o1[2] = v1[2] * cs[3] - v1[3] * sn[3]; o1[3] = v1[2] * sn[3] + v1[3] * cs[3];
                    o0 = o0 * s; o1 = o1 * s;
                    u32x4 w; w.x = cvt_pk_bf16(o0[0], o0[1]); w.y = cvt_pk_bf16(o0[2], o0[3]); w.z = cvt_pk_bf16(o1[0], o1[1]); w.w = cvt_pk_bf16(o1[2], o1[3]);
                    *(u32x4*)(rowp + bj * HALF) = w; }
            }
    }
};
__device__ __forceinline__ float dpp_ror1(float x)  { return __builtin_bit_cast(float, __builtin_amdgcn_update_dpp(0, __builtin_bit_cast(int, x), 0x121, 0xF, 0xF, false)); }
__device__ __forceinline__ float dpp_ror15(float x) { return __builtin_bit_cast(float, __builtin_amdgcn_update_dpp(0, __builtin_bit_cast(int, x), 0x12F, 0xF, 0xF, false)); }
struct EpiIn {
    static constexpr bool PERM = true, AFTER_DRAIN = false, GRIDMAP = false;
    bf16_t* P; int ldp; bf16_t* CATc; int ldcat; bf16_t* GS; int ldg; const float* cosT; const float* sinT; const float* convw; int nconv; float ksc;
    __device__ __forceinline__ void operator()(const f32x4 (&acc)[2][2][4][2], const Unit& u, int wr, int wc, int fr, int fq) const {
        const int row0 = u.pm * BM + wr * 64 + fr;
        if (u.pn < 12) {
            const int col0 = u.pn * BM + wc * 32 + 8 * fq;
            const bool rope = u.pn < 8; const float s = (u.pn >= 4 && u.pn < 8) ? ksc : 1.f;
            const int ti = 16 * (wc & 1) + 4 * fq;
#pragma unroll
            for (int ai = 0; ai < 2; ++ai)
#pragma unroll
                for (int m = 0; m < 4; ++m) {
                    const int r = row0 + ai * HALF + m * 16;
                    f32x4 cs = (f32x4){1.f, 1.f, 1.f, 1.f}, sn = (f32x4){0.f, 0.f, 0.f, 0.f};
                    if (rope) { const int ntok = r & 8191; const int pos = (wc >> 1) ? (ntok & 63) : (ntok >> 6); cs = *(const f32x4*)(cosT + pos * 32 + ti); sn = *(const f32x4*)(sinT + pos * 32 + ti); }
                    bf16_t* rowp = P + (size_t)r * ldp + col0;
#pragma unroll
                    for (int bj = 0; bj < 2; ++bj) {
                        const f32x4 v0 = acc[ai][bj][m][0], v1 = acc[ai][bj][m][1]; f32x4 o0, o1;
                        o0[0] = v0[0] * cs[0] - v0[1] * sn[0]; o0[1] = v0[0] * sn[0] + v0[1] * cs[0];
                        o0[2] = v0[2] * cs[1] - v0[3] * sn[1]; o0[3] = v0[2] * sn[1] + v0[3] * cs[1];
                        o1[0] = v1[0] * cs[2] - v1[1] * sn[2]; o1[1] = v1[0] * sn[2] + v1[1] * cs[2];
                        o1[2] = v1[2] * cs[3] - v1[3] * sn[3]; o1[3] = v1[2] * sn[3] + v1[3] * cs[3];
                        o0 = o0 * s; o1 = o1 * s;
                        u32x4 w; w.x = cvt_pk_bf16(o0[0], o0[1]); w.y = cvt_pk_bf16(o0[2], o0[3]); w.z = cvt_pk_bf16(o1[0], o1[1]); w.w = cvt_pk_bf16(o1[2], o1[3]);
                        *(u32x4*)(rowp + bj * HALF) = w; }
                }
        } else {
            typedef unsigned u32x2 __attribute__((ext_vector_type(2)));
            const int ch0 = 64 * (u.pn - 12) + 16 * wc + 4 * fq;
            const f32x4 w0 = *(const f32x4*)(convw + ch0), w1 = *(const f32x4*)(convw + nconv + ch0), w2 = *(const f32x4*)(convw + 2 * nconv + ch0);
#pragma unroll
            for (int ai = 0; ai < 2; ++ai) {
                f32x4 cv[4], rr[4], ll[4];
#pragma unroll
                for (int m = 0; m < 4; ++m) { cv[m] = acc[ai][0][m][0] * acc[ai][0][m][1];
#pragma unroll
                    for (int e = 0; e < 4; ++e) { rr[m][e] = dpp_ror1(cv[m][e]); ll[m][e] = dpp_ror15(cv[m][e]); } }
#pragma unroll
                for (int m = 0; m < 4; ++m) {
                    const f32x4 z = (f32x4){0.f, 0.f, 0.f, 0.f};
                    const f32x4 prev = fr > 0 ? rr[m] : (m > 0 ? rr[m > 0 ? m - 1 : 0] : z), next = fr < 15 ? ll[m] : (m < 3 ? ll[m < 3 ? m + 1 : 3] : z);
                    const f32x4 o = acc[ai][1][m][0] * (w0 * prev + w1 * cv[m] + w2 * next);
                    const f32x4 gq = acc[ai][1][m][1]; f32x4 gs;
#pragma unroll
                    for (int e = 0; e < 4; ++e) gs[e] = gq[e] * __builtin_amdgcn_rcpf(1.f + __expf(-gq[e]));
                    const size_t r = (size_t)(row0 + ai * HALF + m * 16);
                    *(u32x2*)(CATc + r * ldcat + ch0) = (u32x2){cvt_pk_bf16(o[0], o[1]), cvt_pk_bf16(o[2], o[3])};
                    *(u32x2*)(GS + r * ldg + ch0) = (u32x2){cvt_pk_bf16(gs[0], gs[1]), cvt_pk_bf16(gs[2], gs[3])};
                }
            }
        }
    }
};
struct EpiRes {
    static constexpr bool PERM = true, AFTER_DRAIN = false, GRIDMAP = false;
    const bf16_t* base; bf16_t* out; int ldc; const float* gate; int gate_bstride;
    __device__ __forceinline__ void operator()(const f32x4 (&acc)[2][2][4][2], const Unit& u, int wr, int wc, int fr, int fq) const {
        const int row0 = u.pm * BM + wr * 64 + fr, col0 = u.pn * BM + wc * 32 + 8 * fq;
        const float* gp = gate + (size_t)((u.pm * BM) >> 13) * gate_bstride + col0;
        f32x4 gv[2][2];
#pragma unroll
        for (int bj = 0; bj < 2; ++bj)
#pragma unroll
            for (int n = 0; n < 2; ++n) gv[bj][n] = *(const f32x4*)(gp + bj * HALF + 4 * n);
#pragma unroll
        for (int ai = 0; ai < 2; ++ai) {
            u32x4 bq[4][2];
#pragma unroll
            for (int m = 0; m < 4; ++m)
#pragma unroll
                for (int bj = 0; bj < 2; ++bj) bq[m][bj] = *(const u32x4*)(base + (size_t)(row0 + ai * HALF + m * 16) * ldc + col0 + bj * HALF);
            asm volatile("" ::: "memory");
#pragma unroll
            for (int m = 0; m < 4; ++m) { const size_t off = (size_t)(row0 + ai * HALF + m * 16) * ldc + col0;
#pragma unroll
                for (int bj = 0; bj < 2; ++bj) { const u32x4 q = bq[m][bj];
                    const f32x4 b0 = (f32x4){__builtin_bit_cast(float, q.x << 16), __builtin_bit_cast(float, q.x & 0xffff0000u), __builtin_bit_cast(float, q.y << 16), __builtin_bit_cast(float, q.y & 0xffff0000u)};
                    const f32x4 b1 = (f32x4){__builtin_bit_cast(float, q.z << 16), __builtin_bit_cast(float, q.z & 0xffff0000u), __builtin_bit_cast(float, q.w << 16), __builtin_bit_cast(float, q.w & 0xffff0000u)};
                    const f32x4 o0 = b0 + gv[bj][0] * acc[ai][bj][m][0], o1 = b1 + gv[bj][1] * acc[ai][bj][m][1];
                    u32x4 w; w.x = cvt_pk_bf16(o0[0], o0[1]); w.y = cvt_pk_bf16(o0[2], o0[3]); w.z = cvt_pk_bf16(o1[0], o1[1]); w.w = cvt_pk_bf16(o1[2], o1[3]);
                    *(u32x4*)(out + off + bj * HALF) = w; } }
            asm volatile("" ::: "memory");
        }
    }
};
struct EpiResNorm {
    static constexpr bool PERM = true, AFTER_DRAIN = false, GRIDMAP = false;
    const float* base; bf16_t* out; int ldc; const float* gate; int gate_bstride; const float* mul; bf16_t* xn; float* rowss;
    __device__ __forceinline__ void operator()(const f32x4 (&acc)[2][2][4][2], const Unit& u, int wr, int wc, int fr, int fq) const {
        const int row0 = u.pm * BM + wr * 64 + fr, col0 = u.pn * BM + wc * 32 + 8 * fq, b = (u.pm * BM) >> 13;
        const float* gp = gate + (size_t)b * gate_bstride + col0; const float* mp = mul + (size_t)b * ldc + col0;
        f32x4 gv[2][2], mvv[2][2];
#pragma unroll
        for (int bj = 0; bj < 2; ++bj)
#pragma unroll
            for (int n = 0; n < 2; ++n) { gv[bj][n] = *(const f32x4*)(gp + bj * HALF + 4 * n); mvv[bj][n] = *(const f32x4*)(mp + bj * HALF + 4 * n); }
#pragma unroll
        for (int hq = 0; hq < 4; ++hq) { const int ai = hq >> 1, m0 = 2 * (hq & 1);
            f32x4 bsv[2][2][2];
#pragma unroll
            for (int mm = 0; mm < 2; ++mm)
#pragma unroll
                for (int bj = 0; bj < 2; ++bj)
#pragma unroll
                    for (int n = 0; n < 2; ++n) bsv[mm][bj][n] = *(const f32x4*)(base + (size_t)(row0 + ai * HALF + (m0 + mm) * 16) * ldc + col0 + bj * HALF + 4 * n);
            asm volatile("" ::: "memory");
#pragma unroll
            for (int mm = 0; mm < 2; ++mm) { const int m = m0 + mm; const int r = row0 + ai * HALF + m * 16; const size_t off = (size_t)r * ldc + col0; float ss = 0.f;
#pragma unroll
                for (int bj = 0; bj < 2; ++bj) {
                    const f32x4 v0 = bsv[mm][bj][0] + gv[bj][0] * acc[ai][bj][m][0], v1 = bsv[mm][bj][1] + gv[bj][1] * acc[ai][bj][m][1];
                    ss += ((v0[0] * v0[0] + v0[1] * v0[1]) + (v0[2] * v0[2] + v0[3] * v0[3])) + ((v1[0] * v1[0] + v1[1] * v1[1]) + (v1[2] * v1[2] + v1[3] * v1[3]));
                    const f32x4 y0 = v0 * mvv[bj][0], y1 = v1 * mvv[bj][1];
                    u32x4 wn; wn.x = cvt_pk_bf16(y0[0], y0[1]); wn.y = cvt_pk_bf16(y0[2], y0[3]); wn.z = cvt_pk_bf16(y1[0], y1[1]); wn.w = cvt_pk_bf16(y1[2], y1[3]);
                    u32x4 wm; wm.x = cvt_pk_bf16(v0[0], v0[1]); wm.y = cvt_pk_bf16(v0[2], v0[3]); wm.z = cvt_pk_bf16(v1[0], v1[1]); wm.w = cvt_pk_bf16(v1[2], v1[3]);
                    *(u32x4*)(xn + off + bj * HALF) = wn; *(u32x4*)(out + off + bj * HALF) = wm; }
                ss += __shfl_xor(ss, 16); ss += __shfl_xor(ss, 32);
                if (fq == 0) rowss[(size_t)r * 32 + 4 * u.pn + wc] = ss; }
            asm volatile("" ::: "memory");
        }
    }
};
struct EpiUp {
    static constexpr bool PERM = true, AFTER_DRAIN = false, GRIDMAP = false;
    bf16_t* O; int ldc; int split_cols; size_t split_stride; const float* bias; int bias_bstride; const PG8_LAS float* rs; int pm_cached; const float* rowss; float inv_d, eps;
    __device__ __forceinline__ void operator()(const f32x4 (&acc)[2][2][4][2], const Unit& u, int wr, int wc, int fr, int fq) const {
        const int row0 = u.pm * BM + wr * 64 + fr; int colt = u.pn * BM; bf16_t* base = O;
        { const int t = colt / split_cols; base += (size_t)t * split_stride; colt -= t * split_cols; }
        const int col0 = colt + wc * 32 + 8 * fq; const float* bp = bias + (size_t)((u.pm * BM) >> 13) * bias_bstride + u.pn * BM + wc * 32 + 8 * fq;
        f32x4 bv[2][2];
#pragma unroll
        for (int bj = 0; bj < 2; ++bj)
#pragma unroll
            for (int n = 0; n < 2; ++n) bv[bj][n] = *(const f32x4*)(bp + bj * HALF + 4 * n);
#pragma unroll
        for (int ai = 0; ai < 2; ++ai)
#pragma unroll
            for (int m = 0; m < 4; ++m) { const int rl = ai * HALF + wr * 64 + m * 16 + fr; const int r = u.pm * BM + rl; float rsv;
                if (u.pm == pm_cached) rsv = rs[rl];
                else { float t = 0.f; for (int i = 0; i < 32; ++i) t += rowss[(size_t)r * 32 + i]; rsv = rsqrtf(t * inv_d + eps); }
                bf16_t* rowp = base + (size_t)r * ldc + col0;
#pragma unroll
                for (int bj = 0; bj < 2; ++bj) { const f32x4 v0 = acc[ai][bj][m][0] * rsv + bv[bj][0], v1 = acc[ai][bj][m][1] * rsv + bv[bj][1];
                    u32x4 w; w.x = cvt_pk_bf16(v0[0], v0[1]); w.y = cvt_pk_bf16(v0[2], v0[3]); w.z = cvt_pk_bf16(v1[0], v1[1]); w.w = cvt_pk_bf16(v1[2], v1[3]);
                    *(u32x4*)(rowp + bj * HALF) = w; } }
    }
};
__device__ __forceinline__ float dpp_ror4(float x)  { return __builtin_bit_cast(float, __builtin_amdgcn_mov_dpp(__builtin_bit_cast(int, x), 0x124, 0xF, 0xF, false)); }
__device__ __forceinline__ float dpp_ror12(float x) { return __builtin_bit_cast(float, __builtin_amdgcn_mov_dpp(__builtin_bit_cast(int, x), 0x12C, 0xF, 0xF, false)); }
struct EpiGate {
    static constexpr bool PERM = true, AFTER_DRAIN = false, GRIDMAP = true;
    bf16_t* ACT; int lda; bf16_t* EDGE; const float* bias; int bias_bstride; const float* fcw; const float* fcb; int nch; const PG8_LAS float* rs; const PG8_LAS int* pml;
    __device__ __forceinline__ void operator()(f32x4 (&acc)[2][2][4][2], const Unit& u, int wr, int wc, int fr, int fq) const {
        asm volatile("" : "+v"(fr), "+v"(fq));
        const int b = u.pm >> 5, rblk = (u.pm >> 3) & 3, cblk = u.pm & 7;
        const int chl = 32 * wc + 8 * fq, ch = 128 * u.pn + chl;
        const int q = fr >> 2, lc = 4 * wr + (fr & 3);
        const size_t tok00 = (size_t)b * 8192 + (size_t)(32 * rblk) * 64 + 8 * cblk + lc;
        {
            const float* bp = bias + (size_t)b * bias_bstride + 256 * u.pn + chl;
            int slot = 0;
#pragma unroll
            for (int j = 1; j < 8; ++j) if (pml[j] == u.pm) slot = j;
            const f32x4 ba0 = *(const f32x4*)(bp), ba1 = *(const f32x4*)(bp + 4), bb0 = *(const f32x4*)(bp + 128), bb1 = *(const f32x4*)(bp + 132);
#pragma unroll
            for (int ai = 0; ai < 2; ++ai)
#pragma unroll
                for (int m = 0; m < 4; ++m) { const int rl = ai * HALF + wr * 64 + m * 16 + fr; const float rsv = rs[slot * 256 + rl];
                    acc[ai][0][m][0] = acc[ai][0][m][0] * rsv + ba0; acc[ai][0][m][1] = acc[ai][0][m][1] * rsv + ba1; acc[ai][1][m][0] = acc[ai][1][m][0] * rsv + bb0; acc[ai][1][m][1] = acc[ai][1][m][1] * rsv + bb1; }
        }
        {
            const bool top = fr < 8; const f32x4 a0 = top ? acc[0][0][0][0] : acc[1][0][3][0], a1 = top ? acc[0][0][0][1] : acc[1][0][3][1], b0 = top ? acc[0][1][0][0] : acc[1][1][3][0], b1 = top ? acc[0][1][0][1] : acc[1][1][3][1];
            bf16_t* eb = EDGE + ((size_t)((b * 4 + rblk) * 6) * 64 + (size_t)(8 * cblk + lc)) * nch + ch; const size_t ss = (size_t)64 * nch;
            u32x4 w; w.x = cvt_pk_bf16(a0[0], a0[1]); w.y = cvt_pk_bf16(a0[2], a0[3]); w.z = cvt_pk_bf16(a1[0], a1[1]); w.w = cvt_pk_bf16(a1[2], a1[3]);
            *(u32x4*)(eb + (size_t)q * ss) = w;
            if (q == 0 || q == 3) { u32x4 v; v.x = cvt_pk_bf16(b0[0], b0[1]); v.y = cvt_pk_bf16(b0[2], b0[3]); v.z = cvt_pk_bf16(b1[0], b1[1]); v.w = cvt_pk_bf16(b1[2], b1[3]); *(u32x4*)(eb + (size_t)(q == 0 ? 4 : 5) * ss) = v; }
        }
#pragma unroll
        for (int n = 0; n < 2; ++n) {
            constexpr float NL2E = -1.4426950408889634f;
            const f32x4 w0 = *(const f32x4*)(fcw + ch + 4 * n) * NL2E, w1 = *(const f32x4*)(fcw + nch + ch + 4 * n) * NL2E, w2 = *(const f32x4*)(fcw + 2 * nch + ch + 4 * n) * NL2E, cb = *(const f32x4*)(fcb + ch + 4 * n) * NL2E;
#pragma unroll
            for (int e = 0; e < 4; ++e) {
                float r4[2][4], r12[2][4];
#pragma unroll
                for (int ai = 0; ai < 2; ++ai)
#pragma unroll
                    for (int m = 0; m < 4; ++m) { r4[ai][m] = dpp_ror4(acc[ai][0][m][n][e]); r12[ai][m] = dpp_ror12(acc[ai][0][m][n][e]); }
#pragma unroll
                for (int ai = 0; ai < 2; ++ai)
#pragma unroll
                    for (int m = 0; m < 4; ++m) {
                        const float up = q > 0 ? r4[ai][m] : (m > 0 ? r4[ai][m > 0 ? m - 1 : 0] : (ai > 0 ? r4[0][3] : 0.f));
                        const float dn = q < 3 ? r12[ai][m] : (m < 3 ? r12[ai][m < 3 ? m + 1 : 3] : (ai < 1 ? r12[1][0] : 0.f));
                        const float t = __builtin_fmaf(w2[e], dn, __builtin_fmaf(w1[e], acc[ai][0][m][n][e], __builtin_fmaf(w0[e], up, cb[e])));
                        float res = (t * -0.6931471805599453f) * __builtin_amdgcn_rcpf(1.f + __builtin_amdgcn_exp2f(t)) * acc[ai][1][m][n][e];
                        asm volatile("" : "+v"(res));
                        acc[ai][0][m][n][e] = res;
                    }
                __builtin_amdgcn_sched_barrier(0);
            }
        }
#pragma unroll
        for (int ai = 0; ai < 2; ++ai)
#pragma unroll
            for (int m = 0; m < 4; ++m) { const int lr = 16 * ai + 4 * m + q;
                if (lr != 0 && lr != 31) { const f32x4 v0 = acc[ai][0][m][0], v1 = acc[ai][0][m][1];
                    u32x4 w; w.x = cvt_pk_bf16(v0[0], v0[1]); w.y = cvt_pk_bf16(v0[2], v0[3]); w.z = cvt_pk_bf16(v1[0], v1[1]); w.w = cvt_pk_bf16(v1[2], v1[3]);
                    *(u32x4*)(ACT + (tok00 + (size_t)lr * 64) * lda + ch) = w; } }
    }
};
struct EpiNull {
    static constexpr bool PERM = true, AFTER_DRAIN = false, GRIDMAP = false;
    __device__ __forceinline__ void operator()(const f32x4 (&acc)[2][2][4][2], const Unit&, int, int, int, int) const {
#pragma unroll
        for (int ai = 0; ai < 2; ++ai)
#pragma unroll
            for (int bj = 0; bj < 2; ++bj)
#pragma unroll
                for (int m = 0; m < 4; ++m)
#pragma unroll
                    for (int n = 0; n < 2; ++n) asm volatile("" :: "v"(acc[ai][bj][m][n]));
    }
};
struct SameTileOrder : StaticOrder {
    __host__ __device__ bool next(int i, Unit& u) const { const long L = (long)i * G + c; if (L >= nwg) return false; u.pm = 0; u.pn = c % nN; return true; }
};
template <class Epi, class Sched, bool ALIGN_EPI = false, bool SP2 = false>
__device__ __forceinline__ void gemm_phase(PG8_LAS unsigned char* lds, const Gemm g, const Sched& S, const Epi& E) {
    const int tid = threadIdx.x, wid = __builtin_amdgcn_readfirstlane(tid >> 6), lane = tid & 63, wr = wid >> 2, wc = wid & 3, fr = lane & 15, fq = lane >> 4;
    const int K = g.K, nt = K / BK;
    unsigned voffA[2], voffB[2];
#pragma unroll
    for (int i = 0; i < 2; ++i) { int R, C; stage_rc(tid * 16 + i * 8192, R, C); const int Rb = Epi::PERM ? ((R & ~31) + perm32(R & 31)) : R;
        const int Ra = Epi::GRIDMAP ? ((4 * ((R >> 4) & 3) + ((R & 15) >> 2)) * 64 + 4 * (R >> 6) + (R & 3)) : R;
        voffA[i] = (unsigned)(Ra * K + C) * 2u; voffB[i] = (unsigned)(Rb * K + C) * 2u; }
    const size_t kstep = (size_t)(BK * 2);
    const size_t hstep = (size_t)HALF * K * 2;
    const size_t tstep = 2 * hstep;
    const size_t hstepA = Epi::GRIDMAP ? (size_t)1024 * K * 2 : hstep;
#define PG8_ABASE(pm_) ((const char*)g.A + (Epi::GRIDMAP ? (size_t)(((pm_) >> 5) * 8192 + (((pm_) >> 3) & 3) * 2048 + ((pm_) & 7) * 8) * K * 2 : (size_t)(pm_) * tstep))
    const unsigned ldsw = (unsigned)wid * 1024u;
    const int aoff = lds_byte(wr * 64 + fr, fq * 8), boff = lds_byte(wc * 32 + fr, fq * 8);
#define PG8_SA(b, h) (((b) * 2 + (h)) * HTB)
#define PG8_SB(b, h) ((4 + (b) * 2 + (h)) * HTB)
#define PG8_STAGE(bufoff, gbase, voff) do { _Pragma("unroll") for (int _i = 0; _i < 2; ++_i) \
        __builtin_amdgcn_global_load_lds((const unsigned*)((const char*)(gbase) + (voff)[_i]), (PG8_LAS unsigned*)(lds + (bufoff) + ldsw + _i * 8192), 16, 0, 0); } while (0)
#define PG8_LDA(dst, b, h) do { _Pragma("unroll") for (int m = 0; m < 4; ++m) _Pragma("unroll") for (int k = 0; k < 2; ++k) dst[m][k] = *(const PG8_LAS bf16x8*)(lds + PG8_SA(b, h) + aoff + m * 2048 + k * 1024); } while (0)
#define PG8_LDB(dst, b, h) do { _Pragma("unroll") for (int n = 0; n < 2; ++n) _Pragma("unroll") for (int k = 0; k < 2; ++k) dst[n][k] = *(const PG8_LAS bf16x8*)(lds + PG8_SB(b, h) + boff + n * 2048 + k * 1024); } while (0)
#define PG8_MMA(ai, bj, At, Bt) do { __builtin_amdgcn_s_setprio(1); _Pragma("unroll") for (int m = 0; m < 4; ++m) _Pragma("unroll") for (int n = 0; n < 2; ++n) _Pragma("unroll") for (int k = 0; k < 2; ++k) \
        acc[ai][bj][m][n] = __builtin_amdgcn_mfma_f32_16x16x32_bf16(Bt[n][k], At[m][k], acc[ai][bj][m][n], 0, 0, 0); __builtin_amdgcn_s_setprio(0); } while (0)
#define PG8_WAIT_V(n) asm volatile("s_waitcnt vmcnt(" #n ")" ::: "memory")
#define PG8_WAIT_L(n) asm volatile("s_waitcnt lgkmcnt(" #n ")" ::: "memory")
#define PG8_BAR __builtin_amdgcn_s_barrier()
#define PG8_SCHED __builtin_amdgcn_sched_barrier(0)
    Unit cur, nxt; int ui = 0;
    if (!S.next(0, cur)) return;
    f32x4 acc[2][2][4][2];
#pragma unroll
    for (int a = 0; a < 2; ++a)
#pragma unroll
        for (int b = 0; b < 2; ++b)
#pragma unroll
            for (int m = 0; m < 4; ++m)
#pragma unroll
                for (int n = 0; n < 2; ++n) acc[a][b][m][n] = (f32x4){0.f, 0.f, 0.f, 0.f};
    bf16x8 At[4][2], B0[2][2], B1[2][2];
    const char* cA = PG8_ABASE(cur.pm); const char* cB = (const char*)g.Bt + (size_t)cur.pn * tstep;
    S.a_ready(cur);
    if constexpr (SP2) {
        PG8_STAGE(PG8_SB(0, 0), cB, voffB); PG8_STAGE(PG8_SB(0, 1), cB + hstep, voffB); PG8_STAGE(PG8_SA(0, 0), cA, voffA); PG8_STAGE(PG8_SA(0, 1), cA + hstepA, voffA);
        if (wr == 1) PG8_BAR;
        PG8_WAIT_V(2); PG8_BAR;
        PG8_STAGE(PG8_SB(1, 0), cB + kstep, voffB); PG8_STAGE(PG8_SA(1, 0), cA + kstep, voffA); PG8_STAGE(PG8_SB(1, 1), cB + hstep + kstep, voffB);
        PG8_WAIT_V(6); PG8_BAR;
    } else {
        PG8_STAGE(PG8_SB(0, 0), cB, voffB); PG8_STAGE(PG8_SA(0, 0), cA, voffA); PG8_STAGE(PG8_SB(0, 1), cB + hstep, voffB); PG8_STAGE(PG8_SA(0, 1), cA + hstepA, voffA);
        if (wr == 1) PG8_BAR;
        PG8_WAIT_V(4); PG8_BAR;
        PG8_STAGE(PG8_SB(1, 0), cB + kstep, voffB); PG8_STAGE(PG8_SA(1, 0), cA + kstep, voffA); PG8_STAGE(PG8_SB(1, 1), cB + hstep + kstep, voffB);
        PG8_WAIT_V(6); PG8_BAR;
    }
    for (;;) {
        const bool has_next = S.next(ui + 1, nxt);
        const char* nA = has_next ? PG8_ABASE(nxt.pm) : cA; const char* nB = has_next ? (const char*)g.Bt + (size_t)nxt.pn * tstep : cB;
        for (int t = 0; t < nt; t += 2) {
            const bool last = (t == nt - 2);
            const char* a1 = cA + (size_t)(t + 1) * kstep;
            const char* a2 = last ? nA : cA + (size_t)(t + 2) * kstep; const char* b2 = last ? nB : cB + (size_t)(t + 2) * kstep;
            const char* a3 = a2 + kstep; const char* b3 = b2 + kstep;
            if (last && has_next) S.a_ready(nxt);
            if constexpr (SP2) {
            PG8_LDB(B0, 0, 0); PG8_LDB(B1, 0, 1); PG8_SCHED; PG8_LDA(At, 0, 0); PG8_STAGE(PG8_SA(1, 1), a1 + hstepA, voffA);
            PG8_WAIT_V(8); PG8_WAIT_L(0); PG8_BAR; PG8_MMA(0, 0, At, B0); PG8_MMA(0, 1, At, B1); PG8_BAR; PG8_SCHED;
            PG8_LDA(At, 0, 1); PG8_STAGE(PG8_SB(0, 0), b2, voffB); PG8_STAGE(PG8_SB(0, 1), b2 + hstep, voffB); PG8_STAGE(PG8_SA(0, 0), a2, voffA);
            PG8_WAIT_V(8); PG8_WAIT_L(0); PG8_BAR; PG8_MMA(1, 0, At, B0); PG8_MMA(1, 1, At, B1); PG8_BAR; PG8_SCHED;
            PG8_LDB(B0, 1, 0); PG8_LDB(B1, 1, 1); PG8_SCHED; PG8_LDA(At, 1, 0); PG8_STAGE(PG8_SA(0, 1), a2 + hstepA, voffA);
            PG8_WAIT_V(8); PG8_WAIT_L(0); PG8_BAR; PG8_MMA(0, 0, At, B0); PG8_MMA(0, 1, At, B1); PG8_BAR; PG8_SCHED;
            PG8_LDA(At, 1, 1); PG8_STAGE(PG8_SB(1, 0), b3, voffB); PG8_STAGE(PG8_SB(1, 1), b3 + hstep, voffB); PG8_STAGE(PG8_SA(1, 0), a3, voffA);
            PG8_WAIT_V(8); PG8_WAIT_L(0); PG8_BAR; PG8_MMA(1, 0, At, B0); PG8_MMA(1, 1, At, B1); PG8_BAR; PG8_SCHED;
            } else {
            PG8_LDB(B0, 0, 0); PG8_SCHED; PG8_LDA(At, 0, 0); PG8_STAGE(PG8_SA(1, 1), a1 + hstepA, voffA);
            PG8_WAIT_L(8); PG8_BAR; PG8_WAIT_L(0); PG8_MMA(0, 0, At, B0); PG8_BAR; PG8_SCHED;
            PG8_LDB(B1, 0, 1); PG8_STAGE(PG8_SB(0, 0), b2, voffB);
            PG8_BAR; PG8_WAIT_L(0); PG8_MMA(0, 1, At, B1); PG8_BAR;
            PG8_LDA(At, 0, 1); PG8_STAGE(PG8_SA(0, 0), a2, voffA);
            PG8_BAR; PG8_WAIT_L(0); PG8_MMA(1, 0, At, B0); PG8_BAR; PG8_SCHED;
            PG8_STAGE(PG8_SB(0, 1), b2 + hstep, voffB);
            PG8_WAIT_V(6); PG8_BAR; PG8_MMA(1, 1, At, B1); PG8_BAR;
            PG8_LDB(B0, 1, 0); PG8_SCHED; PG8_LDA(At, 1, 0); PG8_STAGE(PG8_SA(0, 1), a2 + hstepA, voffA);
            PG8_WAIT_L(8); PG8_BAR; PG8_WAIT_L(0); PG8_MMA(0, 0, At, B0); PG8_BAR; PG8_SCHED;
            PG8_LDB(B1, 1, 1); PG8_STAGE(PG8_SB(1, 0), b3, voffB);
            PG8_BAR; PG8_WAIT_L(0); PG8_MMA(0, 1, At, B1); PG8_BAR;
            PG8_LDA(At, 1, 1); PG8_STAGE(PG8_SA(1, 0), a3, voffA);
            PG8_BAR; PG8_WAIT_L(0); PG8_MMA(1, 0, At, B0); PG8_BAR; PG8_SCHED;
            PG8_STAGE(PG8_SB(1, 1), b3 + hstep, voffB);
            PG8_WAIT_V(6); PG8_BAR; PG8_MMA(1, 1, At, B1); PG8_BAR;
            }
        }
        if constexpr (ALIGN_EPI) { if (wr == 0) PG8_BAR; }
        if constexpr (!Epi::AFTER_DRAIN) { E(acc, cur, wr, wc, fr, fq); S.done(cur); }
        if (!has_next) break;
#pragma unroll
        for (int a = 0; a < 2; ++a)
#pragma unroll
            for (int b = 0; b < 2; ++b)
#pragma unroll
                for (int m = 0; m < 4; ++m)
#pragma unroll
                    for (int n = 0; n < 2; ++n) acc[a][b][m][n] = (f32x4){0.f, 0.f, 0.f, 0.f};
        cur = nxt; cA = nA; cB = nB; ++ui;
        if constexpr (ALIGN_EPI) { if (wr == 1) PG8_BAR; }
    }
    PG8_WAIT_V(0);
    if constexpr (!ALIGN_EPI) { if (wr == 0) PG8_BAR; }
    PG8_BAR;
#undef PG8_ABASE
#undef PG8_SA
#undef PG8_SB
#undef PG8_STAGE
#undef PG8_LDA
#undef PG8_LDB
#undef PG8_MMA
#undef PG8_WAIT_V
#undef PG8_WAIT_L
#undef PG8_BAR
#undef PG8_SCHED
}
}

constexpr int NWAVES = 8, NTHR = 512;
constexpr int BATCH = 2, SEQ = 8192, D = 2048, M = BATCH * SEQ, CTXL = 256, MC = BATCH * CTXL;
constexpr int RW = 1024, NH = 8, DH = 128, CCH = 1024, INW = 7168, DFF = 5632, NUP = 2 * DFF, NCHK = 64, CHK = 128;
constexpr int NMOD = 6 * D;
constexpr int PLD = 3 * RW;
constexpr float EPS = 1e-6f;
constexpr float KSCALE = 0.08838834764831845f;
constexpr int NSL = 8;

constexpr size_t MiB = 1u << 20;
constexpr size_t WS_CTL = 0, CTL_ZERO_BYTES = 1 * MiB;
constexpr size_t WS_COS = 1 * MiB, WS_SIN = WS_COS + 16384, WS_PW = WS_COS + 32768, WS_MODF = WS_COS + 65536, WS_MUL2 = WS_COS + 212992, WS_BIAS2 = WS_COS + 229376, WS_MODP = WS_COS + 524288;
constexpr int PWS = 260;
constexpr size_t WS_WOUT = 4 * MiB, WS_WUP = 12 * MiB, WS_WDN = 56 * MiB, WS_XN = 78 * MiB, WS_HC = 142 * MiB, WS_KVC = 144 * MiB, WS_BIG = 146 * MiB;
constexpr size_t WS_P = WS_BIG, WS_GS = WS_BIG + 96 * MiB  , WS_CAT = WS_BIG + 224 * MiB, WS_WIN = WS_BIG + 128 * MiB  , WS_UA = WS_BIG, WS_UB = WS_BIG + 176 * MiB;
constexpr size_t WS_SPV = WS_BIG + 288 * MiB;
constexpr size_t WS_CTXS = WS_BIG + 352 * MiB;
constexpr size_t WS_ROWSS = WS_CTXS + 4 * MiB;
constexpr size_t WS_END = WS_ROWSS + 2 * MiB;
static_assert(WS_MODP + (size_t)NSL * 3 * NMOD * 4 <= WS_WOUT && WS_BIAS2 + 2 * (size_t)NUP * 4 <= WS_MODP && WS_MUL2 + 2 * D * 4 <= WS_BIAS2 && WS_MODF + 3 * (size_t)NMOD * 4 <= WS_MUL2, "tables");
constexpr int CW_BAR = 4096;

constexpr int LDS_BYTES = 147456;
constexpr int MISC_OFF = LDS_BYTES - 256;

#define GAS __attribute__((address_space(1)))
#define LAS __attribute__((address_space(3)))
typedef unsigned short bf16;
typedef unsigned v4u __attribute__((ext_vector_type(4)));
typedef unsigned v2u __attribute__((ext_vector_type(2)));
typedef float f32x4 __attribute__((ext_vector_type(4)));
typedef GAS unsigned gu32;
#define LDS_WAIT() asm volatile("s_waitcnt lgkmcnt(0)" ::: "memory")
#define VM_WAIT() asm volatile("s_waitcnt vmcnt(0)" ::: "memory")
__device__ __forceinline__ unsigned f2bf(float f) { unsigned u = __builtin_bit_cast(unsigned, f); return (u + 0x7fffu + ((u >> 16) & 1u)) >> 16; }
__device__ __forceinline__ unsigned pk2(float lo, float hi) { return f2bf(lo) | (f2bf(hi) << 16); }
__device__ __forceinline__ float bflo(unsigned w) { return __builtin_bit_cast(float, w << 16); }
__device__ __forceinline__ float bfhi(unsigned w) { return __builtin_bit_cast(float, w & 0xffff0000u); }
__device__ __forceinline__ float bf1(bf16 h) { return __builtin_bit_cast(float, ((unsigned)h) << 16); }
__device__ __forceinline__ float silu_f(float x) { return x * __builtin_amdgcn_rcpf(1.f + __expf(-x)); }
__device__ __forceinline__ float wave_sum(float v) {
#pragma unroll
    for (int o = 1; o < 64; o <<= 1) v += __shfl_xor(v, o);
    return v;
}


typedef short s16x4 __attribute__((ext_vector_type(4)));
typedef short bf16x8 __attribute__((ext_vector_type(8)));
__device__ __forceinline__ unsigned off_b(unsigned row, unsigned ch) { return 256u * row + 16u * (ch ^ (((row & 3u) << 2) | ((row >> 2) & 3u))); }
__device__ __forceinline__ s16x4 tr_rd(LAS unsigned char* p) { return __builtin_bit_cast(s16x4, __builtin_amdgcn_ds_read_tr16_b64_v4i16((LAS s16x4*)p)); }
__device__ __forceinline__ bf16x8 tr_frag(LAS unsigned char* img, unsigned lane, unsigned Ra, unsigned Rb, unsigned c) {
    const unsigned q = (lane & 15u) >> 2, p = lane & 3u;
    const s16x4 lo = tr_rd(img + off_b(Ra + q, 2u * c + (p >> 1)) + 8u * (p & 1u));
    const s16x4 hi = tr_rd(img + off_b(Rb + q, 2u * c + (p >> 1)) + 8u * (p & 1u));
    return __builtin_shufflevector(lo, hi, 0, 1, 2, 3, 4, 5, 6, 7);
}
__device__ __forceinline__ bf16x8 row_frag(LAS unsigned char* img, unsigned lane, unsigned rb, unsigned s_) { return *(const LAS bf16x8*)(img + off_b(16u * rb + (lane & 15u), 4u * s_ + (lane >> 4))); }
__device__ __forceinline__ v4u scale_pk8(v4u q, float w) { v4u o; o.x = pk2(bflo(q.x) * w, bfhi(q.x) * w); o.y = pk2(bflo(q.y) * w, bfhi(q.y) * w); o.z = pk2(bflo(q.z) * w, bfhi(q.z) * w); o.w = pk2(bflo(q.w) * w, bfhi(q.w) * w); return o; }

#define XB_TMO      128
#define XB_XCNT(j)  (256  + 64 * (j))
#define XB_XSUB(j)  (1280 + 64 * (j))
#define XB_XGEN(j)  (2304 + 64 * (j))
#define XB_TOP      3328
#define XB_TOPGEN   3392
#define XCD_BAR_WORDS 3456
#define XB_SPIN_CAP (1u << 18)
__device__ __forceinline__ unsigned xb_ld(unsigned* p)              { return __hip_atomic_load(p, __ATOMIC_RELAXED, __HIP_MEMORY_SCOPE_AGENT); }
__device__ __forceinline__ unsigned xb_add(unsigned* p, unsigned v) { return __hip_atomic_fetch_add(p, v, __ATOMIC_RELAXED, __HIP_MEMORY_SCOPE_AGENT); }
__device__ __forceinline__ unsigned xb_xcc_id() { return (unsigned)__builtin_amdgcn_s_getreg((3 << 11) | 20) & 0xFu; }
#define XB_SPIN(cond, bar) do { unsigned _sp = 0; while (cond) { __builtin_amdgcn_s_sleep(1); \
    if ((++_sp & 255u) == 0u) { if (xb_ld(&(bar)[XB_TMO])) break; if (_sp > XB_SPIN_CAP) { atomicAdd(&(bar)[XB_TMO], 1u); break; } } } } while (0)
struct XcdBarrier { unsigned* bar; unsigned x; volatile LAS unsigned* st; };
__device__ __forceinline__ XcdBarrier xcd_barrier_post(unsigned* bar, volatile LAS unsigned* st) {
    XcdBarrier b; b.bar = bar; b.x = xb_xcc_id(); b.st = st;
    if (threadIdx.x == 0) (void)xb_add(&bar[XB_XCNT(b.x)], 1u);
    return b;
}
__device__ __forceinline__ void xcd_barrier_complete(unsigned* bar, unsigned x, unsigned& nloc, unsigned& nx) {
    const unsigned G = gridDim.x * gridDim.y * gridDim.z;
    unsigned sum, cnt, mine, sp = 0u;
    for (;;) {
        sum = 0u; cnt = 0u; mine = 0u;
#pragma unroll
        for (unsigned j = 0; j < 16; ++j) { const unsigned c = xb_ld(&bar[XB_XCNT(j)]); sum += c; cnt += (c > 0u) ? 1u : 0u; mine = (j == x) ? c : mine; }
        if (sum == G) break;
        __builtin_amdgcn_s_sleep(1);
        if ((++sp & 255u) == 0u) { if (xb_ld(&bar[XB_TMO])) break; if (sp > XB_SPIN_CAP) { atomicAdd(&bar[XB_TMO], 1u); break; } }
    }
    nloc = mine > 0u ? mine : 1u; nx = cnt > 0u ? cnt : 1u;
}
__device__ __forceinline__ void xcd_barrier(const XcdBarrier& b) {
    asm volatile("s_waitcnt vmcnt(0)" ::: "memory");
    __syncthreads();
    if (threadIdx.x == 0) {
        unsigned* bar = b.bar;
        __builtin_amdgcn_s_waitcnt(0);
        unsigned nloc = b.st[0], nx = b.st[1];
        if (nloc == 0u) { xcd_barrier_complete(bar, b.x, nloc, nx); b.st[0] = nloc; b.st[1] = nx; }
        const unsigned old = xb_add(&bar[XB_XSUB(b.x)], 1u);
        const unsigned gen = old / nloc;
        if (old + 1u == (gen + 1u) * nloc) {
            __builtin_amdgcn_fence(__ATOMIC_RELEASE, "agent");
            asm volatile("s_waitcnt vmcnt(0)" ::: "memory");
            const unsigned og = xb_add(&bar[XB_TOP], 1u);
            const unsigned tg = og / nx;
            if (og + 1u == (tg + 1u) * nx) xb_add(&bar[XB_TOPGEN], 1u);
            else XB_SPIN(xb_ld(&bar[XB_TOPGEN]) == tg, bar);
            __builtin_amdgcn_fence(__ATOMIC_ACQUIRE, "agent");
            xb_add(&bar[XB_XGEN(b.x)], 1u);
            asm volatile("s_waitcnt vmcnt(0)" ::: "memory");
        } else {
            XB_SPIN(xb_ld(&bar[XB_XGEN(b.x)]) == gen, bar);
            __builtin_amdgcn_fence(__ATOMIC_ACQUIRE, "agent");
            asm volatile("s_waitcnt vmcnt(0)" ::: "memory");
        }
    }
    __syncthreads();
}

struct Args { const float* in[18]; float* out; unsigned char* ws; int ph_lo, ph_hi; };
enum { IN_X = 0, IN_C, IN_CTX, IN_CCTX, IN_WMOD, IN_BMOD, IN_G1, IN_WIN, IN_DECF, IN_DECB, IN_CONVW, IN_WOUT, IN_G2, IN_WUP, IN_FCW, IN_FCB, IN_WDN, IN_GF };
enum { PH_PRO = 0, PH_NORM1, PH_GEMM_IN, PH_KV, PH_SCAN, PH_RETOUT, PH_GEMM_OUT, PH_NORM2, PH_GEMM_UP, PH_GATE, PH_GEMM_DN, PH_FNORM, NPH };

__device__ __forceinline__ void tr_load(const float* W, int N, int k0, int n0, f32x4 (&v)[16], int lane) {
#pragma unroll
    for (int i = 0; i < 16; ++i) v[i] = *(const f32x4*)(W + (size_t)(k0 + 4 * i + (lane >> 4)) * N + n0 + 4 * (lane & 15));
}
__device__ __forceinline__ void tr_to_lds(const f32x4 (&v)[16], LAS float* scr, int lane) {
#pragma unroll
    for (int i = 0; i < 16; ++i) { LAS float* d = scr + (4 * i + (lane >> 4)) * 65 + 4 * (lane & 15); d[0] = v[i].x; d[1] = v[i].y; d[2] = v[i].z; d[3] = v[i].w; }
    LDS_WAIT(); asm volatile("" ::: "memory");
}
__device__ __forceinline__ void tr_store(bf16* WT, int K, int mode  , int k0, int n0, LAS float* scr, int lane) {
    const int c = lane & 7;
#pragma unroll
    for (int j = 0; j < 8; ++j) { const int n = (lane >> 3) + 8 * j; const LAS float* s = scr + (8 * c) * 65 + n;
        v4u o; o.x = pk2(s[0 * 65], s[1 * 65]); o.y = pk2(s[2 * 65], s[3 * 65]); o.z = pk2(s[4 * 65], s[5 * 65]); o.w = pk2(s[6 * 65], s[7 * 65]);
        int ng = n0 + n;
        if (mode == 2) { const int cc = ng < DFF ? ng : ng - DFF; ng = 256 * (cc >> 7) + (ng < DFF ? 0 : 128) + (cc & 127); }
        if (mode == 1) {
            if (ng < 2 * RW) ng = (ng & ~63) + 2 * (ng & 31) + ((ng >> 5) & 1);
            else if (ng >= 3 * RW) {
                const int sec = (ng - 3 * RW) >> 10, cc = (ng - 3 * RW) & 1023, tt = cc >> 6, r = cc & 63;
                const int lanecol = 32 * (r >> 4) + 8 * ((r >> 2) & 3) + (r & 3);
                ng = 256 * (12 + tt) + lanecol + (sec == 0 ? 128 + 4 : sec == 1 ? 128 : sec == 2 ? 0 : 4); }
        }
        *(GAS v4u*)(WT + (size_t)ng * K + k0 + 8 * c) = o; }
    LDS_WAIT(); asm volatile("" ::: "memory");
}

__device__ __forceinline__ void norm_row_bf16(const float* xrow, bf16* orow, const LAS float* mulT, const LAS float* addT, int lane) {
    const GAS f32x4* xr = (const GAS f32x4*)xrow + lane;
    f32x4 v[8]; float s = 0.f;
#pragma unroll
    for (int j = 0; j < 8; ++j) { v[j] = xr[64 * j]; s += (v[j].x * v[j].x + v[j].y * v[j].y) + (v[j].z * v[j].z + v[j].w * v[j].w); }
    const float rstd = rsqrtf(wave_sum(s) * (1.f / D) + EPS);
    GAS v2u* o8 = (GAS v2u*)orow + lane;
#pragma unroll
    for (int j = 0; j < 8; ++j) { const f32x4 mu = *(const LAS f32x4*)(mulT + 4 * (lane + 64 * j)), ad = *(const LAS f32x4*)(addT + 4 * (lane + 64 * j));
        const f32x4 y = v[j] * rstd * mu + ad; v2u w; w.x = pk2(y.x, y.y); w.y = pk2(y.z, y.w); o8[64 * j] = w; }
}

__device__ __forceinline__ void norm_row2_bf16(const float* xa, bf16* oa, const LAS float* mulA, const LAS float* addA, const float* xb, bf16* ob, const LAS float* mulB, const LAS float* addB, int lane) {
    const GAS f32x4* pa = (const GAS f32x4*)xa + lane; const GAS f32x4* pb = (const GAS f32x4*)xb + lane;
    f32x4 va[8], vb[8]; float sa = 0.f, sb = 0.f;
#pragma unroll
    for (int j = 0; j < 8; ++j) { va[j] = pa[64 * j]; vb[j] = pb[64 * j]; }
#pragma unroll
    for (int j = 0; j < 8; ++j) { sa += (va[j].x * va[j].x + va[j].y * va[j].y) + (va[j].z * va[j].z + va[j].w * va[j].w); sb += (vb[j].x * vb[j].x + vb[j].y * vb[j].y) + (vb[j].z * vb[j].z + vb[j].w * vb[j].w); }
    const float ra = rsqrtf(wave_sum(sa) * (1.f / D) + EPS), rb = rsqrtf(wave_sum(sb) * (1.f / D) + EPS);
    GAS v2u* qa = (GAS v2u*)oa + lane; GAS v2u* qb = (GAS v2u*)ob + lane;
#pragma unroll
    for (int j = 0; j < 8; ++j) { const f32x4 mu = *(const LAS f32x4*)(mulA + 4 * (lane + 64 * j)), ad = *(const LAS f32x4*)(addA + 4 * (lane + 64 * j));
        const f32x4 y = va[j] * ra * mu + ad; v2u w; w.x = pk2(y.x, y.y); w.y = pk2(y.z, y.w); qa[64 * j] = w; }
#pragma unroll
    for (int j = 0; j < 8; ++j) { const f32x4 mu = *(const LAS f32x4*)(mulB + 4 * (lane + 64 * j)), ad = *(const LAS f32x4*)(addB + 4 * (lane + 64 * j));
        const f32x4 y = vb[j] * rb * mu + ad; v2u w; w.x = pk2(y.x, y.y); w.y = pk2(y.z, y.w); qb[64 * j] = w; }
}

__global__ void __launch_bounds__(NTHR, 2) fwd_kernel(Args args) {
    extern __shared__ __attribute__((aligned(16))) unsigned char lds_raw[];
    LAS unsigned char* lds = (LAS unsigned char*)lds_raw;
    volatile LAS unsigned* MISC = (volatile LAS unsigned*)(lds + MISC_OFF);
    const int tid = threadIdx.x, lane = tid & 63, wave = __builtin_amdgcn_readfirstlane(tid >> 6);
    const int G = gridDim.x, bx = blockIdx.x;
    const int gw = bx * NWAVES + wave, NGW = G * NWAVES;
    const int gtid = bx * NTHR + tid, NGT = G * NTHR;
    unsigned char* ws = args.ws;
    const float* x = args.in[IN_X]; float* out = args.out;
    float* COS = (float*)(ws + WS_COS); float* SIN = (float*)(ws + WS_SIN); float* PW = (float*)(ws + WS_PW);
    float* MODF = (float*)(ws + WS_MODF); float* MODP = (float*)(ws + WS_MODP); float* MUL2 = (float*)(ws + WS_MUL2); float* BIAS2 = (float*)(ws + WS_BIAS2); float* ROWSS = (float*)(ws + WS_ROWSS);
    bf16* WIN_T = (bf16*)(ws + WS_WIN); bf16* WOUT_T = (bf16*)(ws + WS_WOUT); bf16* WUP_T = (bf16*)(ws + WS_WUP); bf16* WDN_T = (bf16*)(ws + WS_WDN);
    bf16* XN = (bf16*)(ws + WS_XN); bf16* HC = (bf16*)(ws + WS_HC); bf16* KVC = (bf16*)(ws + WS_KVC);
    bf16* ACT = (bf16*)(ws + WS_UA); bf16* EDGE = (bf16*)(ws + WS_UB);
    bf16* P = (bf16*)(ws + WS_P); bf16* GS = (bf16*)(ws + WS_GS); bf16* CAT = (bf16*)(ws + WS_CAT); bf16* UA = (bf16*)(ws + WS_UA); bf16* UB = (bf16*)(ws + WS_UB);
    float* CTXS = (float*)(ws + WS_CTXS); bf16* SPV = (bf16*)(ws + WS_SPV); bf16* XM = (bf16*)(ws + WS_SPV);
    bf16* KVS = (bf16*)out;

    if (tid < 64) MISC[tid] = 0u;
    __syncthreads();
#if ONE_LAUNCH
    XcdBarrier bar = xcd_barrier_post((unsigned*)(ws + WS_CTL) + CW_BAR, MISC + 8);
#define GRID_BAR() xcd_barrier(bar)
#else
#define GRID_BAR() do {} while (0)
#endif
    const int lo = args.ph_lo, hi = args.ph_hi;
#ifndef PHMASK
#define PHMASK 0xFFF
#endif
#define IN(k) (((PHMASK >> (k)) & 1) && lo <= (k) && (k) < hi)
#define BOTH(k) (IN(k) && IN((k) + 1))
#ifndef REP_MASK
#define REP_MASK 0
#endif
#define REPS(k) ((((REP_MASK) >> (k)) & 1) + 1)
#ifndef TIME_PHASE
#define TIME_PHASE -1
#endif
    unsigned long long tp_a = 0, tp_b = 0;
#define TP_BEGIN(k) do { if (TIME_PHASE == (k)) tp_a = __builtin_amdgcn_s_memrealtime(); } while (0)
#define TSEG_A(k) do { if (TIME_PHASE == (k)) tp_a = __builtin_amdgcn_s_memrealtime(); } while (0)
#define TSEG_B(k) do { if (TIME_PHASE == (k)) tp_b += __builtin_amdgcn_s_memrealtime() - tp_a; } while (0)
#define TP_END(k) do { if (TIME_PHASE == (k)) tp_b = __builtin_amdgcn_s_memrealtime(); } while (0)
#ifndef GEMM_REP_SEL
#define GEMM_REP_SEL 0
#endif
#define GEMM_REP_ID 15

    if (IN(PH_PRO)) { TP_BEGIN(PH_PRO);
      for (int rep_ = 0; rep_ < REPS(PH_PRO); ++rep_) {
        LAS float* scr = (LAS float*)(lds + wave * 16640);
        constexpr int I_IN = (D / 64) * (INW / 64), I_OUT = (D / 64) * (D / 64), I_UP = (D / 64) * (NUP / 64), I_DN = (DFF / 64) * (D / 64), I_GV = NSL * (NMOD / 64);
        constexpr int NIT = I_IN + I_OUT + I_UP + I_DN + I_GV;
        if (gw < I_GV) {
            const int r = gw, s = r / (NMOD / 64), col = (r % (NMOD / 64)) * 64 + lane;
            float a0 = 0.f, a1 = 0.f, a2 = 0.f;
            for (int kb = 0; kb < 4; ++kb) {
                const int kbase = s * 256 + kb * 64;
                const float c0 = silu_f(args.in[IN_C][kbase + lane]), c1 = silu_f(args.in[IN_C][D + kbase + lane]), c2 = silu_f(args.in[IN_CCTX][kbase + lane]);
                const float* wp = args.in[IN_WMOD] + (size_t)kbase * NMOD + col;
                float wv[64];
#pragma unroll
                for (int kk = 0; kk < 64; ++kk) wv[kk] = wp[(size_t)kk * NMOD];
#pragma unroll
                for (int kk = 0; kk < 64; ++kk) {
                    a0 += wv[kk] * __builtin_bit_cast(float, __builtin_amdgcn_readlane(__builtin_bit_cast(int, c0), kk));
                    a1 += wv[kk] * __builtin_bit_cast(float, __builtin_amdgcn_readlane(__builtin_bit_cast(int, c1), kk));
                    a2 += wv[kk] * __builtin_bit_cast(float, __builtin_amdgcn_readlane(__builtin_bit_cast(int, c2), kk));
                }
            }
            MODP[((size_t)(s * 3 + 0)) * NMOD + col] = a0; MODP[((size_t)(s * 3 + 1)) * NMOD + col] = a1; MODP[((size_t)(s * 3 + 2)) * NMOD + col] = a2;
        }
        {
#define TR_DECODE(it_, P_) const float* P_##W; bf16* P_##T; int P_##K, P_##N, P_##m; { int r_ = (it_) - I_GV; \
                if (r_ < I_IN) { P_##W = args.in[IN_WIN]; P_##T = WIN_T; P_##K = D; P_##N = INW; P_##m = 1; } \
                else if ((r_ -= I_IN) < I_OUT) { P_##W = args.in[IN_WOUT]; P_##T = WOUT_T; P_##K = D; P_##N = D; P_##m = 0; } \
                else if ((r_ -= I_OUT) < I_UP) { P_##W = args.in[IN_WUP]; P_##T = WUP_T; P_##K = D; P_##N = NUP; P_##m = 2; } \
                else { r_ -= I_UP; P_##W = args.in[IN_WDN]; P_##T = WDN_T; P_##K = DFF; P_##N = D; P_##m = 0; } \
                P_##k0 = 64 * (r_ % (P_##K / 64)); P_##n0 = 64 * (r_ / (P_##K / 64)); }
            int it = gw < I_GV ? gw + NGW : gw;
            f32x4 v[16];
            if (it < NIT) { int c_k0, c_n0; TR_DECODE(it, c_) (void)c_T; (void)c_K; (void)c_m; tr_load(c_W, c_N, c_k0, c_n0, v, lane); }
            for (; it < NIT; it += NGW) {
                int c_k0, c_n0; TR_DECODE(it, c_) (void)c_W; (void)c_N;
                tr_to_lds(v, scr, lane);
                if (it + NGW < NIT) { int n_k0, n_n0; TR_DECODE(it + NGW, n_) (void)n_T; (void)n_K; (void)n_m; tr_load(n_W, n_N, n_k0, n_n0, v, lane); }
                tr_store(c_T, c_K, c_m, c_k0, c_n0, scr, lane);
            }
#undef TR_DECODE
        }
        if (gtid < 4096) { const int pos = gtid >> 5, i = gtid & 31; const float fr = powf(10000.f, -(float)i / 32.f); const float ang = (float)pos * fr; COS[gtid] = cosf(ang); SIN[gtid] = sinf(ang); }
        else if (gtid < 4096 + 2 * NH * 257) { const int idx = gtid - 4096, dir = idx / (NH * 257), h = (idx / 257) % NH, k = idx % 257;
            const float lg0 = args.in[dir ? IN_DECB : IN_DECF][h]; const float lg = fminf(lg0, 0.f) - log1pf(expf(-fabsf(lg0)));
            PW[(dir * NH + h) * PWS + k] = expf(lg * (float)k); }
      }
        if (BOTH(PH_PRO)) GRID_BAR();
        TP_END(PH_PRO);
    }

    if (IN(PH_NORM1)) { TP_BEGIN(PH_NORM1);
      for (int rep_ = 0; rep_ < REPS(PH_NORM1); ++rep_) {
        if (TIME_PHASE == 110) tp_a = __builtin_amdgcn_s_memrealtime();
        LAS float* mulT = (LAS float*)lds;
        LAS float* addT = (LAS float*)(lds + 3 * D * 4);
        for (int i = tid; i < 3 * D / 4; i += NTHR) { const int r = i / (D / 4), k = 4 * (i % (D / 4));
            f32x4 sh = *(const f32x4*)(args.in[IN_BMOD] + k), sc = *(const f32x4*)(args.in[IN_BMOD] + D + k);
#pragma unroll
            for (int s = 0; s < NSL; ++s) { sh += *(const f32x4*)(MODP + (size_t)(s * 3 + r) * NMOD + k); sc += *(const f32x4*)(MODP + (size_t)(s * 3 + r) * NMOD + D + k); }
            *(LAS f32x4*)(mulT + r * D + k) = *(const f32x4*)(args.in[IN_G1] + k) * (sc + 1.f); *(LAS f32x4*)(addT + r * D + k) = sh; }
        for (int i = gtid; i < 3 * NMOD / 4; i += NGT) { const int r = i / (NMOD / 4), col = 4 * (i % (NMOD / 4)); f32x4 a = *(const f32x4*)(args.in[IN_BMOD] + col);
#pragma unroll
            for (int s = 0; s < NSL; ++s) a += *(const f32x4*)(MODP + (size_t)(s * 3 + r) * NMOD + col);
            *(f32x4*)(MODF + (size_t)r * NMOD + col) = a; }
        LAS float* sh2T = (LAS float*)(lds + 6 * D * 4);
        for (int i = tid; i < 2 * D / 4; i += NTHR) { const int r = i / (D / 4), k = 4 * (i % (D / 4)); f32x4 sh = *(const f32x4*)(args.in[IN_BMOD] + 3 * D + k);
#pragma unroll
            for (int s = 0; s < NSL; ++s) sh += *(const f32x4*)(MODP + (size_t)(s * 3 + r) * NMOD + 3 * D + k);
            *(LAS f32x4*)(sh2T + r * D + k) = sh; }
        if (gtid < 2 * D / 4) { const int r = gtid / (D / 4), k = 4 * (gtid % (D / 4)); f32x4 sc = *(const f32x4*)(args.in[IN_BMOD] + 4 * D + k);
#pragma unroll
            for (int s = 0; s < NSL; ++s) sc += *(const f32x4*)(MODP + (size_t)(s * 3 + r) * NMOD + 4 * D + k);
            *(f32x4*)(MUL2 + r * D + k) = *(const f32x4*)(args.in[IN_G2] + k) * (sc + 1.f); }
        __syncthreads();
        if (TIME_PHASE == 110) tp_b = __builtin_amdgcn_s_memrealtime();
        if (TIME_PHASE == 111) tp_a = __builtin_amdgcn_s_memrealtime();
        const int ncw = MC < NGW ? MC : 0;
        const int bc0 = ncw ? (gw < ncw ? 4 * gw : 4 * ncw + 6 * (gw - ncw)) : gw, bc1 = ncw ? (gw < ncw ? bc0 + 4 : bc0 + 6) : NUP, bcs = ncw ? 1 : NGW;
        for (int col = bc0; col < bc1 && col < NUP; col += bcs) {
            const bf16* wrow = WUP_T + (size_t)col * D; float s0 = 0.f, s1 = 0.f;
#pragma unroll
            for (int j = 0; j < 4; ++j) { const int k0 = 8 * (lane + 64 * j); const v4u wq = *(const GAS v4u*)(wrow + k0);
                const float wv[8] = {bflo(wq.x), bfhi(wq.x), bflo(wq.y), bfhi(wq.y), bflo(wq.z), bfhi(wq.z), bflo(wq.w), bfhi(wq.w)};
                const f32x4 a0 = *(const LAS f32x4*)(sh2T + k0), a1 = *(const LAS f32x4*)(sh2T + k0 + 4), c0 = *(const LAS f32x4*)(sh2T + D + k0), c1 = *(const LAS f32x4*)(sh2T + D + k0 + 4);
                s0 += (wv[0] * a0.x + wv[1] * a0.y) + (wv[2] * a0.z + wv[3] * a0.w) + (wv[4] * a1.x + wv[5] * a1.y) + (wv[6] * a1.z + wv[7] * a1.w);
                s1 += (wv[0] * c0.x + wv[1] * c0.y) + (wv[2] * c0.z + wv[3] * c0.w) + (wv[4] * c1.x + wv[5] * c1.y) + (wv[6] * c1.z + wv[7] * c1.w); }
            s0 = wave_sum(s0); s1 = wave_sum(s1);
            if (lane == 0) { BIAS2[col] = s0; BIAS2[NUP + col] = s1; }
        }
        if (TIME_PHASE == 111) tp_b = __builtin_amdgcn_s_memrealtime();
        if (TIME_PHASE == 112) tp_a = __builtin_amdgcn_s_memrealtime();
        for (int m = gw; m < M; m += 2 * NGW) {
            const int m2 = m + NGW < M ? m + NGW : m;
            norm_row2_bf16(x + (size_t)m * D, XN + (size_t)m * D, mulT + (m >> 13) * D, addT + (m >> 13) * D, x + (size_t)m2 * D, XN + (size_t)m2 * D, mulT + (m2 >> 13) * D, addT + (m2 >> 13) * D, lane);
        }
        for (int mc = gw; mc < MC; mc += NGW) norm_row_bf16(args.in[IN_CTX] + (size_t)mc * D, HC + (size_t)mc * D, mulT + 2 * D, addT + 2 * D, lane);
      }
        if (TIME_PHASE == 112) tp_b = __builtin_amdgcn_s_memrealtime();
        if (TIME_PHASE == 113) tp_a = __builtin_amdgcn_s_memrealtime();
        if (BOTH(PH_NORM1)) GRID_BAR();
        if (TIME_PHASE == 113) tp_b = __builtin_amdgcn_s_memrealtime();
        TP_END(PH_NORM1);
    }

    if (IN(PH_GEMM_IN)) { TP_BEGIN(PH_GEMM_IN);
      {
        __syncthreads();
        { pg8::Gemm g{XN, WIN_T, M, INW, D}; pg8::StaticOrder S; S.init(M, INW, G, bx);
          pg8::EpiIn E{P, PLD, CAT + RW, D, GS, RW, COS, SIN, args.in[IN_CONVW], CCH, KSCALE};
          pg8::gemm_phase<pg8::EpiIn, pg8::StaticOrder, GP_ALIGN, GP_SP2>(lds, g, S, E);
          if (REPS(GEMM_REP_ID) == 2 && GEMM_REP_SEL == __LINE__) pg8::gemm_phase<pg8::EpiIn, pg8::StaticOrder, GP_ALIGN, GP_SP2>(lds, g, S, E);
          if (GEMM_REP_SEL == 9001) { pg8::EpiNull EN; pg8::gemm_phase<pg8::EpiNull, pg8::StaticOrder, GP_ALIGN, GP_SP2>(lds, g, S, EN); }
          if (GEMM_REP_SEL == 9002) { pg8::EpiNull EN; pg8::SameTileOrder S2; S2.init(M, INW, G, bx); pg8::gemm_phase<pg8::EpiNull, pg8::SameTileOrder, GP_ALIGN, GP_SP2>(lds, g, S2, EN); } }
        { pg8::Gemm g{HC, WIN_T + (size_t)RW * D, MC, 2 * RW, D}; pg8::StaticOrder S; S.init(MC, 2 * RW, G, bx);
          pg8::EpiBf16R E{KVC, 2 * RW, 0, 0, COS, SIN, 0, 0, 4, KSCALE};
          pg8::gemm_phase<pg8::EpiBf16R, pg8::StaticOrder, GP_ALIGN, GP_SP2>(lds, g, S, E);
          if (REPS(GEMM_REP_ID) == 2 && GEMM_REP_SEL == __LINE__) pg8::gemm_phase<pg8::EpiBf16R, pg8::StaticOrder, GP_ALIGN, GP_SP2>(lds, g, S, E); }
      }
        if (BOTH(PH_GEMM_IN)) GRID_BAR();
        TP_END(PH_GEMM_IN);
    }

    if (IN(PH_KV)) { TP_BEGIN(PH_KV);
      for (int rep_ = 0; rep_ < REPS(PH_KV); ++rep_) {
        __syncthreads();
        LAS unsigned char* Kimg = lds; LAS unsigned char* Vfimg = lds + 32768; LAS unsigned char* Vbimg = lds + 65536;
        constexpr int NKVI = BATCH * NH * NCHK + BATCH * NH * 2;
#define P3_DECODE(it_) const bf16* kptr; const bf16* vptr; size_t stride; int wfo, wbo, h; size_t ooff; bool ctxi; \
            if ((it_) < BATCH * NH * NCHK) { const int b = (it_) >> 9, ch = (it_) & 63; h = ((it_) >> 6) & 7; \
                kptr = P + ((size_t)b * SEQ + (size_t)ch * CHK) * PLD + RW + h * DH; vptr = kptr + RW; stride = PLD; wfo = 127; wbo = 0; \
                ooff = ((((size_t)b * NH + h) * NCHK + ch) * DH) * DH; ctxi = false; } \
            else { const int r = (it_) - BATCH * NH * NCHK, b = r >> 4, c = r & 1; h = (r >> 1) & 7; \
                kptr = KVC + ((size_t)b * CTXL + (size_t)c * CHK) * (2 * RW) + h * DH; vptr = kptr + RW; stride = 2 * RW; wfo = CTXL - 1 - CHK * c; wbo = CHK * c; \
                ooff = ((((size_t)b * NH + h) * 2 + c) * DH) * DH; ctxi = true; } \
            (void)wfo; (void)wbo; (void)ooff; (void)ctxi; (void)kptr; (void)vptr; (void)stride;
#define P3_LOAD() do { _Pragma("unroll") for (int i = 0; i < 4; ++i) { const int p = tid + NTHR * i, row = p >> 4, c16 = p & 15; \
            nk[i] = *(const GAS v4u*)(kptr + (size_t)row * stride + c16 * 8); nv[i] = *(const GAS v4u*)(vptr + (size_t)row * stride + c16 * 8); } } while (0)
        v4u nk[4], nv[4];
        if (bx < NKVI) { P3_DECODE(bx) P3_LOAD(); }
        for (int item = bx; item < NKVI; item += G) {
            P3_DECODE(item)
            const float* pwf = PW + (0 * NH + h) * PWS; const float* pwb = PW + (1 * NH + h) * PWS;
#pragma unroll
            for (int i = 0; i < 4; ++i) { const int p = tid + NTHR * i, row = p >> 4, c16 = p & 15;
                const float wf = pwf[wfo - row], wb = pwb[wbo + row];
                const unsigned o = off_b(row, c16);
                *(LAS v4u*)(Kimg + o) = nk[i]; *(LAS v4u*)(Vfimg + o) = scale_pk8(nv[i], wf); *(LAS v4u*)(Vbimg + o) = scale_pk8(nv[i], wb); }
            if (item + G < NKVI) { const int nit = item + G; { P3_DECODE(nit) P3_LOAD(); } }
            __syncthreads();
            {
                const unsigned g4 = lane >> 4, fr = lane & 15; const int dkg = wave >> 1, dvh = wave & 1;
                f32x4 accf[4][2], accb[4][2];
#pragma unroll
                for (int mt = 0; mt < 4; ++mt)
#pragma unroll
                    for (int nt = 0; nt < 2; ++nt) { accf[mt][nt] = (f32x4){0.f, 0.f, 0.f, 0.f}; accb[mt][nt] = (f32x4){0.f, 0.f, 0.f, 0.f}; }
#pragma unroll
                for (int ks = 0; ks < 4; ++ks) {
                    bf16x8 kf[2];
#pragma unroll
                    for (int nt = 0; nt < 2; ++nt) kf[nt] = tr_frag(Kimg, lane, 32 * ks + 8 * g4, 32 * ks + 8 * g4 + 4, 2 * dkg + nt);
#pragma unroll
                    for (int mt = 0; mt < 4; ++mt) {
                        const bf16x8 vf = tr_frag(Vfimg, lane, 32 * ks + 8 * g4, 32 * ks + 8 * g4 + 4, 4 * dvh + mt);
                        const bf16x8 vb = tr_frag(Vbimg, lane, 32 * ks + 8 * g4, 32 * ks + 8 * g4 + 4, 4 * dvh + mt);
#pragma unroll
                        for (int nt = 0; nt < 2; ++nt) { accf[mt][nt] = __builtin_amdgcn_mfma_f32_16x16x32_bf16(vf, kf[nt], accf[mt][nt], 0, 0, 0); accb[mt][nt] = __builtin_amdgcn_mfma_f32_16x16x32_bf16(vb, kf[nt], accb[mt][nt], 0, 0, 0); }
                    }
                }
#pragma unroll
                for (int mt = 0; mt < 4; ++mt)
#pragma unroll
                    for (int nt = 0; nt < 2; ++nt) { const size_t o = ooff + (size_t)(16 * (2 * dkg + nt) + fr) * DH + 16 * (4 * dvh + mt) + 4 * g4;
                        if (ctxi) { *(f32x4*)(CTXS + o) = accf[mt][nt]; *(f32x4*)(CTXS + (size_t)BATCH * NH * 2 * DH * DH + o) = accb[mt][nt]; }
                        else { v2u wf_, wb_; wf_.x = pk2(accf[mt][nt].x, accf[mt][nt].y); wf_.y = pk2(accf[mt][nt].z, accf[mt][nt].w); wb_.x = pk2(accb[mt][nt].x, accb[mt][nt].y); wb_.y = pk2(accb[mt][nt].z, accb[mt][nt].w);
                            *(GAS v2u*)(KVS + o) = wf_; *(GAS v2u*)(KVS + (size_t)BATCH * NH * NCHK * DH * DH + o) = wb_; } }
            }
            __syncthreads();
        }
#undef P3_DECODE
#undef P3_LOAD
      }
        if (BOTH(PH_KV)) GRID_BAR();
        TP_END(PH_KV);
    }

    if (IN(PH_SCAN)) { TP_BEGIN(PH_SCAN);
      for (int rep_ = 0; rep_ < REPS(PH_SCAN); ++rep_) {
        for (int e4 = gtid; e4 < 2 * BATCH * NH * DH * DH / 4; e4 += NGT) {
            const int dv4 = e4 & 31, dk = (e4 >> 5) & 127, h = (e4 >> 12) & 7, b = (e4 >> 15) & 1, dir = e4 >> 16;
            const float* pw = PW + (dir * NH + h) * PWS;
            const float* c0 = CTXS + ((((size_t)(dir * BATCH + b) * NH + h) * 2 + 0) * DH) * DH + (size_t)dk * DH + dv4 * 4;
            f32x4 s = *(const f32x4*)c0 + *(const f32x4*)(c0 + (size_t)DH * DH);
            const float cd = pw[CHK];
            const size_t boff = (((size_t)(dir * BATCH + b) * NH + h) * NCHK) * DH * DH + (size_t)dk * DH + dv4 * 4;
#pragma unroll 16
            for (int i = 0; i < NCHK; ++i) {
                const int n = dir ? (NCHK - 1 - i) : i;
                const v2u tq = *(const GAS v2u*)(KVS + boff + (size_t)n * DH * DH); const f32x4 t = (f32x4){bflo(tq.x), bfhi(tq.x), bflo(tq.y), bfhi(tq.y)};
                v2u w; w.x = pk2(s.x, s.y); w.y = pk2(s.z, s.w);
                *(GAS v2u*)(SPV + boff + (size_t)n * DH * DH) = w;
                s = s * cd + t;
            }
        }
      }
        if (BOTH(PH_SCAN)) GRID_BAR();
        TP_END(PH_SCAN);
    }

    if (IN(PH_RETOUT)) { TP_BEGIN(PH_RETOUT);
      for (int rep_ = 0; rep_ < REPS(PH_RETOUT); ++rep_) {
        __syncthreads();
        LAS unsigned char* Qi = lds; LAS unsigned char* Ki = lds + 32768; LAS unsigned char* Vi = lds + 65536; LAS unsigned char* Si = lds + 98304;
        LAS float* pwl = (LAS float*)(lds + 131072);
        v4u rq[4], rk[4], rv[4], rf[4], rb[4];
#define P5_PTRS(it_) const int b_ = (it_) >> 9, h_ = ((it_) >> 6) & 7, ch_ = (it_) & 63; const size_t tk_ = (size_t)b_ * SEQ + (size_t)ch_ * CHK; const bf16* qp_ = P + tk_ * PLD + h_ * DH; \
        const bf16* sfp_ = SPV + ((((size_t)(0 * BATCH + b_) * NH + h_) * NCHK + ch_) * DH) * DH; const bf16* sbp_ = SPV + ((((size_t)(1 * BATCH + b_) * NH + h_) * NCHK + ch_) * DH) * DH; \
        const bf16* gp_ = GS + (tk_ + 16 * wave + (lane & 15)) * RW + h_ * DH + 4 * (lane >> 4); (void)qp_; (void)sfp_; (void)sbp_; (void)gp_;
#define P5_LOAD_QK() do { _Pragma("unroll") for (int i = 0; i < 4; ++i) { const int p = tid + NTHR * i, row = p >> 4, c16 = p & 15; \
            rq[i] = *(const GAS v4u*)(qp_ + (size_t)row * PLD + c16 * 8); rk[i] = *(const GAS v4u*)(qp_ + (size_t)row * PLD + RW + c16 * 8); } } while (0)
#define P5_LOAD_VFB() do { _Pragma("unroll") for (int i = 0; i < 4; ++i) { const int p = tid + NTHR * i, row = p >> 4, c16 = p & 15; \
            rv[i] = *(const GAS v4u*)(qp_ + (size_t)row * PLD + 2 * RW + c16 * 8); rf[i] = *(const GAS v4u*)(sfp_ + (size_t)row * DH + c16 * 8); rb[i] = *(const GAS v4u*)(sbp_ + (size_t)row * DH + c16 * 8); } } while (0)
#define P5_LOAD_G() do { _Pragma("unroll") for (int nt = 0; nt < 8; ++nt) rg[nt] = *(const GAS v2u*)(gp_ + 16 * nt); } while (0)
        if (bx < BATCH * NH * NCHK) { P5_PTRS(bx) P5_LOAD_QK(); }
        for (int item = bx; item < BATCH * NH * NCHK; item += G) {
            const int b = item >> 9, h = (item >> 6) & 7, ch = item & 63;
            const size_t tok0 = (size_t)b * SEQ + (size_t)ch * CHK;
            const int nitem = item + G; const bool hasn = nitem < BATCH * NH * NCHK;
            TSEG_A(120);
            int tid_o = threadIdx.x; asm volatile("" : "+v"(tid_o));
            const int tid = tid_o, lane = tid_o & 63;
#pragma unroll
            for (int i = 0; i < 4; ++i) { const int p = tid + NTHR * i, row = p >> 4, c16 = p & 15; const unsigned o = off_b(row, c16);
                *(LAS v4u*)(Qi + o) = rq[i]; *(LAS v4u*)(Ki + o) = rk[i]; }
            float pwv = 0.f; if (tid < 2 * 129) pwv = PW[((tid / 129) * NH + h) * PWS + (tid % 129)];
            { P5_PTRS(item) P5_LOAD_VFB(); }
            if (tid < 2 * 129) pwl[(tid / 129) * 132 + (tid % 129)] = pwv;
            __syncthreads();
            TSEG_B(120); TSEG_A(121);
            const unsigned g4 = lane >> 4, fr = lane & 15; const int i_in = 16 * wave + (int)fr;
            bf16x8 qf[4];
#pragma unroll
            for (int ks = 0; ks < 4; ++ks) qf[ks] = row_frag(Qi, lane, wave, ks);
            f32x4 sc[8];
#pragma unroll
            for (int jt = 0; jt < 8; ++jt) { sc[jt] = (f32x4){0.f, 0.f, 0.f, 0.f};
#pragma unroll
                for (int ks = 0; ks < 4; ++ks) sc[jt] = __builtin_amdgcn_mfma_f32_16x16x32_bf16(row_frag(Ki, lane, jt, ks), qf[ks], sc[jt], 0, 0, 0); }
            __syncthreads();
            TSEG_B(121); TSEG_A(122);
#pragma unroll
            for (int i = 0; i < 4; ++i) { const int p = tid + NTHR * i, row = p >> 4, c16 = p & 15; const unsigned o = off_b(row, c16); *(LAS v4u*)(Vi + o) = rv[i]; *(LAS v4u*)(Si + o) = rf[i]; *(LAS v4u*)(Ki + o) = rb[i]; }
            if (hasn) { P5_PTRS(nitem) P5_LOAD_QK(); }
            __syncthreads();
            TSEG_B(122); TSEG_A(123);
            v2u rg[8]; { P5_PTRS(item) P5_LOAD_G(); }
            bf16x8 pf[4];
#pragma unroll
            for (int ks = 0; ks < 4; ++ks) {
                float pv[8];
#pragma unroll
                for (int hf = 0; hf < 2; ++hf)
#pragma unroll
                    for (int rg = 0; rg < 4; ++rg) { const int j = 16 * (2 * ks + hf) + 4 * (int)g4 + rg;
                        const float dm = (j <= i_in) ? pwl[i_in - j] : pwl[132 + (j - i_in)];
                        pv[4 * hf + rg] = sc[2 * ks + hf][rg] * dm; }
                v4u w; w.x = pk2(pv[0], pv[1]); w.y = pk2(pv[2], pv[3]); w.z = pk2(pv[4], pv[5]); w.w = pk2(pv[6], pv[7]);
                pf[ks] = __builtin_bit_cast(bf16x8, w);
            }
            f32x4 o[8];
#pragma unroll
            for (int nt = 0; nt < 8; ++nt) { o[nt] = (f32x4){0.f, 0.f, 0.f, 0.f};
#pragma unroll
                for (int ks = 0; ks < 4; ++ks) o[nt] = __builtin_amdgcn_mfma_f32_16x16x32_bf16(tr_frag(Vi, lane, 32 * ks + 4 * g4, 32 * ks + 16 + 4 * g4, nt), pf[ks], o[nt], 0, 0, 0); }
            {
                const float qd = pwl[i_in + 1]; bf16x8 qs[4];
#pragma unroll
                for (int ks = 0; ks < 4; ++ks) qs[ks] = __builtin_bit_cast(bf16x8, scale_pk8(__builtin_bit_cast(v4u, qf[ks]), qd));
#pragma unroll
                for (int nt = 0; nt < 8; ++nt)
#pragma unroll
                    for (int ks = 0; ks < 4; ++ks) o[nt] = __builtin_amdgcn_mfma_f32_16x16x32_bf16(tr_frag(Si, lane, 32 * ks + 8 * g4, 32 * ks + 8 * g4 + 4, nt), qs[ks], o[nt], 0, 0, 0);
            }
            {
                const float qd = pwl[132 + (CHK - i_in)]; bf16x8 qs[4];
#pragma unroll
                for (int ks = 0; ks < 4; ++ks) qs[ks] = __builtin_bit_cast(bf16x8, scale_pk8(__builtin_bit_cast(v4u, qf[ks]), qd));
#pragma unroll
                for (int nt = 0; nt < 8; ++nt)
#pragma unroll
                    for (int ks = 0; ks < 4; ++ks) o[nt] = __builtin_amdgcn_mfma_f32_16x16x32_bf16(tr_frag(Ki, lane, 32 * ks + 8 * g4, 32 * ks + 8 * g4 + 4, nt), qs[ks], o[nt], 0, 0, 0);
            }
            TSEG_B(123); TSEG_A(124);
            {
                float ss = 0.f;
#pragma unroll
                for (int nt = 0; nt < 8; ++nt) ss += (o[nt].x * o[nt].x + o[nt].y * o[nt].y) + (o[nt].z * o[nt].z + o[nt].w * o[nt].w);
                ss += __shfl_xor(ss, 16); ss += __shfl_xor(ss, 32);
                const float rstd = rsqrtf(ss * (1.f / DH) + EPS);
                bf16* op = CAT + (tok0 + i_in) * D + h * DH + 4 * g4;
#pragma unroll
                for (int nt = 0; nt < 8; ++nt) { const v2u gq = rg[nt];
                    v2u w; w.x = pk2(o[nt].x * rstd * bflo(gq.x), o[nt].y * rstd * bfhi(gq.x)); w.y = pk2(o[nt].z * rstd * bflo(gq.y), o[nt].w * rstd * bfhi(gq.y));
                    *(GAS v2u*)(op + 16 * nt) = w; }
            }
            __syncthreads();
            TSEG_B(124);
        }
#undef P5_PTRS
#undef P5_LOAD_QK
#undef P5_LOAD_VFB
#undef P5_LOAD_G
      }
        if (BOTH(PH_RETOUT)) GRID_BAR();
        TP_END(PH_RETOUT);
    }

    if (IN(PH_GEMM_OUT)) { TP_BEGIN(PH_GEMM_OUT);
      {
        __syncthreads();
        pg8::Gemm g{CAT, WOUT_T, M, D, D}; pg8::StaticOrder S; S.init(M, D, G, bx);
        pg8::EpiResNorm E{x, XM, D, MODF + 2 * D, NMOD, MUL2, XN, ROWSS};
        pg8::gemm_phase<pg8::EpiResNorm, pg8::StaticOrder, GP_ALIGN, GP_SP2>(lds, g, S, E);
        if (REPS(GEMM_REP_ID) == 2 && GEMM_REP_SEL == __LINE__) pg8::gemm_phase<pg8::EpiResNorm, pg8::StaticOrder, GP_ALIGN, GP_SP2>(lds, g, S, E);
      }
        if (BOTH(PH_GEMM_OUT)) GRID_BAR();
        TP_END(PH_GEMM_OUT);
    }

    if (IN(PH_GEMM_UP)) { TP_BEGIN(PH_GEMM_UP);
      {
        __syncthreads();
        pg8::Gemm g{XN, WUP_T, M, NUP, D}; pg8::StaticOrder S; S.init(M, NUP, G, bx);
        LAS float* rsl = (LAS float*)(lds + 131072);
        LAS int* pml = (LAS int*)(lds + 131072 + 8192);
        if (tid == 0) { int n = 0; pg8::Unit uu; for (int i = 0; S.next(i, uu); ++i) { bool f = false; for (int j = 0; j < n; ++j) f = f || (pml[j] == uu.pm); if (!f && n < 8) pml[n++] = uu.pm; } for (int j = n; j < 8; ++j) pml[j] = -1; }
        __syncthreads();
        for (int j = 0; j < 8; ++j) { const int pmj = pml[j];
            if (pmj >= 0 && tid < 256) { const int lr = 16 * (tid >> 7) + 4 * ((tid >> 4) & 3) + ((tid & 15) >> 2), lc = 4 * ((tid >> 6) & 1) + (tid & 3);
                const size_t tok = (size_t)(pmj >> 5) * 8192 + (size_t)(32 * ((pmj >> 3) & 3) + lr) * 64 + 8 * (pmj & 7) + lc;
                const float* rp = ROWSS + tok * 32; float t = 0.f;
#pragma unroll
                for (int i = 0; i < 8; ++i) { const f32x4 q = *(const f32x4*)(rp + 4 * i); t += (q.x + q.y) + (q.z + q.w); }
                rsl[j * 256 + tid] = rsqrtf(t * (1.f / D) + EPS); } }
        __syncthreads();
        pg8::EpiGate E{ACT, DFF, EDGE, BIAS2, NUP, args.in[IN_FCW], args.in[IN_FCB], DFF, rsl, pml};
        pg8::gemm_phase<pg8::EpiGate, pg8::StaticOrder, GP_ALIGN, GP_SP2>(lds, g, S, E);
      }
        if (BOTH(PH_GEMM_UP)) GRID_BAR();
        TP_END(PH_GEMM_UP);
    }

    if (IN(PH_GATE)) { TP_BEGIN(PH_GATE);
      for (int rep_ = 0; rep_ < REPS(PH_GATE); ++rep_) {
        const float* fw = args.in[IN_FCW]; const float* fb = args.in[IN_FCB];
        for (int item = gtid; item < BATCH * 4 * 2 * 64 * (DFF / 8); item += NGT) {
            const int c8 = item % (DFF / 8), t = item / (DFF / 8), gc = t & 63, eb = (t >> 6) & 1, rblk = (t >> 7) & 3, b = t >> 9;
            auto eptr = [&](int rb, int slot) { return EDGE + ((size_t)((b * 4 + rb) * 6 + slot) * 64 + gc) * DFF + c8 * 8; };
            const v4u z = (v4u){0u, 0u, 0u, 0u};
            const v4u a0 = eb == 0 ? (rblk > 0 ? *(const GAS v4u*)eptr(rblk - 1, 3) : z) : *(const GAS v4u*)eptr(rblk, 2);
            const v4u a1 = *(const GAS v4u*)eptr(rblk, eb == 0 ? 0 : 3);
            const v4u a2 = eb == 0 ? *(const GAS v4u*)eptr(rblk, 1) : (rblk < 3 ? *(const GAS v4u*)eptr(rblk + 1, 0) : z);
            const v4u bq = *(const GAS v4u*)eptr(rblk, eb == 0 ? 4 : 5);
            const float A0[8] = {bflo(a0.x), bfhi(a0.x), bflo(a0.y), bfhi(a0.y), bflo(a0.z), bfhi(a0.z), bflo(a0.w), bfhi(a0.w)};
            const float A1[8] = {bflo(a1.x), bfhi(a1.x), bflo(a1.y), bfhi(a1.y), bflo(a1.z), bfhi(a1.z), bflo(a1.w), bfhi(a1.w)};
            const float A2[8] = {bflo(a2.x), bfhi(a2.x), bflo(a2.y), bfhi(a2.y), bflo(a2.z), bfhi(a2.z), bflo(a2.w), bfhi(a2.w)};
            const float BB[8] = {bflo(bq.x), bfhi(bq.x), bflo(bq.y), bfhi(bq.y), bflo(bq.z), bfhi(bq.z), bflo(bq.w), bfhi(bq.w)};
            float o[8];
#pragma unroll
            for (int e = 0; e < 8; ++e) { const int c = c8 * 8 + e; const float av = fw[c] * A0[e] + fw[DFF + c] * A1[e] + fw[2 * DFF + c] * A2[e] + fb[c]; o[e] = silu_f(av) * BB[e]; }
            v4u w; w.x = pk2(o[0], o[1]); w.y = pk2(o[2], o[3]); w.z = pk2(o[4], o[5]); w.w = pk2(o[6], o[7]);
            const size_t tok = (size_t)b * SEQ + (size_t)(32 * rblk + (eb ? 31 : 0)) * 64 + gc;
            *(GAS v4u*)(ACT + tok * DFF + c8 * 8) = w;
        }
      }
        if (BOTH(PH_GATE)) GRID_BAR();
        TP_END(PH_GATE);
    }

    if (IN(PH_GEMM_DN)) { TP_BEGIN(PH_GEMM_DN);
      {
        __syncthreads();
        pg8::Gemm g{ACT, WDN_T, M, D, DFF}; pg8::StaticOrder S; S.init(M, D, G, bx);
        pg8::EpiRes E{XM, XN, D, MODF + 5 * D, NMOD};
        pg8::gemm_phase<pg8::EpiRes, pg8::StaticOrder, GP_ALIGN, GP_SP2>(lds, g, S, E);
        if (REPS(GEMM_REP_ID) == 2 && GEMM_REP_SEL == __LINE__) pg8::gemm_phase<pg8::EpiRes, pg8::StaticOrder, GP_ALIGN, GP_SP2>(lds, g, S, E);
      }
        if (BOTH(PH_GEMM_DN)) GRID_BAR();
        TP_END(PH_GEMM_DN);
    }

    if (IN(PH_FNORM)) { TP_BEGIN(PH_FNORM);
        const float* gfin = args.in[IN_GF];
        for (int m = gw; m < M; m += NGW) {
            const GAS v4u* xr = (const GAS v4u*)(XN + (size_t)m * D) + lane;
            v4u q[4]; float s = 0.f;
#pragma unroll
            for (int j = 0; j < 4; ++j) q[j] = xr[64 * j];
            float v[4][8];
#pragma unroll
            for (int j = 0; j < 4; ++j) { v[j][0] = bflo(q[j].x); v[j][1] = bfhi(q[j].x); v[j][2] = bflo(q[j].y); v[j][3] = bfhi(q[j].y); v[j][4] = bflo(q[j].z); v[j][5] = bfhi(q[j].z); v[j][6] = bflo(q[j].w); v[j][7] = bfhi(q[j].w);
#pragma unroll
                for (int e = 0; e < 8; ++e) s += v[j][e] * v[j][e]; }
            const float rstd = rsqrtf(wave_sum(s) * (1.f / D) + EPS);
            float* orow = out + (size_t)m * D;
#pragma unroll
            for (int j = 0; j < 4; ++j) { const int k0 = 8 * (lane + 64 * j); const f32x4 g0 = *(const f32x4*)(gfin + k0), g1 = *(const f32x4*)(gfin + k0 + 4);
                *(GAS f32x4*)(orow + k0) = (f32x4){v[j][0], v[j][1], v[j][2], v[j][3]} * rstd * g0; *(GAS f32x4*)(orow + k0 + 4) = (f32x4){v[j][4], v[j][5], v[j][6], v[j][7]} * rstd * g1; }
        }
    }
    if (TIME_PHASE == PH_FNORM) { VM_WAIT(); tp_b = __builtin_amdgcn_s_memrealtime(); }
    if (TIME_PHASE >= 0 && bx == 0 && tid == 0) { const unsigned long long t0 = __builtin_amdgcn_s_memrealtime(), span = (TIME_PHASE >= 120 ? tp_b : (tp_b - tp_a)) * 8ull; while (__builtin_amdgcn_s_memrealtime() - t0 < span) __builtin_amdgcn_s_sleep(8); }
#undef IN
#undef BOTH
}

extern "C" void kernel_launch(void* const* d_in, const int* in_sizes, int n_in, void* d_out, int out_size, void* d_ws, size_t ws_size, hipStream_t stream) {
    static int grid = 0;
    if (grid == 0) {
        if (n_in != 18 || in_sizes[0] != M * D || out_size != M * D || ws_size < WS_END) { fprintf(stderr, "kernel_launch: unexpected shapes/workspace (n_in %d, in0 %d, out %d, ws %zu, need %zu); nothing launched\n", n_in, n_in > 0 ? in_sizes[0] : -1, out_size, ws_size, (size_t)WS_END); grid = -1; return; }
        int dev = 0, cus = 0, per_cu = 0;
        if (hipGetDevice(&dev) != hipSuccess || hipDeviceGetAttribute(&cus, hipDeviceAttributeMultiprocessorCount, dev) != hipSuccess) { grid = -1; return; }
        if (hipFuncSetAttribute((const void*)fwd_kernel, hipFuncAttributeMaxDynamicSharedMemorySize, LDS_BYTES) != hipSuccess) { fprintf(stderr, "kernel_launch: hipFuncSetAttribute failed\n"); grid = -1; return; }
        if (hipOccupancyMaxActiveBlocksPerMultiprocessor(&per_cu, (const void*)fwd_kernel, NTHR, LDS_BYTES) != hipSuccess || per_cu < 1) { fprintf(stderr, "kernel_launch: occupancy query says %d\n", per_cu); per_cu = 1; }
        (void)hipGetLastError();
        grid = cus * (per_cu < 1 ? 1 : 1);
    }
    if (grid < 0) return;
    (void)hipMemsetAsync((char*)d_ws + WS_CTL + (size_t)CW_BAR * 4, 0, 16384, stream);
    Args a{};
    for (int i = 0; i < 18; ++i) a.in[i] = (const float*)d_in[i];
    a.out = (float*)d_out; a.ws = (unsigned char*)d_ws;
#if ONE_LAUNCH
    a.ph_lo = 0; a.ph_hi = NPH;
    void* kargs[] = {&a};
    hipError_t e = hipLaunchCooperativeKernel((const void*)fwd_kernel, dim3(grid), dim3(NTHR), kargs, LDS_BYTES, stream);
    if (e != hipSuccess) fprintf(stderr, "kernel_launch: cooperative launch failed: %s (grid %d)\n", hipGetErrorString(e), grid);
#else
    for (int p = 0; p < NPH; ++p) { a.ph_lo = p; a.ph_hi = p + 1; hipLaunchKernelGGL(fwd_kernel, dim3(grid), dim3(NTHR), LDS_BYTES, stream, a); }
#endif
}
```

```cpp
#include <hip/hip_runtime.h>
#include <cstdio>
#include <cstdint>

#ifndef GP_ALIGN
#define GP_ALIGN true
#endif
#ifndef GP_SP2
#define GP_SP2 true
#endif
#ifndef ONE_LAUNCH
#define ONE_LAUNCH 1
#endif

namespace pg8 {
#define PG8_LAS __attribute__((address_space(3)))
typedef unsigned short bf16_t;
typedef short bf16x8 __attribute__((ext_vector_type(8)));
typedef float f32x4 __attribute__((ext_vector_type(4)));
typedef unsigned u32x4 __attribute__((ext_vector_type(4)));
typedef int i32x4 __attribute__((ext_vector_type(4)));
typedef int i32x8 __attribute__((ext_vector_type(8)));
typedef unsigned u32x2 __attribute__((ext_vector_type(2)));
constexpr int BM = 256, BK = 64, HALF = 128, HTB = HALF * BK * 2, STAGE_BYTES = 8 * HTB, NXCD = 8, WGM = 8;

__host__ __device__ __forceinline__ int lds_byte(int r, int c) { const int st = (r >> 4) * 2 + (c >> 5), rr = r & 15, cc = c & 31, ob = rr * 64 + cc * 2; return st * 1024 + (ob ^ (((ob >> 9) & 1) << 5)); }
__host__ __device__ __forceinline__ void stage_rc(int b, int& R, int& C) { const int st = b / 1024, sb = b % 1024, swz = sb ^ (((sb >> 9) & 1) << 5); R = (st >> 1) * 16 + swz / 64; C = (st & 1) * 32 + (swz % 64) / 2; }
__host__ __device__ __forceinline__ int perm32(int rho) { const int n = rho >> 4, i = rho & 15; return 8 * (i >> 2) + 4 * n + (i & 3); }

struct Unit { int pm, pn; };
struct Gemm { const bf16_t* A; const bf16_t* Bt; int M, N, K; };

struct StaticOrder {
    int nM, nN, nwg, G, c;
    __host__ __device__ void init(int M, int N, int G_, int c_) { nM = M / BM; nN = N / BM; nwg = nM * nN; G = G_; c = c_; }
    __host__ __device__ bool next(int i, Unit& u) const {
        const long L = (long)i * G + c; if (L >= nwg) return false;
        int wgid = (int)L; { const int q = nwg / NXCD, r = nwg % NXCD, xcd = wgid % NXCD, off = wgid / NXCD; wgid = (xcd < r ? xcd * (q + 1) : r * (q + 1) + (xcd - r) * q) + off; }
        const int nig = WGM * nN, gid = wgid / nig, fm = gid * WGM, gsz = (nM - fm) < WGM ? (nM - fm) : WGM;
        u.pm = fm + ((wgid % nig) % gsz); u.pn = (wgid % nig) / gsz; return true;
    }
    __device__ __forceinline__ void a_ready(const Unit&) const {}
    __device__ __forceinline__ void done(const Unit&) const {}
};

__device__ __forceinline__ unsigned cvt_pk4_fp8(float a, float b, float c, float d) {
    a = __builtin_amdgcn_fmed3f(a, -448.f, 448.f); b = __builtin_amdgcn_fmed3f(b, -448.f, 448.f); c = __builtin_amdgcn_fmed3f(c, -448.f, 448.f); d = __builtin_amdgcn_fmed3f(d, -448.f, 448.f);
    int w = __builtin_amdgcn_cvt_pk_fp8_f32(a, b, 0, false); w = __builtin_amdgcn_cvt_pk_fp8_f32(c, d, w, true); return (unsigned)w; }
__device__ __forceinline__ unsigned cvt_pk_bf16(float lo, float hi) { unsigned r; asm volatile("v_cvt_pk_bf16_f32 %0, %1, %2" : "=v"(r) : "v"(lo), "v"(hi)); return r; }


struct EpiBf16R {
    static constexpr bool PERM = true, AFTER_DRAIN = false, GRIDMAP = false;
    bf16_t* O; int ldc; int split_cols; size_t split_stride;
    const float* cosT; const float* sinT; int rope_hi; int sc_lo, sc_hi; float sc; float sc_all;
    __device__ __forceinline__ void operator()(const f32x4 (&acc)[2][2][4][2], const Unit& u, int wr, int wc, int fr, int fq) const {
        const int row0 = u.pm * BM + wr * 64 + fr; int colt = u.pn * BM; bf16_t* base = O;
        if (split_cols) { const int t = colt / split_cols; base += (size_t)t * split_stride; colt -= t * split_cols; }
        const int col0 = colt + wc * 32 + 8 * fq;
        const bool rope = u.pn < rope_hi; const float s = ((u.pn >= sc_lo && u.pn < sc_hi) ? sc : 1.f) * sc_all;
        const int ti = 16 * (wc & 1) + 4 * fq;
#pragma unroll
        for (int ai = 0; ai < 2; ++ai)
#pragma unroll
            for (int m = 0; m < 4; ++m) {
                const int r = row0 + ai * HALF + m * 16;
                f32x4 cs = (f32x4){1.f, 1.f, 1.f, 1.f}, sn = (f32x4){0.f, 0.f, 0.f, 0.f};
                if (rope) { const int ntok = r & 8191; const int pos = (wc >> 1) ? (ntok & 63) : (ntok >> 6); cs = *(const f32x4*)(cosT + pos * 32 + ti); sn = *(const f32x4*)(sinT + pos * 32 + ti); }
                bf16_t* rowp = base + (size_t)r * ldc + col0;
#pragma unroll
                for (int bj = 0; bj < 2; ++bj) {
                    const f32x4 v0 = acc[ai][bj][m][0], v1 = acc[ai][bj][m][1]; f32x4 o0, o1;
                    o0[0] = v0[0] * cs[0] - v0[1] * sn[0]; o0[1] = v0[0] * sn[0] + v0[1] * cs[0];
                    o0[2] = v0[2] * cs[1] - v0[3] * sn[1]; o0[3] = v0[2] * sn[1] + v0[3] * cs[1];
                    o1[0] = v1[0] * cs[2] - v1[1] * sn[2]; o1[1] = v1[0] * sn[2] + v1[1] * cs[2];
                    o1[2] = v1[2] * cs[3] - v1[3] * sn[3]; o1[3] = v1[2] * sn[3] + v1[3] * cs[3];
                    o0 = o0 * s; o1 = o1 * s;
                    u32x4 w; w.x = cvt_pk_bf16(o0[0], o0[1]); w.y = cvt_pk_bf16(o0[2], o0[3]); w.z = cvt_pk_bf16(o1[0], o1[1]); w.w = cvt_pk_bf16(o1[2], o1[3]);
                    *(u32x4*)(rowp + bj * HALF) = w; }
            }
    }
};
__device__ __forceinline__ float dpp_ror1(float x)  { return __builtin_bit_cast(float, __builtin_amdgcn_update_dpp(0, __builtin_bit_cast(int, x), 0x121, 0xF, 0xF, false)); }
__device__ __forceinline__ float dpp_shr1z(float x) { return __builtin_bit_cast(float, __builtin_amdgcn_update_dpp(0, __builtin_bit_cast(int, x), 0x111, 0xF, 0xF, true)); }
__device__ __forceinline__ float dpp_shl1z(float x) { return __builtin_bit_cast(float, __builtin_amdgcn_update_dpp(0, __builtin_bit_cast(int, x), 0x101, 0xF, 0xF, true)); }
__device__ __forceinline__ float dpp_ror15(float x) { return __builtin_bit_cast(float, __builtin_amdgcn_update_dpp(0, __builtin_bit_cast(int, x), 0x12F, 0xF, 0xF, false)); }
struct EpiIn {
    static constexpr bool PERM = true, AFTER_DRAIN = false, GRIDMAP = false;
    bf16_t* P; int ldp; bf16_t* CATc; int ldcat; bf16_t* GS; int ldg; const float* cosT; const float* sinT; const float* convw; int nconv; float ksc;
    __device__ __forceinline__ void operator()(const f32x4 (&acc)[2][2][4][2], const Unit& u, int wr, int wc, int fr, int fq) const {
        const int row0 = u.pm * BM + wr * 64 + fr;
        if (u.pn < 12) {
            const int col0 = u.pn * BM + wc * 32 + 8 * fq;
            const bool rope = u.pn < 8; const float s = (u.pn >= 4 && u.pn < 8) ? ksc : 1.f;
            const int ti = 16 * (wc & 1) + 4 * fq;
            const bool colh = (wc >> 1) != 0;
            f32x4 csA[4], snA[4];
#pragma unroll
            for (int j = 0; j < 4; ++j) { csA[j] = (f32x4){1.f, 1.f, 1.f, 1.f}; snA[j] = (f32x4){0.f, 0.f, 0.f, 0.f}; }
            if (rope) {
#pragma unroll
                for (int j = 0; j < 4; ++j) if (colh || j < 2) { const int ntok = (row0 + (colh ? j * 16 : j * HALF)) & 8191; const int pos = colh ? (ntok & 63) : (ntok >> 6);
                    csA[j] = *(const f32x4*)(cosT + pos * 32 + ti); snA[j] = *(const f32x4*)(sinT + pos * 32 + ti); }
            }
            asm volatile("" ::: "memory");
#pragma unroll
            for (int ai = 0; ai < 2; ++ai)
#pragma unroll
                for (int m = 0; m < 4; ++m) {
                    const int r = row0 + ai * HALF + m * 16;
                    const f32x4 cs = colh ? csA[m] : csA[ai], sn = colh ? snA[m] : snA[ai];
                    bf16_t* rowp = P + (size_t)r * ldp + col0;
#pragma unroll
                    for (int bj = 0; bj < 2; ++bj) {
                        const f32x4 v0 = acc[ai][bj][m][0], v1 = acc[ai][bj][m][1]; f32x4 o0, o1;
                        o0[0] = v0[0] * cs[0] - v0[1] * sn[0]; o0[1] = v0[0] * sn[0] + v0[1] * cs[0];
                        o0[2] = v0[2] * cs[1] - v0[3] * sn[1]; o0[3] = v0[2] * sn[1] + v0[3] * cs[1];
                        o1[0] = v1[0] * cs[2] - v1[1] * sn[2]; o1[1] = v1[0] * sn[2] + v1[1] * cs[2];
                        o1[2] = v1[2] * cs[3] - v1[3] * sn[3]; o1[3] = v1[2] * sn[3] + v1[3] * cs[3];
                        o0 = o0 * s; o1 = o1 * s;
                        u32x4 w; w.x = cvt_pk_bf16(o0[0], o0[1]); w.y = cvt_pk_bf16(o0[2], o0[3]); w.z = cvt_pk_bf16(o1[0], o1[1]); w.w = cvt_pk_bf16(o1[2], o1[3]);
                        *(u32x4*)(rowp + bj * HALF) = w; }
                }
        } else {
            typedef unsigned u32x2 __attribute__((ext_vector_type(2)));
            const int ch0 = 64 * (u.pn - 12) + 16 * wc + 4 * fq;
            const f32x4 w0 = *(const f32x4*)(convw + ch0), w1 = *(const f32x4*)(convw + nconv + ch0), w2 = *(const f32x4*)(convw + 2 * nconv + ch0);
#pragma unroll
            for (int ai = 0; ai < 2; ++ai) {
                f32x4 cv[4], rr[4], ll[4];
#pragma unroll
                for (int m = 0; m < 4; ++m) { cv[m] = acc[ai][0][m][0] * acc[ai][0][m][1];
#pragma unroll
                    for (int e = 0; e < 4; ++e) { rr[m][e] = dpp_ror1(cv[m][e]); ll[m][e] = dpp_ror15(cv[m][e]); } }
#pragma unroll
                for (int m = 0; m < 4; ++m) {
                    const f32x4 z = (f32x4){0.f, 0.f, 0.f, 0.f};
                    const f32x4 prev = fr > 0 ? rr[m] : (m > 0 ? rr[m > 0 ? m - 1 : 0] : z), next = fr < 15 ? ll[m] : (m < 3 ? ll[m < 3 ? m + 1 : 3] : z);
                    const f32x4 o = acc[ai][1][m][0] * (w0 * prev + w1 * cv[m] + w2 * next);
                    const f32x4 gq = acc[ai][1][m][1]; f32x4 gs;
#pragma unroll
                    for (int e = 0; e < 4; ++e) gs[e] = gq[e] * __builtin_amdgcn_rcpf(1.f + __expf(-gq[e]));
                    const size_t r = (size_t)(row0 + ai * HALF + m * 16);
                    *(u32x2*)(CATc + r * ldcat + ch0) = (u32x2){cvt_pk_bf16(o[0], o[1]), cvt_pk_bf16(o[2], o[3])};
                    *(u32x2*)(GS + r * ldg + ch0) = (u32x2){cvt_pk_bf16(gs[0], gs[1]), cvt_pk_bf16(gs[2], gs[3])};
                }
            }
        }
    }
};
struct EpiRes {
    static constexpr bool PERM = true, AFTER_DRAIN = false, GRIDMAP = false;
    const bf16_t* base; bf16_t* out; int ldc; const float* gate; int gate_bstride; float ascale; const float* mul;
    __device__ __forceinline__ void operator()(const f32x4 (&acc)[2][2][4][2], const Unit& u, int wr, int wc, int fr, int fq) const {
        const int row0 = u.pm * BM + wr * 64 + fr, col0 = u.pn * BM + wc * 32 + 8 * fq;
        const float* gp = gate + (size_t)((u.pm * BM) >> 13) * gate_bstride + col0;
        const float* mp = mul + (size_t)((u.pm * BM) >> 13) * ldc + col0;
        f32x4 gv[2][2], iv[2][2];
#pragma unroll
        for (int bj = 0; bj < 2; ++bj)
#pragma unroll
            for (int n = 0; n < 2; ++n) { gv[bj][n] = *(const f32x4*)(gp + bj * HALF + 4 * n) * ascale; const f32x4 mq = *(const f32x4*)(mp + bj * HALF + 4 * n);
                iv[bj][n] = (f32x4){__builtin_amdgcn_rcpf(mq[0]), __builtin_amdgcn_rcpf(mq[1]), __builtin_amdgcn_rcpf(mq[2]), __builtin_amdgcn_rcpf(mq[3])}; }
#pragma unroll
        for (int ai = 0; ai < 2; ++ai) {
            u32x4 bq[4][2];
#pragma unroll
            for (int m = 0; m < 4; ++m)
#pragma unroll
                for (int bj = 0; bj < 2; ++bj) bq[m][bj] = *(const u32x4*)(base + (size_t)(row0 + ai * HALF + m * 16) * ldc + col0 + bj * HALF);
            asm volatile("" ::: "memory");
#pragma unroll
            for (int m = 0; m < 4; ++m) { const size_t off = (size_t)(row0 + ai * HALF + m * 16) * ldc + col0;
#pragma unroll
                for (int bj = 0; bj < 2; ++bj) { const u32x4 q = bq[m][bj];
                    const f32x4 b0 = (f32x4){__builtin_bit_cast(float, q.x << 16), __builtin_bit_cast(float, q.x & 0xffff0000u), __builtin_bit_cast(float, q.y << 16), __builtin_bit_cast(float, q.y & 0xffff0000u)};
                    const f32x4 b1 = (f32x4){__builtin_bit_cast(float, q.z << 16), __builtin_bit_cast(float, q.z & 0xffff0000u), __builtin_bit_cast(float, q.w << 16), __builtin_bit_cast(float, q.w & 0xffff0000u)};
                    const f32x4 o0 = b0 * iv[bj][0] + gv[bj][0] * acc[ai][bj][m][0], o1 = b1 * iv[bj][1] + gv[bj][1] * acc[ai][bj][m][1];
                    u32x4 w; w.x = cvt_pk_bf16(o0[0], o0[1]); w.y = cvt_pk_bf16(o0[2], o0[3]); w.z = cvt_pk_bf16(o1[0], o1[1]); w.w = cvt_pk_bf16(o1[2], o1[3]);
                    *(u32x4*)(out + off + bj * HALF) = w; } }
            asm volatile("" ::: "memory");
        }
    }
};
struct EpiResNorm {
    static constexpr bool PERM = true, AFTER_DRAIN = false, GRIDMAP = false;
    const float* base; int ldc; const float* gate; int gate_bstride; const float* mul; bf16_t* xn; float* rowss;
    __device__ __forceinline__ void operator()(const f32x4 (&acc)[2][2][4][2], const Unit& u, int wr, int wc, int fr, int fq) const {
        const int row0 = u.pm * BM + wr * 64 + fr, col0 = u.pn * BM + wc * 32 + 8 * fq, b = (u.pm * BM) >> 13;
        const float* gp = gate + (size_t)b * gate_bstride + col0; const float* mp = mul + (size_t)b * ldc + col0;
        f32x4 gv[2][2], mvv[2][2];
#pragma unroll
        for (int bj = 0; bj < 2; ++bj)
#pragma unroll
            for (int n = 0; n < 2; ++n) { gv[bj][n] = *(const f32x4*)(gp + bj * HALF + 4 * n); mvv[bj][n] = *(const f32x4*)(mp + bj * HALF + 4 * n); }
#pragma unroll
        for (int hq = 0; hq < 4; ++hq) { const int ai = hq >> 1, m0 = 2 * (hq & 1);
            f32x4 bsv[2][2][2];
#pragma unroll
            for (int mm = 0; mm < 2; ++mm)
#pragma unroll
                for (int bj = 0; bj < 2; ++bj)
#pragma unroll
                    for (int n = 0; n < 2; ++n) bsv[mm][bj][n] = __builtin_nontemporal_load((const f32x4*)(base + (size_t)(row0 + ai * HALF + (m0 + mm) * 16) * ldc + col0 + bj * HALF + 4 * n));
            asm volatile("" ::: "memory");
#pragma unroll
            for (int mm = 0; mm < 2; ++mm) { const int m = m0 + mm; const int r = row0 + ai * HALF + m * 16; const size_t off = (size_t)r * ldc + col0; float ss = 0.f;
#pragma unroll
                for (int bj = 0; bj < 2; ++bj) {
                    const f32x4 v0 = bsv[mm][bj][0] + gv[bj][0] * acc[ai][bj][m][0], v1 = bsv[mm][bj][1] + gv[bj][1] * acc[ai][bj][m][1];
                    ss += ((v0[0] * v0[0] + v0[1] * v0[1]) + (v0[2] * v0[2] + v0[3] * v0[3])) + ((v1[0] * v1[0] + v1[1] * v1[1]) + (v1[2] * v1[2] + v1[3] * v1[3]));
                    const f32x4 y0 = v0 * mvv[bj][0], y1 = v1 * mvv[bj][1];
                    u32x4 wn; wn.x = cvt_pk_bf16(y0[0], y0[1]); wn.y = cvt_pk_bf16(y0[2], y0[3]); wn.z = cvt_pk_bf16(y1[0], y1[1]); wn.w = cvt_pk_bf16(y1[2], y1[3]);
                    *(u32x4*)(xn + off + bj * HALF) = wn; }
                ss += __shfl_xor(ss, 16); ss += __shfl_xor(ss, 32);
                if (fq == 0) rowss[(size_t)r * 32 + 4 * u.pn + wc] = ss; }
            asm volatile("" ::: "memory");
        }
    }
};
struct EpiUp {
    static constexpr bool PERM = true, AFTER_DRAIN = false, GRIDMAP = false;
    bf16_t* O; int ldc; int split_cols; size_t split_stride; const float* bias; int bias_bstride; const PG8_LAS float* rs; int pm_cached; const float* rowss; float inv_d, eps;
    __device__ __forceinline__ void operator()(const f32x4 (&acc)[2][2][4][2], const Unit& u, int wr, int wc, int fr, int fq) const {
        const int row0 = u.pm * BM + wr * 64 + fr; int colt = u.pn * BM; bf16_t* base = O;
        { const int t = colt / split_cols; base += (size_t)t * split_stride; colt -= t * split_cols; }
        const int col0 = colt + wc * 32 + 8 * fq; const float* bp = bias + (size_t)((u.pm * BM) >> 13) * bias_bstride + u.pn * BM + wc * 32 + 8 * fq;
        f32x4 bv[2][2];
#pragma unroll
        for (int bj = 0; bj < 2; ++bj)
#pragma unroll
            for (int n = 0; n < 2; ++n) bv[bj][n] = *(const f32x4*)(bp + bj * HALF + 4 * n);
#pragma unroll
        for (int ai = 0; ai < 2; ++ai)
#pragma unroll
            for (int m = 0; m < 4; ++m) { const int rl = ai * HALF + wr * 64 + m * 16 + fr; const int r = u.pm * BM + rl; float rsv;
                if (u.pm == pm_cached) rsv = rs[rl];
                else { float t = 0.f; for (int i = 0; i < 32; ++i) t += rowss[(size_t)r * 32 + i]; rsv = rsqrtf(t * inv_d + eps); }
                bf16_t* rowp = base + (size_t)r * ldc + col0;
#pragma unroll
                for (int bj = 0; bj < 2; ++bj) { const f32x4 v0 = acc[ai][bj][m][0] * rsv + bv[bj][0], v1 = acc[ai][bj][m][1] * rsv + bv[bj][1];
                    u32x4 w; w.x = cvt_pk_bf16(v0[0], v0[1]); w.y = cvt_pk_bf16(v0[2], v0[3]); w.z = cvt_pk_bf16(v1[0], v1[1]); w.w = cvt_pk_bf16(v1[2], v1[3]);
                    *(u32x4*)(rowp + bj * HALF) = w; } }
    }
};
struct EpiGate {
    static constexpr bool PERM = true, AFTER_DRAIN = false, GRIDMAP = true;
    bf16_t* ACT; int lda; const float* bias; int bias_bstride; const float* fcw; const float* fcb; int nch; const PG8_LAS float* rs; const PG8_LAS int* pml;
    __device__ __forceinline__ void operator()(f32x4 (&acc)[2][2][4][2], const Unit& u, int wr, int wc, int fr, int fq) const {
        asm volatile("" : "+v"(fr), "+v"(fq));
        const int b = u.pm >> 5, cp = u.pm & 31;
        const int chl = 32 * wc + 8 * fq, ch = 128 * u.pn + chl;
        const size_t tok00 = (size_t)b * 8192 + 2 * cp + wr;
        {
            const float* bp = bias + (size_t)b * bias_bstride + 256 * u.pn + chl;
            int slot = 0;
#pragma unroll
            for (int j = 1; j < 8; ++j) if (pml[j] == u.pm) slot = j;
            const f32x4 ba0 = *(const f32x4*)(bp), ba1 = *(const f32x4*)(bp + 4), bb0 = *(const f32x4*)(bp + 128), bb1 = *(const f32x4*)(bp + 132);
#pragma unroll
            for (int ai = 0; ai < 2; ++ai)
#pragma unroll
                for (int m = 0; m < 4; ++m) { const int rl = ai * HALF + wr * 64 + m * 16 + fr; const float rsv = rs[slot * 256 + rl];
                    acc[ai][0][m][0] = acc[ai][0][m][0] * rsv + ba0; acc[ai][0][m][1] = acc[ai][0][m][1] * rsv + ba1; acc[ai][1][m][0] = acc[ai][1][m][0] * rsv + bb0; acc[ai][1][m][1] = acc[ai][1][m][1] * rsv + bb1; }
        }
        __builtin_amdgcn_sched_barrier(0);
#pragma unroll
        for (int n = 0; n < 2; ++n) {
            constexpr float NL2E = -1.4426950408889634f;
            const f32x4 w0 = *(const f32x4*)(fcw + ch + 4 * n) * NL2E, w1 = *(const f32x4*)(fcw + nch + ch + 4 * n) * NL2E, w2 = *(const f32x4*)(fcw + 2 * nch + ch + 4 * n) * NL2E, cb = *(const f32x4*)(fcb + ch + 4 * n) * NL2E;
#pragma unroll
            for (int e = 0; e < 4; ++e) {
                const float w0e = fr == 0 ? w0[e] : 0.f, w2e = fr == 15 ? w2[e] : 0.f;
                float tt[2][4];
#pragma unroll
                for (int ai = 0; ai < 2; ++ai)
#pragma unroll
                    for (int m = 0; m < 4; ++m) { const float x = acc[ai][0][m][n][e];
                        float t = __builtin_fmaf(w1[e], x, cb[e]); const float w0s = w0[e], w2s = w2[e];
                        asm volatile("v_fmac_f32_dpp %0, %1, %2 row_shr:1 row_mask:0xf bank_mask:0xf bound_ctrl:1" : "+v"(t) : "v"(x), "v"(w0s));
                        asm volatile("v_fmac_f32_dpp %0, %1, %2 row_shl:1 row_mask:0xf bank_mask:0xf bound_ctrl:1" : "+v"(t) : "v"(x), "v"(w2s));
                        if (ai > 0 || m > 0) { const float xp = m > 0 ? acc[ai][0][m > 0 ? m - 1 : 0][n][e] : acc[0][0][3][n][e]; asm volatile("v_fmac_f32_dpp %0, %1, %2 row_ror:1 row_mask:0xf bank_mask:0xf" : "+v"(t) : "v"(xp), "v"(w0e)); }
                        if (ai < 1 || m < 3) { const float xn = m < 3 ? acc[ai][0][m < 3 ? m + 1 : 3][n][e] : acc[1][0][0][n][e]; asm volatile("v_fmac_f32_dpp %0, %1, %2 row_ror:15 row_mask:0xf bank_mask:0xf" : "+v"(t) : "v"(xn), "v"(w2e)); }
                        tt[ai][m] = t; }
#pragma unroll
                for (int ai = 0; ai < 2; ++ai)
#pragma unroll
                    for (int m = 0; m < 4; ++m) { const float t = tt[ai][m];
                        float res = (t * -0.6931471805599453f) * __builtin_amdgcn_rcpf(1.f + __builtin_amdgcn_exp2f(t)) * acc[ai][1][m][n][e];
                        asm volatile("" : "+v"(res));
                        acc[ai][0][m][n][e] = res;
                    }
                __builtin_amdgcn_sched_barrier(0);
            }
        }
#pragma unroll
        for (int ai = 0; ai < 2; ++ai)
#pragma unroll
            for (int mp = 0; mp < 2; ++mp) {
                const f32x4 a0 = acc[ai][0][2 * mp][0], a1 = acc[ai][0][2 * mp][1], c0 = acc[ai][0][2 * mp + 1][0], c1 = acc[ai][0][2 * mp + 1][1];
                unsigned ax = cvt_pk4_fp8(a0[0], a0[1], a0[2], a0[3]), ay = cvt_pk4_fp8(a1[0], a1[1], a1[2], a1[3]), cx = cvt_pk4_fp8(c0[0], c0[1], c0[2], c0[3]), cy = cvt_pk4_fp8(c1[0], c1[1], c1[2], c1[3]);
                asm volatile("s_nop 1\n\tv_permlane16_swap_b32 %0, %1" : "+v"(ax), "+v"(cx)); asm volatile("s_nop 1\n\tv_permlane16_swap_b32 %0, %1" : "+v"(ay), "+v"(cy));
                const int od = fq & 1, lr = 64 * ai + 16 * (2 * mp + od) + fr;
                u32x4 w; w.x = ax; w.y = ay; w.z = cx; w.w = cy;
                *(u32x4*)((unsigned char*)ACT + (tok00 + (size_t)lr * 64) * lda + ch - 8 * od) = w; }
    }
};
struct EpiNull {
    static constexpr bool PERM = true, AFTER_DRAIN = false, GRIDMAP = false;
    __device__ __forceinline__ void operator()(const f32x4 (&acc)[2][2][4][2], const Unit&, int, int, int, int) const {
#pragma unroll
        for (int ai = 0; ai < 2; ++ai)
#pragma unroll
            for (int bj = 0; bj < 2; ++bj)
#pragma unroll
                for (int m = 0; m < 4; ++m)
#pragma unroll
                    for (int n = 0; n < 2; ++n) asm volatile("" :: "v"(acc[ai][bj][m][n]));
    }
};
struct SameTileOrder : StaticOrder {
    __host__ __device__ bool next(int i, Unit& u) const { const long L = (long)i * G + c; if (L >= nwg) return false; u.pm = 0; u.pn = c % nN; return true; }
};
template <class Epi, class Sched, bool ALIGN_EPI = false, bool SP2 = false, bool F8 = false>
__device__ __forceinline__ void gemm_phase(PG8_LAS unsigned char* lds, const Gemm g, const Sched& S, const Epi& E) {
    const int tid = threadIdx.x, wid = __builtin_amdgcn_readfirstlane(tid >> 6), lane = tid & 63, wr = wid >> 2, wc = wid & 3, fr = lane & 15, fq = lane >> 4;
    const int K = g.K, nt = K / BK;
    unsigned voffA[2], voffB[2];
#pragma unroll
    for (int i = 0; i < 2; ++i) { int R, C; stage_rc(tid * 16 + i * 8192, R, C); const int Rb = Epi::PERM ? ((R & ~31) + perm32(R & 31)) : R;
        const int Ra = Epi::GRIDMAP ? ((R & 63) * 64 + (R >> 6)) : R;
        voffA[i] = (unsigned)(Ra * K + C) * 2u; voffB[i] = (unsigned)(Rb * K + C) * 2u; }
    const size_t kstep = (size_t)(BK * 2);
    const size_t hstep = (size_t)HALF * K * 2;
    const size_t tstep = 2 * hstep;
    const size_t hstepA = Epi::GRIDMAP ? (size_t)4096 * K * 2 : hstep;
#define PG8_ABASE(pm_) ((const char*)g.A + (Epi::GRIDMAP ? (size_t)(((pm_) >> 5) * 8192 + ((pm_) & 31) * 2) * K * 2 : (size_t)(pm_) * tstep))
    const unsigned ldsw = (unsigned)wid * 1024u;
    const int aoff = lds_byte(wr * 64 + fr, fq * 8), boff = lds_byte(wc * 32 + fr, fq * 8);
#define PG8_SA(b, h) (((b) * 2 + (h)) * HTB)
#define PG8_SB(b, h) ((4 + (b) * 2 + (h)) * HTB)
#define PG8_STAGE(bufoff, gbase, voff) do { _Pragma("unroll") for (int _i = 0; _i < 2; ++_i) \
        __builtin_amdgcn_global_load_lds((const unsigned*)((const char*)(gbase) + (voff)[_i]), (PG8_LAS unsigned*)(lds + (bufoff) + ldsw + _i * 8192), 16, 0, 0); } while (0)
#define PG8_LDA(dst, b, h) do { _Pragma("unroll") for (int m = 0; m < 4; ++m) _Pragma("unroll") for (int k = 0; k < 2; ++k) dst[m][k] = *(const PG8_LAS bf16x8*)(lds + PG8_SA(b, h) + aoff + m * 2048 + k * 1024); } while (0)
#define PG8_LDB(dst, b, h) do { _Pragma("unroll") for (int n = 0; n < 2; ++n) _Pragma("unroll") for (int k = 0; k < 2; ++k) dst[n][k] = *(const PG8_LAS bf16x8*)(lds + PG8_SB(b, h) + boff + n * 2048 + k * 1024); } while (0)
#define PG8_CAT8(x) __builtin_shufflevector(__builtin_bit_cast(i32x4, x[0]), __builtin_bit_cast(i32x4, x[1]), 0, 1, 2, 3, 4, 5, 6, 7)
#define PG8_MMA(ai, bj, At, Bt) do { __builtin_amdgcn_s_setprio(1); _Pragma("unroll") for (int m = 0; m < 4; ++m) _Pragma("unroll") for (int n = 0; n < 2; ++n) { \
        if constexpr (F8) { const i32x8 a8_ = PG8_CAT8(Bt[n]), b8_ = PG8_CAT8(At[m]); asm volatile("v_mfma_f32_16x16x128_f8f6f4 %0, %1, %2, %0" : "+v"(acc[ai][bj][m][n]) : "v"(a8_), "v"(b8_)); }   \
        else { _Pragma("unroll") for (int k = 0; k < 2; ++k) acc[ai][bj][m][n] = __builtin_amdgcn_mfma_f32_16x16x32_bf16(Bt[n][k], At[m][k], acc[ai][bj][m][n], 0, 0, 0); } } __builtin_amdgcn_s_setprio(0); } while (0)
#define PG8_WAIT_V(n) asm volatile("s_waitcnt vmcnt(" #n ")" ::: "memory")
#define PG8_WAIT_L(n) asm volatile("s_waitcnt lgkmcnt(" #n ")" ::: "memory")
#define PG8_BAR __builtin_amdgcn_s_barrier()
#define PG8_SCHED __builtin_amdgcn_sched_barrier(0)
    Unit cur, nxt; int ui = 0;
    if (!S.next(0, cur)) return;
    f32x4 acc[2][2][4][2];
#pragma unroll
    for (int a = 0; a < 2; ++a)
#pragma unroll
        for (int b = 0; b < 2; ++b)
#pragma unroll
            for (int m = 0; m < 4; ++m)
#pragma unroll
                for (int n = 0; n < 2; ++n) acc[a][b][m][n] = (f32x4){0.f, 0.f, 0.f, 0.f};
    bf16x8 At[4][2], B0[2][2], B1[2][2];
    const char* cA = PG8_ABASE(cur.pm); const char* cB = (const char*)g.Bt + (size_t)cur.pn * tstep;
    S.a_ready(cur);
    if constexpr (SP2) {
        PG8_STAGE(PG8_SB(0, 0), cB, voffB); PG8_STAGE(PG8_SB(0, 1), cB + hstep, voffB); PG8_STAGE(PG8_SA(0, 0), cA, voffA); PG8_STAGE(PG8_SA(0, 1), cA + hstepA, voffA);
        if (wr == 1) PG8_BAR;
        PG8_WAIT_V(2); PG8_BAR;
        PG8_STAGE(PG8_SB(1, 0), cB + kstep, voffB); PG8_STAGE(PG8_SA(1, 0), cA + kstep, voffA); PG8_STAGE(PG8_SB(1, 1), cB + hstep + kstep, voffB);
        PG8_WAIT_V(6); PG8_BAR;
    } else {
        PG8_STAGE(PG8_SB(0, 0), cB, voffB); PG8_STAGE(PG8_SA(0, 0), cA, voffA); PG8_STAGE(PG8_SB(0, 1), cB + hstep, voffB); PG8_STAGE(PG8_SA(0, 1), cA + hstepA, voffA);
        if (wr == 1) PG8_BAR;
        PG8_WAIT_V(4); PG8_BAR;
        PG8_STAGE(PG8_SB(1, 0), cB + kstep, voffB); PG8_STAGE(PG8_SA(1, 0), cA + kstep, voffA); PG8_STAGE(PG8_SB(1, 1), cB + hstep + kstep, voffB);
        PG8_WAIT_V(6); PG8_BAR;
    }
    for (;;) {
        const bool has_next = S.next(ui + 1, nxt);
        const char* nA = has_next ? PG8_ABASE(nxt.pm) : cA; const char* nB = has_next ? (const char*)g.Bt + (size_t)nxt.pn * tstep : cB;
        for (int t = 0; t < nt; t += 2) {
            const bool last = (t == nt - 2);
            const char* a1 = cA + (size_t)(t + 1) * kstep;
            const char* a2 = last ? nA : cA + (size_t)(t + 2) * kstep; const char* b2 = last ? nB : cB + (size_t)(t + 2) * kstep;
            const char* a3 = a2 + kstep; const char* b3 = b2 + kstep;
            if (last && has_next) S.a_ready(nxt);
            if constexpr (SP2) {
            PG8_LDB(B0, 0, 0); PG8_LDB(B1, 0, 1); PG8_SCHED; PG8_LDA(At, 0, 0); PG8_STAGE(PG8_SA(1, 1), a1 + hstepA, voffA);
            PG8_WAIT_V(8); PG8_WAIT_L(0); PG8_BAR; PG8_MMA(0, 0, At, B0); PG8_MMA(0, 1, At, B1); PG8_BAR; PG8_SCHED;
            PG8_LDA(At, 0, 1); PG8_STAGE(PG8_SB(0, 0), b2, voffB); PG8_STAGE(PG8_SB(0, 1), b2 + hstep, voffB); PG8_STAGE(PG8_SA(0, 0), a2, voffA);
            PG8_WAIT_V(8); PG8_WAIT_L(0); PG8_BAR; PG8_MMA(1, 0, At, B0); PG8_MMA(1, 1, At, B1); PG8_BAR; PG8_SCHED;
            PG8_LDB(B0, 1, 0); PG8_LDB(B1, 1, 1); PG8_SCHED; PG8_LDA(At, 1, 0); PG8_STAGE(PG8_SA(0, 1), a2 + hstepA, voffA);
            PG8_WAIT_V(8); PG8_WAIT_L(0); PG8_BAR; PG8_MMA(0, 0, At, B0); PG8_MMA(0, 1, At, B1); PG8_BAR; PG8_SCHED;
            PG8_LDA(At, 1, 1); PG8_STAGE(PG8_SB(1, 0), b3, voffB); PG8_STAGE(PG8_SB(1, 1), b3 + hstep, voffB); PG8_STAGE(PG8_SA(1, 0), a3, voffA);
            PG8_WAIT_V(8); PG8_WAIT_L(0); PG8_BAR; PG8_MMA(1, 0, At, B0); PG8_MMA(1, 1, At, B1); PG8_BAR; PG8_SCHED;
            } else {
            PG8_LDB(B0, 0, 0); PG8_SCHED; PG8_LDA(At, 0, 0); PG8_STAGE(PG8_SA(1, 1), a1 + hstepA, voffA);
            PG8_WAIT_L(8); PG8_BAR; PG8_WAIT_L(0); PG8_MMA(0, 0, At, B0); PG8_BAR; PG8_SCHED;
            PG8_LDB(B1, 0, 1); PG8_STAGE(PG8_SB(0, 0), b2, voffB);
            PG8_BAR; PG8_WAIT_L(0); PG8_MMA(0, 1, At, B1); PG8_BAR;
            PG8_LDA(At, 0, 1); PG8_STAGE(PG8_SA(0, 0), a2, voffA);
            PG8_BAR; PG8_WAIT_L(0); PG8_MMA(1, 0, At, B0); PG8_BAR; PG8_SCHED;
            PG8_STAGE(PG8_SB(0, 1), b2 + hstep, voffB);
            PG8_WAIT_V(6); PG8_BAR; PG8_MMA(1, 1, At, B1); PG8_BAR;
            PG8_LDB(B0, 1, 0); PG8_SCHED; PG8_LDA(At, 1, 0); PG8_STAGE(PG8_SA(0, 1), a2 + hstepA, voffA);
            PG8_WAIT_L(8); PG8_BAR; PG8_WAIT_L(0); PG8_MMA(0, 0, At, B0); PG8_BAR; PG8_SCHED;
            PG8_LDB(B1, 1, 1); PG8_STAGE(PG8_SB(1, 0), b3, voffB);
            PG8_BAR; PG8_WAIT_L(0); PG8_MMA(0, 1, At, B1); PG8_BAR;
            PG8_LDA(At, 1, 1); PG8_STAGE(PG8_SA(1, 0), a3, voffA);
            PG8_BAR; PG8_WAIT_L(0); PG8_MMA(1, 0, At, B0); PG8_BAR; PG8_SCHED;
            PG8_STAGE(PG8_SB(1, 1), b3 + hstep, voffB);
            PG8_WAIT_V(6); PG8_BAR; PG8_MMA(1, 1, At, B1); PG8_BAR;
            }
        }
        if constexpr (F8) {
            asm volatile("s_nop 7\n\ts_nop 7\n\ts_nop 7" : "+v"(acc[0][0][0][0]), "+v"(acc[0][0][0][1]), "+v"(acc[0][0][1][0]), "+v"(acc[0][0][1][1]), "+v"(acc[0][0][2][0]), "+v"(acc[0][0][2][1]), "+v"(acc[0][0][3][0]), "+v"(acc[0][0][3][1]) :: "memory");
            asm volatile("" : "+v"(acc[0][1][0][0]), "+v"(acc[0][1][0][1]), "+v"(acc[0][1][1][0]), "+v"(acc[0][1][1][1]), "+v"(acc[0][1][2][0]), "+v"(acc[0][1][2][1]), "+v"(acc[0][1][3][0]), "+v"(acc[0][1][3][1]));
            asm volatile("" : "+v"(acc[1][0][0][0]), "+v"(acc[1][0][0][1]), "+v"(acc[1][0][1][0]), "+v"(acc[1][0][1][1]), "+v"(acc[1][0][2][0]), "+v"(acc[1][0][2][1]), "+v"(acc[1][0][3][0]), "+v"(acc[1][0][3][1]));
            asm volatile("" : "+v"(acc[1][1][0][0]), "+v"(acc[1][1][0][1]), "+v"(acc[1][1][1][0]), "+v"(acc[1][1][1][1]), "+v"(acc[1][1][2][0]), "+v"(acc[1][1][2][1]), "+v"(acc[1][1][3][0]), "+v"(acc[1][1][3][1])); }
        if constexpr (ALIGN_EPI) { if (wr == 0) PG8_BAR; }
        if constexpr (!Epi::AFTER_DRAIN) { E(acc, cur, wr, wc, fr, fq); S.done(cur); }
        if (!has_next) break;
#pragma unroll
        for (int a = 0; a < 2; ++a)
#pragma unroll
            for (int b = 0; b < 2; ++b)
#pragma unroll
                for (int m = 0; m < 4; ++m)
#pragma unroll
                    for (int n = 0; n < 2; ++n) acc[a][b][m][n] = (f32x4){0.f, 0.f, 0.f, 0.f};
        cur = nxt; cA = nA; cB = nB; ++ui;
        if constexpr (ALIGN_EPI) { if (wr == 1) PG8_BAR; }
    }
    PG8_WAIT_V(0);
    if constexpr (!ALIGN_EPI) { if (wr == 0) PG8_BAR; }
    PG8_BAR;
#undef PG8_ABASE
#undef PG8_SA
#undef PG8_SB
#undef PG8_STAGE
#undef PG8_LDA
#undef PG8_LDB
#undef PG8_MMA
#undef PG8_CAT8
#undef PG8_WAIT_V
#undef PG8_WAIT_L
#undef PG8_BAR
#undef PG8_SCHED
}
}

constexpr int NWAVES = 8, NTHR = 512;
constexpr int BATCH = 2, SEQ = 8192, D = 2048, M = BATCH * SEQ, CTXL = 256, MC = BATCH * CTXL;
constexpr int RW = 1024, NH = 8, DH = 128, CCH = 1024, INW = 7168, DFF = 5632, NUP = 2 * DFF, NCHK = 64, CHK = 128;
constexpr int NMOD = 6 * D;
constexpr int PLD = 3 * RW;
constexpr float EPS = 1e-6f;
constexpr float KSCALE = 0.08838834764831845f;
constexpr int NSL = 8;

constexpr size_t MiB = 1u << 20;
constexpr size_t WS_CTL = 0, CTL_ZERO_BYTES = 1 * MiB;
constexpr size_t WS_COS = 1 * MiB, WS_SIN = WS_COS + 16384, WS_PW = WS_COS + 32768, WS_MODF = WS_COS + 65536, WS_MUL2 = WS_COS + 212992, WS_BIAS2 = WS_COS + 229376, WS_MODP = WS_COS + 524288;
constexpr int PWS = 260;
constexpr size_t WS_WOUT = 4 * MiB, WS_WUP = 12 * MiB, WS_WDN = 56 * MiB, WS_XN = 78 * MiB, WS_HC = 142 * MiB, WS_KVC = 144 * MiB, WS_BIG = 146 * MiB;
constexpr size_t WS_WKV8 = 68 * MiB  , WS_HC8 = 72 * MiB  ;
constexpr size_t WS_P = WS_BIG, WS_GS = WS_BIG + 96 * MiB  , WS_CAT = WS_BIG + 224 * MiB, WS_WIN = WS_BIG + 128 * MiB  , WS_UA = WS_BIG, WS_UB = WS_BIG + 176 * MiB;
constexpr size_t WS_SPV = WS_BIG + 288 * MiB;
constexpr size_t WS_CTXS = WS_BIG + 352 * MiB;
constexpr size_t WS_ROWSS = WS_CTXS + 4 * MiB;
constexpr size_t WS_END = WS_ROWSS + 2 * MiB;
static_assert(WS_MODP + (size_t)NSL * 3 * NMOD * 4 <= WS_WOUT && WS_BIAS2 + 2 * (size_t)NUP * 4 <= WS_MODP && WS_MUL2 + 2 * D * 4 <= WS_BIAS2 && WS_MODF + 3 * (size_t)NMOD * 4 <= WS_MUL2, "tables");
constexpr int CW_BAR = 4096;

constexpr int LDS_BYTES = 147456;
constexpr int MISC_OFF = LDS_BYTES - 256;

#define GAS __attribute__((address_space(1)))
#define LAS __attribute__((address_space(3)))
typedef unsigned short bf16;
typedef unsigned v4u __attribute__((ext_vector_type(4)));
typedef unsigned v2u __attribute__((ext_vector_type(2)));
typedef float f32x4 __attribute__((ext_vector_type(4)));
typedef GAS unsigned gu32;
#define LDS_WAIT() asm volatile("s_waitcnt lgkmcnt(0)" ::: "memory")
#define VM_WAIT() asm volatile("s_waitcnt vmcnt(0)" ::: "memory")
__device__ __forceinline__ unsigned f2bf(float f) { unsigned u = __builtin_bit_cast(unsigned, f); return (u + 0x7fffu + ((u >> 16) & 1u)) >> 16; }
__device__ __forceinline__ unsigned pk2(float lo, float hi) { return f2bf(lo) | (f2bf(hi) << 16); }
__device__ __forceinline__ float bflo(unsigned w) { return __builtin_bit_cast(float, w << 16); }
__device__ __forceinline__ float bfhi(unsigned w) { return __builtin_bit_cast(float, w & 0xffff0000u); }
__device__ __forceinline__ float bf1(bf16 h) { return __builtin_bit_cast(float, ((unsigned)h) << 16); }
__device__ __forceinline__ float silu_f(float x) { return x * __builtin_amdgcn_rcpf(1.f + __expf(-x)); }
__device__ __forceinline__ float wave_sum(float v) {
#pragma unroll
    for (int o = 1; o < 64; o <<= 1) v += __shfl_xor(v, o);
    return v;
}


typedef short s16x4 __attribute__((ext_vector_type(4)));
typedef short bf16x8 __attribute__((ext_vector_type(8)));
__device__ __forceinline__ unsigned off_b(unsigned row, unsigned ch) { return 256u * row + 16u * (ch ^ (((row & 3u) << 2) | ((row >> 2) & 3u))); }
__device__ __forceinline__ s16x4 tr_rd(LAS unsigned char* p) { return __builtin_bit_cast(s16x4, __builtin_amdgcn_ds_read_tr16_b64_v4i16((LAS s16x4*)p)); }
__device__ __forceinline__ bf16x8 tr_frag(LAS unsigned char* img, unsigned lane, unsigned Ra, unsigned Rb, unsigned c) {
    const unsigned q = (lane & 15u) >> 2, p = lane & 3u;
    const s16x4 lo = tr_rd(img + off_b(Ra + q, 2u * c + (p >> 1)) + 8u * (p & 1u));
    const s16x4 hi = tr_rd(img + off_b(Rb + q, 2u * c + (p >> 1)) + 8u * (p & 1u));
    return __builtin_shufflevector(lo, hi, 0, 1, 2, 3, 4, 5, 6, 7);
}
__device__ __forceinline__ bf16x8 row_frag(LAS unsigned char* img, unsigned lane, unsigned rb, unsigned s_) { return *(const LAS bf16x8*)(img + off_b(16u * rb + (lane & 15u), 4u * s_ + (lane >> 4))); }
__device__ __forceinline__ v4u scale_pk8(v4u q, float w) { v4u o; o.x = pk2(bflo(q.x) * w, bfhi(q.x) * w); o.y = pk2(bflo(q.y) * w, bfhi(q.y) * w); o.z = pk2(bflo(q.z) * w, bfhi(q.z) * w); o.w = pk2(bflo(q.w) * w, bfhi(q.w) * w); return o; }

#define XB_TMO      128
#define XB_XCNT(j)  (256  + 64 * (j))
#define XB_XSUB(j)  (1280 + 64 * (j))
#define XB_XGEN(j)  (2304 + 64 * (j))
#define XB_TOP      3328
#define XB_TOPGEN   3392
#define XCD_BAR_WORDS 3456
#define XB_SPIN_CAP (1u << 18)
__device__ __forceinline__ unsigned xb_ld(unsigned* p)              { return __hip_atomic_load(p, __ATOMIC_RELAXED, __HIP_MEMORY_SCOPE_AGENT); }
__device__ __forceinline__ unsigned xb_add(unsigned* p, unsigned v) { return __hip_atomic_fetch_add(p, v, __ATOMIC_RELAXED, __HIP_MEMORY_SCOPE_AGENT); }
__device__ __forceinline__ unsigned xb_xcc_id() { return (unsigned)__builtin_amdgcn_s_getreg((3 << 11) | 20) & 0xFu; }
#define XB_SPIN(cond, bar) do { unsigned _sp = 0; while (cond) { __builtin_amdgcn_s_sleep(1); \
    if ((++_sp & 255u) == 0u) { if (xb_ld(&(bar)[XB_TMO])) break; if (_sp > XB_SPIN_CAP) { atomicAdd(&(bar)[XB_TMO], 1u); break; } } } } while (0)
struct XcdBarrier { unsigned* bar; unsigned x; volatile LAS unsigned* st; };
__device__ __forceinline__ XcdBarrier xcd_barrier_post(unsigned* bar, volatile LAS unsigned* st) {
    XcdBarrier b; b.bar = bar; b.x = xb_xcc_id(); b.st = st;
    if (threadIdx.x == 0) (void)xb_add(&bar[XB_XCNT(b.x)], 1u);
    return b;
}
__device__ __forceinline__ void xcd_barrier_complete(unsigned* bar, unsigned x, unsigned& nloc, unsigned& nx) {
    const unsigned G = gridDim.x * gridDim.y * gridDim.z;
    unsigned sum, cnt, mine, sp = 0u;
    for (;;) {
        sum = 0u; cnt = 0u; mine = 0u;
#pragma unroll
        for (unsigned j = 0; j < 16; ++j) { const unsigned c = xb_ld(&bar[XB_XCNT(j)]); sum += c; cnt += (c > 0u) ? 1u : 0u; mine = (j == x) ? c : mine; }
        if (sum == G) break;
        __builtin_amdgcn_s_sleep(1);
        if ((++sp & 255u) == 0u) { if (xb_ld(&bar[XB_TMO])) break; if (sp > XB_SPIN_CAP) { atomicAdd(&bar[XB_TMO], 1u); break; } }
    }
    nloc = mine > 0u ? mine : 1u; nx = cnt > 0u ? cnt : 1u;
}
__device__ __forceinline__ void xcd_barrier(const XcdBarrier& b) {
    asm volatile("s_waitcnt vmcnt(0)" ::: "memory");
    __syncthreads();
    if (threadIdx.x == 0) {
        unsigned* bar = b.bar;
        __builtin_amdgcn_s_waitcnt(0);
        unsigned nloc = b.st[0], nx = b.st[1];
        if (nloc == 0u) { xcd_barrier_complete(bar, b.x, nloc, nx); b.st[0] = nloc; b.st[1] = nx; }
        const unsigned old = xb_add(&bar[XB_XSUB(b.x)], 1u);
        const unsigned gen = old / nloc;
        if (old + 1u == (gen + 1u) * nloc) {
            __builtin_amdgcn_fence(__ATOMIC_RELEASE, "agent");
            asm volatile("s_waitcnt vmcnt(0)" ::: "memory");
            const unsigned og = xb_add(&bar[XB_TOP], 1u);
            const unsigned tg = og / nx;
            if (og + 1u == (tg + 1u) * nx) xb_add(&bar[XB_TOPGEN], 1u);
            else XB_SPIN(xb_ld(&bar[XB_TOPGEN]) == tg, bar);
            __builtin_amdgcn_fence(__ATOMIC_ACQUIRE, "agent");
            xb_add(&bar[XB_XGEN(b.x)], 1u);
            asm volatile("s_waitcnt vmcnt(0)" ::: "memory");
        } else {
            XB_SPIN(xb_ld(&bar[XB_XGEN(b.x)]) == gen, bar);
            __builtin_amdgcn_fence(__ATOMIC_ACQUIRE, "agent");
            asm volatile("s_waitcnt vmcnt(0)" ::: "memory");
        }
    }
    __syncthreads();
}

struct Args { const float* in[18]; float* out; unsigned char* ws; int ph_lo, ph_hi; };
enum { IN_X = 0, IN_C, IN_CTX, IN_CCTX, IN_WMOD, IN_BMOD, IN_G1, IN_WIN, IN_DECF, IN_DECB, IN_CONVW, IN_WOUT, IN_G2, IN_WUP, IN_FCW, IN_FCB, IN_WDN, IN_GF };
enum { PH_PRO = 0, PH_NORM1, PH_GEMM_IN, PH_KV, PH_SCAN, PH_RETOUT, PH_GEMM_OUT, PH_NORM2, PH_GEMM_UP, PH_GATE, PH_GEMM_DN, PH_FNORM, NPH };

__device__ __forceinline__ void tr_load(const float* W, int N, int k0, int n0, f32x4 (&v)[16], int lane) {
#pragma unroll
    for (int i = 0; i < 16; ++i) v[i] = __builtin_nontemporal_load((const f32x4*)(W + (size_t)(k0 + 4 * i + (lane >> 4)) * N + n0 + 4 * (lane & 15)));
}
__device__ __forceinline__ void tr_to_lds(const f32x4 (&v)[16], LAS float* scr, int lane) {
#pragma unroll
    for (int i = 0; i < 16; ++i) { LAS float* d = scr + (4 * i + (lane >> 4)) * 65 + 4 * (lane & 15); d[0] = v[i].x; d[1] = v[i].y; d[2] = v[i].z; d[3] = v[i].w; }
    LDS_WAIT(); asm volatile("" ::: "memory");
}
__device__ __forceinline__ void tr_store(bf16* WT, int K, int mode  , int k0, int n0, LAS float* scr, int lane, unsigned char* W8) {
    const int c = lane & 7;
#pragma unroll
    for (int j = 0; j < 8; ++j) { const int n = (lane >> 3) + 8 * j; const LAS float* s = scr + (8 * c) * 65 + n;
        v4u o; o.x = pk2(s[0 * 65], s[1 * 65]); o.y = pk2(s[2 * 65], s[3 * 65]); o.z = pk2(s[4 * 65], s[5 * 65]); o.w = pk2(s[6 * 65], s[7 * 65]);
        int ng = n0 + n;
        if (mode == 2) { const int cc = ng < DFF ? ng : ng - DFF; ng = 256 * (cc >> 7) + (ng < DFF ? 0 : 128) + (cc & 127); }
        if (mode == 1) {
            if (ng < 2 * RW) ng = (ng & ~63) + 2 * (ng & 31) + ((ng >> 5) & 1);
            else if (ng >= 3 * RW) {
                const int sec = (ng - 3 * RW) >> 10, cc = (ng - 3 * RW) & 1023, tt = cc >> 6, r = cc & 63;
                const int lanecol = 32 * (r >> 4) + 8 * ((r >> 2) & 3) + (r & 3);
                ng = 256 * (12 + tt) + lanecol + (sec == 0 ? 128 + 4 : sec == 1 ? 128 : sec == 2 ? 0 : 4); }
        }
        if (mode == 1 && ng >= RW && ng < 3 * RW) { v2u o8; o8.x = pg8::cvt_pk4_fp8(64.f * s[0 * 65], 64.f * s[1 * 65], 64.f * s[2 * 65], 64.f * s[3 * 65]); o8.y = pg8::cvt_pk4_fp8(64.f * s[4 * 65], 64.f * s[5 * 65], 64.f * s[6 * 65], 64.f * s[7 * 65]);
            *(GAS v2u*)(W8 + (size_t)(ng - RW) * K + k0 + 8 * c) = o8; }
        if (mode == 3) { v2u o8; o8.x = pg8::cvt_pk4_fp8(64.f * s[0 * 65], 64.f * s[1 * 65], 64.f * s[2 * 65], 64.f * s[3 * 65]); o8.y = pg8::cvt_pk4_fp8(64.f * s[4 * 65], 64.f * s[5 * 65], 64.f * s[6 * 65], 64.f * s[7 * 65]);
            *(GAS v2u*)((unsigned char*)WT + (size_t)ng * K + k0 + 8 * c) = o8; }
        else *(GAS v4u*)(WT + (size_t)ng * K + k0 + 8 * c) = o; }
    LDS_WAIT(); asm volatile("" ::: "memory");
}

__device__ __forceinline__ void norm_row_bf16(const float* xrow, bf16* orow, const LAS float* mulT, const LAS float* addT, int lane) {
    const GAS f32x4* xr = (const GAS f32x4*)xrow + lane;
    f32x4 v[8]; float s = 0.f;
#pragma unroll
    for (int j = 0; j < 8; ++j) { v[j] = xr[64 * j]; s += (v[j].x * v[j].x + v[j].y * v[j].y) + (v[j].z * v[j].z + v[j].w * v[j].w); }
    const float rstd = rsqrtf(wave_sum(s) * (1.f / D) + EPS);
    GAS v2u* o8 = (GAS v2u*)orow + lane;
#pragma unroll
    for (int j = 0; j < 8; ++j) { const f32x4 mu = *(const LAS f32x4*)(mulT + 4 * (lane + 64 * j)), ad = *(const LAS f32x4*)(addT + 4 * (lane + 64 * j));
        const f32x4 y = v[j] * rstd * mu + ad; v2u w; w.x = pk2(y.x, y.y); w.y = pk2(y.z, y.w); o8[64 * j] = w; }
}

__device__ __forceinline__ void norm_row_fp8(const float* xrow, unsigned char* orow, const LAS float* mulT, const LAS float* addT, int lane) {
    const GAS f32x4* xr = (const GAS f32x4*)xrow + lane;
    f32x4 v[8]; float s = 0.f;
#pragma unroll
    for (int j = 0; j < 8; ++j) { v[j] = xr[64 * j]; s += (v[j].x * v[j].x + v[j].y * v[j].y) + (v[j].z * v[j].z + v[j].w * v[j].w); }
    const float rstd = rsqrtf(wave_sum(s) * (1.f / D) + EPS);
    GAS unsigned* o4 = (GAS unsigned*)orow + lane;
#pragma unroll
    for (int j = 0; j < 8; ++j) { const f32x4 mu = *(const LAS f32x4*)(mulT + 4 * (lane + 64 * j)), ad = *(const LAS f32x4*)(addT + 4 * (lane + 64 * j));
        const f32x4 y = v[j] * rstd * mu + ad; o4[64 * j] = pg8::cvt_pk4_fp8(y.x, y.y, y.z, y.w); }
}

__device__ __forceinline__ void norm_row2_bf16(const float* xa, bf16* oa, const LAS float* mulA, const LAS float* addA, const float* xb, bf16* ob, const LAS float* mulB, const LAS float* addB, int lane) {
    const GAS f32x4* pa = (const GAS f32x4*)xa + lane; const GAS f32x4* pb = (const GAS f32x4*)xb + lane;
    f32x4 va[8], vb[8]; float sa = 0.f, sb = 0.f;
#pragma unroll
    for (int j = 0; j < 8; ++j) { va[j] = pa[64 * j]; vb[j] = pb[64 * j]; }
#pragma unroll
    for (int j = 0; j < 8; ++j) { sa += (va[j].x * va[j].x + va[j].y * va[j].y) + (va[j].z * va[j].z + va[j].w * va[j].w); sb += (vb[j].x * vb[j].x + vb[j].y * vb[j].y) + (vb[j].z * vb[j].z + vb[j].w * vb[j].w); }
    const float ra = rsqrtf(wave_sum(sa) * (1.f / D) + EPS), rb = rsqrtf(wave_sum(sb) * (1.f / D) + EPS);
    GAS v2u* qa = (GAS v2u*)oa + lane; GAS v2u* qb = (GAS v2u*)ob + lane;
#pragma unroll
    for (int j = 0; j < 8; ++j) { const f32x4 mu = *(const LAS f32x4*)(mulA + 4 * (lane + 64 * j)), ad = *(const LAS f32x4*)(addA + 4 * (lane + 64 * j));
        const f32x4 y = va[j] * ra * mu + ad; v2u w; w.x = pk2(y.x, y.y); w.y = pk2(y.z, y.w); qa[64 * j] = w; }
#pragma unroll
    for (int j = 0; j < 8; ++j) { const f32x4 mu = *(const LAS f32x4*)(mulB + 4 * (lane + 64 * j)), ad = *(const LAS f32x4*)(addB + 4 * (lane + 64 * j));
        const f32x4 y = vb[j] * rb * mu + ad; v2u w; w.x = pk2(y.x, y.y); w.y = pk2(y.z, y.w); qb[64 * j] = w; }
}

__device__ __forceinline__ f32x4 moda4(const int* p) { const int4 v = *(const int4*)p; return (f32x4){(float)v.x, (float)v.y, (float)v.z, (float)v.w} * (1.f / 16777216.f); }

__global__ void __launch_bounds__(NTHR, 2) fwd_kernel(Args args) {
    extern __shared__ __attribute__((aligned(16))) unsigned char lds_raw[];
    LAS unsigned char* lds = (LAS unsigned char*)lds_raw;
    volatile LAS unsigned* MISC = (volatile LAS unsigned*)(lds + MISC_OFF);
    const int tid = threadIdx.x, lane = tid & 63, wave = __builtin_amdgcn_readfirstlane(tid >> 6);
    const int G = gridDim.x, bx = blockIdx.x;
    const int gw = bx * NWAVES + wave, NGW = G * NWAVES;
    const int gtid = bx * NTHR + tid, NGT = G * NTHR;
    unsigned char* ws = args.ws;
    const float* x = args.in[IN_X]; float* out = args.out;
    float* COS = (float*)(ws + WS_COS); float* SIN = (float*)(ws + WS_SIN); float* PW = (float*)(ws + WS_PW);
    float* MODF = (float*)(ws + WS_MODF); int* MODA = (int*)(ws + WS_CTL + 65536);
    float* MODP = (float*)(ws + WS_MODP); (void)MODP; float* MUL2 = (float*)(ws + WS_MUL2); float* BIAS2 = (float*)(ws + WS_BIAS2); float* ROWSS = (float*)(ws + WS_ROWSS);
    bf16* WIN_T = (bf16*)(ws + WS_WIN); bf16* WOUT_T = (bf16*)(ws + WS_WOUT); bf16* WUP_T = (bf16*)(ws + WS_WUP); bf16* WDN_T = (bf16*)(ws + WS_WDN);
    unsigned char* WKV8 = ws + WS_WKV8; unsigned char* HC8 = ws + WS_HC8;
    bf16* XN = (bf16*)(ws + WS_XN); bf16* HC = (bf16*)(ws + WS_HC); (void)HC; bf16* KVC = (bf16*)(ws + WS_KVC);
    bf16* ACT = (bf16*)(ws + WS_UA);
    bf16* P = (bf16*)(ws + WS_P); bf16* GS = (bf16*)(ws + WS_GS); bf16* CAT = (bf16*)(ws + WS_CAT); bf16* UA = (bf16*)(ws + WS_UA); bf16* UB = (bf16*)(ws + WS_UB);
    float* CTXS = (float*)(ws + WS_CTXS);
    bf16* KVS = (bf16*)(ws + WS_XN);
    bf16* SPV = KVS;

    if (tid < 64) MISC[tid] = 0u;
    __syncthreads();
#if ONE_LAUNCH
    XcdBarrier bar = xcd_barrier_post((unsigned*)(ws + WS_CTL) + CW_BAR, MISC + 8);
#define GRID_BAR() xcd_barrier(bar)
#else
#define GRID_BAR() do {} while (0)
#endif
    const int lo = args.ph_lo, hi = args.ph_hi;
#ifndef PHMASK
#define PHMASK 0xFFF
#endif
#define IN(k) (((PHMASK >> (k)) & 1) && lo <= (k) && (k) < hi)
#define BOTH(k) (IN(k) && IN((k) + 1))
#ifndef REP_MASK
#define REP_MASK 0
#endif
#define REPS(k) ((((REP_MASK) >> (k)) & 1) + 1)
#ifndef TIME_PHASE
#define TIME_PHASE -1
#endif
    unsigned long long tp_a = 0, tp_b = 0;
#define TP_BEGIN(k) do { if (TIME_PHASE == (k)) tp_a = __builtin_amdgcn_s_memrealtime(); } while (0)
#define TSEG_A(k) do { if (TIME_PHASE == (k)) tp_a = __builtin_amdgcn_s_memrealtime(); } while (0)
#define TSEG_B(k) do { if (TIME_PHASE == (k)) tp_b += __builtin_amdgcn_s_memrealtime() - tp_a; } while (0)
#define TP_END(k) do { if (TIME_PHASE == (k)) tp_b = __builtin_amdgcn_s_memrealtime(); } while (0)
#ifndef GEMM_REP_SEL
#define GEMM_REP_SEL 0
#endif
#define GEMM_REP_ID 15

    constexpr int I_IN = (D / 64) * (INW / 64), I_OUT = (D / 64) * (D / 64), I_UP = (D / 64) * (NUP / 64), I_DN = (DFF / 64) * (D / 64), I_GV = NSL * (NMOD / 64);
    if (IN(PH_PRO)) { TP_BEGIN(PH_PRO);
      for (int rep_ = 0; rep_ < REPS(PH_PRO); ++rep_) {
        if (gw < I_GV) {
            const int r = gw, s = r / (NMOD / 64), col = (r % (NMOD / 64)) * 64 + lane;
            float a0 = 0.f, a1 = 0.f, a2 = 0.f;
            for (int kb = 0; kb < 4; ++kb) {
                const int kbase = s * 256 + kb * 64;
                const float c0 = silu_f(args.in[IN_C][kbase + lane]), c1 = silu_f(args.in[IN_C][D + kbase + lane]), c2 = silu_f(args.in[IN_CCTX][kbase + lane]);
                const float* wp = args.in[IN_WMOD] + (size_t)kbase * NMOD + col;
                float wv[64];
#pragma unroll
                for (int kk = 0; kk < 64; ++kk) wv[kk] = __builtin_nontemporal_load(wp + (size_t)kk * NMOD);
#pragma unroll
                for (int kk = 0; kk < 64; ++kk) {
                    a0 += wv[kk] * __builtin_bit_cast(float, __builtin_amdgcn_readlane(__builtin_bit_cast(int, c0), kk));
                    a1 += wv[kk] * __builtin_bit_cast(float, __builtin_amdgcn_readlane(__builtin_bit_cast(int, c1), kk));
                    a2 += wv[kk] * __builtin_bit_cast(float, __builtin_amdgcn_readlane(__builtin_bit_cast(int, c2), kk));
                }
            }
            atomicAdd(MODA + col, __float2int_rn(a0 * 16777216.f)); atomicAdd(MODA + NMOD + col, __float2int_rn(a1 * 16777216.f)); atomicAdd(MODA + 2 * NMOD + col, __float2int_rn(a2 * 16777216.f));
        }
        {
#define TR_DECODE(it_, P_) const float* P_##W; bf16* P_##T; int P_##K, P_##N, P_##m; { int r_ = (it_); \
                if (r_ < I_IN) { P_##W = args.in[IN_WIN]; P_##T = WIN_T; P_##K = D; P_##N = INW; P_##m = 1; } \
                else if ((r_ -= I_IN) < I_UP) { P_##W = args.in[IN_WUP]; P_##T = WUP_T; P_##K = D; P_##N = NUP; P_##m = 2; } \
                else if ((r_ -= I_UP) < I_OUT) { P_##W = args.in[IN_WOUT]; P_##T = WOUT_T; P_##K = D; P_##N = D; P_##m = 0; } \
                else { r_ -= I_OUT; P_##W = args.in[IN_WDN]; P_##T = WDN_T; P_##K = DFF; P_##N = D; P_##m = 3; } \
                P_##k0 = 64 * (r_ / (P_##N / 64)); P_##n0 = 64 * (r_ % (P_##N / 64)); }
#define TR_RUN(first_, end_, wid_, nw_) do { LAS float* scr_ = (LAS float*)(lds + wave * 16640); int it_ = (first_) + (wid_); f32x4 v_[16]; \
                if (it_ < (end_)) { int c_k0, c_n0; TR_DECODE(it_, c_) (void)c_T; (void)c_K; (void)c_m; tr_load(c_W, c_N, c_k0, c_n0, v_, lane); } \
                for (; it_ < (end_); it_ += (nw_)) { int c_k0, c_n0; TR_DECODE(it_, c_) (void)c_W; (void)c_N; \
                    tr_to_lds(v_, scr_, lane); \
                    if (it_ + (nw_) < (end_)) { int n_k0, n_n0; TR_DECODE(it_ + (nw_), n_) (void)n_T; (void)n_K; (void)n_m; tr_load(n_W, n_N, n_k0, n_n0, v_, lane); } \
                    tr_store(c_T, c_K, c_m, c_k0, c_n0, scr_, lane, WKV8); } } while (0)
            TR_RUN(-I_GV, I_IN + I_UP, gw < I_GV ? gw + NGW : gw, NGW);
        }
        if (gtid < 4096) { const int pos = gtid >> 5, i = gtid & 31; const float fr = powf(10000.f, -(float)i / 32.f); const float ang = (float)pos * fr; COS[gtid] = cosf(ang); SIN[gtid] = sinf(ang); }
        else if (gtid < 4096 + 2 * NH * 257) { const int idx = gtid - 4096, dir = idx / (NH * 257), h = (idx / 257) % NH, k = idx % 257;
            const float lg0 = args.in[dir ? IN_DECB : IN_DECF][h]; const float lg = fminf(lg0, 0.f) - log1pf(expf(-fabsf(lg0)));
            PW[(dir * NH + h) * PWS + k] = expf(lg * (float)k); }
      }
        if (BOTH(PH_PRO)) GRID_BAR();
        TP_END(PH_PRO);
    }

    if (IN(PH_NORM1)) { TP_BEGIN(PH_NORM1);
      for (int rep_ = 0; rep_ < REPS(PH_NORM1); ++rep_) {
        if (TIME_PHASE == 110) tp_a = __builtin_amdgcn_s_memrealtime();
        f32x4 va[8], vb[8];
        auto ldpair = [&](int m) { const int m2 = m + NGW < M ? m + NGW : m; const GAS f32x4* pa = (const GAS f32x4*)(x + (size_t)m * D) + lane; const GAS f32x4* pb = (const GAS f32x4*)(x + (size_t)m2 * D) + lane;
#pragma unroll
            for (int j = 0; j < 8; ++j) { va[j] = __builtin_nontemporal_load(pa + 64 * j); vb[j] = __builtin_nontemporal_load(pb + 64 * j); } };
        if (gw < M) ldpair(gw);
        LAS float* mulT = (LAS float*)lds;
        LAS float* addT = (LAS float*)(lds + 3 * D * 4);
        for (int i = tid; i < 3 * D / 4; i += NTHR) { const int r = i / (D / 4), k = 4 * (i % (D / 4));
            const f32x4 sh = *(const f32x4*)(args.in[IN_BMOD] + k) + moda4(MODA + (size_t)r * NMOD + k), sc = *(const f32x4*)(args.in[IN_BMOD] + D + k) + moda4(MODA + (size_t)r * NMOD + D + k);
            *(LAS f32x4*)(mulT + r * D + k) = *(const f32x4*)(args.in[IN_G1] + k) * (sc + 1.f); *(LAS f32x4*)(addT + r * D + k) = sh; }
        for (int i = gtid; i < 3 * NMOD / 4; i += NGT) { const int r = i / (NMOD / 4), col = 4 * (i % (NMOD / 4));
            *(f32x4*)(MODF + (size_t)r * NMOD + col) = *(const f32x4*)(args.in[IN_BMOD] + col) + moda4(MODA + (size_t)r * NMOD + col); }
        if (gtid < 2 * D / 4) { const int r = gtid / (D / 4), k = 4 * (gtid % (D / 4));
            const f32x4 sc = *(const f32x4*)(args.in[IN_BMOD] + 4 * D + k) + moda4(MODA + (size_t)r * NMOD + 4 * D + k);
            *(f32x4*)(MUL2 + r * D + k) = *(const f32x4*)(args.in[IN_G2] + k) * (sc + 1.f); }
        __syncthreads();
        if (TIME_PHASE == 110) tp_b = __builtin_amdgcn_s_memrealtime();
        if (TIME_PHASE == 111) tp_a = __builtin_amdgcn_s_memrealtime();
        if (TIME_PHASE == 111) tp_b = __builtin_amdgcn_s_memrealtime();
        if (TIME_PHASE == 112) tp_a = __builtin_amdgcn_s_memrealtime();
        {
            for (int m = gw; m < M; m += 2 * NGW) {
                const int m2 = m + NGW < M ? m + NGW : m;
                float sa = 0.f, sb = 0.f; f32x4 ya[8], yb[8];
#pragma unroll
                for (int j = 0; j < 8; ++j) { ya[j] = va[j]; yb[j] = vb[j]; sa += (va[j].x * va[j].x + va[j].y * va[j].y) + (va[j].z * va[j].z + va[j].w * va[j].w); sb += (vb[j].x * vb[j].x + vb[j].y * vb[j].y) + (vb[j].z * vb[j].z + vb[j].w * vb[j].w); }
                if (m + 2 * NGW < M) ldpair(m + 2 * NGW);
                asm volatile("" ::: "memory");
                const float ra = rsqrtf(wave_sum(sa) * (1.f / D) + EPS), rb = rsqrtf(wave_sum(sb) * (1.f / D) + EPS);
                const LAS float* mulA = mulT + (m >> 13) * D; const LAS float* addA = addT + (m >> 13) * D; const LAS float* mulB = mulT + (m2 >> 13) * D; const LAS float* addB = addT + (m2 >> 13) * D;
                GAS v2u* qa = (GAS v2u*)(XN + (size_t)m * D) + lane; GAS v2u* qb = (GAS v2u*)(XN + (size_t)m2 * D) + lane;
#pragma unroll
                for (int j = 0; j < 8; ++j) { const f32x4 mu = *(const LAS f32x4*)(mulA + 4 * (lane + 64 * j)), ad = *(const LAS f32x4*)(addA + 4 * (lane + 64 * j));
                    const f32x4 y = ya[j] * ra * mu + ad; v2u w; w.x = pk2(y.x, y.y); w.y = pk2(y.z, y.w); qa[64 * j] = w; }
#pragma unroll
                for (int j = 0; j < 8; ++j) { const f32x4 mu = *(const LAS f32x4*)(mulB + 4 * (lane + 64 * j)), ad = *(const LAS f32x4*)(addB + 4 * (lane + 64 * j));
                    const f32x4 y = yb[j] * rb * mu + ad; v2u w; w.x = pk2(y.x, y.y); w.y = pk2(y.z, y.w); qb[64 * j] = w; }
            }
        }
        for (int mc = gw; mc < MC; mc += NGW) norm_row_fp8(args.in[IN_CTX] + (size_t)mc * D, HC8 + (size_t)mc * D, mulT + 2 * D, addT + 2 * D, lane);
      }
        if (TIME_PHASE == 112) tp_b = __builtin_amdgcn_s_memrealtime();
        if (TIME_PHASE == 113) tp_a = __builtin_amdgcn_s_memrealtime();
        if (BOTH(PH_NORM1)) GRID_BAR();
        if (TIME_PHASE == 113) tp_b = __builtin_amdgcn_s_memrealtime();
        TP_END(PH_NORM1);
    }

    if (IN(PH_GEMM_IN)) { TP_BEGIN(PH_GEMM_IN);
      {
        __syncthreads();
        { pg8::Gemm g{XN, WIN_T, M, INW, D}; pg8::StaticOrder S; S.init(M, INW, G, bx);
          pg8::EpiIn E{P, PLD, CAT + RW, D, GS, RW, COS, SIN, args.in[IN_CONVW], CCH, KSCALE};
          pg8::gemm_phase<pg8::EpiIn, pg8::StaticOrder, GP_ALIGN, GP_SP2>(lds, g, S, E);
          if (REPS(GEMM_REP_ID) == 2 && GEMM_REP_SEL == __LINE__) pg8::gemm_phase<pg8::EpiIn, pg8::StaticOrder, GP_ALIGN, GP_SP2>(lds, g, S, E);
          if (GEMM_REP_SEL == 9001) { pg8::EpiNull EN; pg8::gemm_phase<pg8::EpiNull, pg8::StaticOrder, GP_ALIGN, GP_SP2>(lds, g, S, EN); }
          if (GEMM_REP_SEL == 9002) { pg8::EpiNull EN; pg8::SameTileOrder S2; S2.init(M, INW, G, bx); pg8::gemm_phase<pg8::EpiNull, pg8::SameTileOrder, GP_ALIGN, GP_SP2>(lds, g, S2, EN); } }
        { pg8::Gemm g{(const bf16*)HC8, (const bf16*)WKV8, MC, 2 * RW, D / 2}; pg8::StaticOrder S; S.init(MC, 2 * RW, G, bx);
          pg8::EpiBf16R E{KVC, 2 * RW, 0, 0, COS, SIN, 0, 0, 4, KSCALE, 1.f / 64.f};
          pg8::gemm_phase<pg8::EpiBf16R, pg8::StaticOrder, GP_ALIGN, GP_SP2, true>(lds, g, S, E);
          if (REPS(GEMM_REP_ID) == 2 && GEMM_REP_SEL == __LINE__) pg8::gemm_phase<pg8::EpiBf16R, pg8::StaticOrder, GP_ALIGN, GP_SP2, true>(lds, g, S, E); }
      }
        {
            constexpr int NCTXU = (MC / 256) * (2 * RW / 256);
            LAS float* sh2T = (LAS float*)lds;
            __syncthreads();
            for (int i = tid; i < 2 * D / 4; i += NTHR) { const int r = i / (D / 4), k = 4 * (i % (D / 4)); *(LAS f32x4*)(sh2T + r * D + k) = *(const f32x4*)(MODF + (size_t)r * NMOD + 3 * D + k); }
            __syncthreads();
            const bool tailw = G > NCTXU; const int tw = tailw ? (bx - NCTXU) * NWAVES + wave : gw, ntw = tailw ? (G - NCTXU) * NWAVES : NGW;
            if (!tailw || bx >= NCTXU)
            for (int col = tw; col < NUP; col += 2 * ntw) {
                const int col2 = col + ntw < NUP ? col + ntw : col;
                const bf16* wr0 = WUP_T + (size_t)col * D; const bf16* wr1 = WUP_T + (size_t)col2 * D; float s0 = 0.f, s1 = 0.f, t0 = 0.f, t1 = 0.f; v4u wq0[4], wq1[4];
#pragma unroll
                for (int j = 0; j < 4; ++j) { const int k0 = 8 * (lane + 64 * j); wq0[j] = *(const GAS v4u*)(wr0 + k0); wq1[j] = *(const GAS v4u*)(wr1 + k0); }
#pragma unroll
                for (int j = 0; j < 4; ++j) { const int k0 = 8 * (lane + 64 * j);
                    const f32x4 a0 = *(const LAS f32x4*)(sh2T + k0), a1 = *(const LAS f32x4*)(sh2T + k0 + 4), c0 = *(const LAS f32x4*)(sh2T + D + k0), c1 = *(const LAS f32x4*)(sh2T + D + k0 + 4);
                    { const v4u wq = wq0[j]; const float wv[8] = {bflo(wq.x), bfhi(wq.x), bflo(wq.y), bfhi(wq.y), bflo(wq.z), bfhi(wq.z), bflo(wq.w), bfhi(wq.w)};
                      s0 += (wv[0] * a0.x + wv[1] * a0.y) + (wv[2] * a0.z + wv[3] * a0.w) + (wv[4] * a1.x + wv[5] * a1.y) + (wv[6] * a1.z + wv[7] * a1.w);
                      s1 += (wv[0] * c0.x + wv[1] * c0.y) + (wv[2] * c0.z + wv[3] * c0.w) + (wv[4] * c1.x + wv[5] * c1.y) + (wv[6] * c1.z + wv[7] * c1.w); }
                    { const v4u wq = wq1[j]; const float wv[8] = {bflo(wq.x), bfhi(wq.x), bflo(wq.y), bfhi(wq.y), bflo(wq.z), bfhi(wq.z), bflo(wq.w), bfhi(wq.w)};
                      t0 += (wv[0] * a0.x + wv[1] * a0.y) + (wv[2] * a0.z + wv[3] * a0.w) + (wv[4] * a1.x + wv[5] * a1.y) + (wv[6] * a1.z + wv[7] * a1.w);
                      t1 += (wv[0] * c0.x + wv[1] * c0.y) + (wv[2] * c0.z + wv[3] * c0.w) + (wv[4] * c1.x + wv[5] * c1.y) + (wv[6] * c1.z + wv[7] * c1.w); } }
                s0 = wave_sum(s0); s1 = wave_sum(s1); t0 = wave_sum(t0); t1 = wave_sum(t1);
                if (lane == 0) { BIAS2[col] = s0; BIAS2[NUP + col] = s1; BIAS2[col2] = t0; BIAS2[NUP + col2] = t1; }
            }
            __syncthreads();
            if (!tailw || bx >= NCTXU) TR_RUN(I_IN + I_UP, I_IN + I_UP + I_OUT + I_DN, tw, ntw);
        }
        if (BOTH(PH_GEMM_IN)) GRID_BAR();
        TP_END(PH_GEMM_IN);
    }

    if (IN(PH_KV)) { TP_BEGIN(PH_KV);
      for (int rep_ = 0; rep_ < REPS(PH_KV); ++rep_) {
        __syncthreads();
        LAS unsigned char* Kimg = lds; LAS unsigned char* Vfimg = lds + 32768; LAS unsigned char* Vbimg = lds + 65536;
        constexpr int NKVI = BATCH * NH * NCHK + BATCH * NH * 2;
#define P3_DECODE(it_) const bf16* kptr; const bf16* vptr; size_t stride; int wfo, wbo, h; size_t ooff; bool ctxi; \
            if ((it_) < BATCH * NH * NCHK) { const int b = (it_) >> 9, ch = (it_) & 63; h = ((it_) >> 6) & 7; \
                kptr = P + ((size_t)b * SEQ + (size_t)ch * CHK) * PLD + RW + h * DH; vptr = kptr + RW; stride = PLD; wfo = 127; wbo = 0; \
                ooff = ((((size_t)b * NH + h) * NCHK + ch) * DH) * DH; ctxi = false; } \
            else { const int r = (it_) - BATCH * NH * NCHK, b = r >> 4, c = r & 1; h = (r >> 1) & 7; \
                kptr = KVC + ((size_t)b * CTXL + (size_t)c * CHK) * (2 * RW) + h * DH; vptr = kptr + RW; stride = 2 * RW; wfo = CTXL - 1 - CHK * c; wbo = CHK * c; \
                ooff = ((((size_t)b * NH + h) * 2 + c) * DH) * DH; ctxi = true; } \
            (void)wfo; (void)wbo; (void)ooff; (void)ctxi; (void)kptr; (void)vptr; (void)stride;
#define P3_LOAD() do { _Pragma("unroll") for (int i = 0; i < 4; ++i) { const int p = tid + NTHR * i, row = p >> 4, c16 = p & 15; \
            nk[i] = *(const GAS v4u*)(kptr + (size_t)row * stride + c16 * 8); nv[i] = *(const GAS v4u*)(vptr + (size_t)row * stride + c16 * 8); \
            nwf[i] = PW[(0 * NH + h) * PWS + wfo - row]; nwb[i] = PW[(1 * NH + h) * PWS + wbo + row]; } } while (0)
        v4u nk[4], nv[4]; float nwf[4], nwb[4];
        if (bx < NKVI) { P3_DECODE(bx) P3_LOAD(); }
        for (int item = bx; item < NKVI; item += G) {
            P3_DECODE(item)
#pragma unroll
            for (int i = 0; i < 4; ++i) { const int p = tid + NTHR * i, row = p >> 4, c16 = p & 15;
                const float wf = nwf[i], wb = nwb[i];
                const unsigned o = off_b(row, c16);
                *(LAS v4u*)(Kimg + o) = nk[i]; *(LAS v4u*)(Vfimg + o) = scale_pk8(nv[i], wf); *(LAS v4u*)(Vbimg + o) = scale_pk8(nv[i], wb); }
            if (item + G < NKVI) { const int nit = item + G; { P3_DECODE(nit) P3_LOAD(); } }
            __syncthreads();
            {
                const unsigned g4 = lane >> 4, fr = lane & 15; const int dkg = wave >> 1, dvh = wave & 1;
                f32x4 accf[4][2], accb[4][2];
#pragma unroll
                for (int mt = 0; mt < 4; ++mt)
#pragma unroll
                    for (int nt = 0; nt < 2; ++nt) { accf[mt][nt] = (f32x4){0.f, 0.f, 0.f, 0.f}; accb[mt][nt] = (f32x4){0.f, 0.f, 0.f, 0.f}; }
#pragma unroll
                for (int ks = 0; ks < 4; ++ks) {
                    bf16x8 kf[2];
#pragma unroll
                    for (int nt = 0; nt < 2; ++nt) kf[nt] = tr_frag(Kimg, lane, 32 * ks + 8 * g4, 32 * ks + 8 * g4 + 4, 2 * dkg + nt);
#pragma unroll
                    for (int mt = 0; mt < 4; ++mt) {
                        const bf16x8 vf = tr_frag(Vfimg, lane, 32 * ks + 8 * g4, 32 * ks + 8 * g4 + 4, 4 * dvh + mt);
                        const bf16x8 vb = tr_frag(Vbimg, lane, 32 * ks + 8 * g4, 32 * ks + 8 * g4 + 4, 4 * dvh + mt);
#pragma unroll
                        for (int nt = 0; nt < 2; ++nt) { accf[mt][nt] = __builtin_amdgcn_mfma_f32_16x16x32_bf16(kf[nt], vf, accf[mt][nt], 0, 0, 0); accb[mt][nt] = __builtin_amdgcn_mfma_f32_16x16x32_bf16(kf[nt], vb, accb[mt][nt], 0, 0, 0); }
                    }
                }
                (void)fr; (void)g4;
#pragma unroll
                for (int mt = 0; mt < 4; ++mt) { const size_t o = ooff + (size_t)(((dkg * 8 + 4 * dvh + mt) * 64 + (int)lane) * 8);
                    if (ctxi) { *(f32x4*)(CTXS + o) = accf[mt][0]; *(f32x4*)(CTXS + o + 4) = accf[mt][1]; *(f32x4*)(CTXS + (size_t)BATCH * NH * 2 * DH * DH + o) = accb[mt][0]; *(f32x4*)(CTXS + (size_t)BATCH * NH * 2 * DH * DH + o + 4) = accb[mt][1]; }
                    else { v4u wf_, wb_; wf_.x = pk2(accf[mt][0].x, accf[mt][0].y); wf_.y = pk2(accf[mt][0].z, accf[mt][0].w); wf_.z = pk2(accf[mt][1].x, accf[mt][1].y); wf_.w = pk2(accf[mt][1].z, accf[mt][1].w);
                        wb_.x = pk2(accb[mt][0].x, accb[mt][0].y); wb_.y = pk2(accb[mt][0].z, accb[mt][0].w); wb_.z = pk2(accb[mt][1].x, accb[mt][1].y); wb_.w = pk2(accb[mt][1].z, accb[mt][1].w);
                        *(GAS v4u*)(KVS + o) = wf_; *(GAS v4u*)(KVS + (size_t)BATCH * NH * NCHK * DH * DH + o) = wb_; } }
            }
            __syncthreads();
        }
#undef P3_DECODE
#undef P3_LOAD
        {
            constexpr int extra_ = 0; (void)extra_; const int ex = NKVI % G; const bool tl = ex != 0;
            (void)tl;
        }
      }
        if (BOTH(PH_KV)) GRID_BAR();
        TP_END(PH_KV);
    }

    v4u pq_[4], pk_[4]; float ppw_ = 0.f; bool pre5 = false;
    if (IN(PH_SCAN)) { TP_BEGIN(PH_SCAN);
        if (BOTH(PH_SCAN) && REPS(PH_SCAN) == 1 && bx < BATCH * NH * NCHK) { const int b_ = bx >> 9, h_ = (bx >> 6) & 7, ch_ = bx & 63; const bf16* qp_ = P + ((size_t)b_ * SEQ + (size_t)ch_ * CHK) * PLD + h_ * DH;
#pragma unroll
            for (int i = 0; i < 4; ++i) { const int p = tid + NTHR * i, row = p >> 4, c16 = p & 15;
                pq_[i] = __builtin_nontemporal_load((const GAS v4u*)(qp_ + (size_t)row * PLD + c16 * 8)); pk_[i] = __builtin_nontemporal_load((const GAS v4u*)(qp_ + (size_t)row * PLD + RW + c16 * 8)); }
            if (tid < 2 * 129) ppw_ = PW[((tid / 129) * NH + h_) * PWS + (tid % 129)];
            pre5 = true; }
      for (int rep_ = 0; rep_ < REPS(PH_SCAN); ++rep_) {
        for (int e4 = gtid; e4 < 2 * BATCH * NH * DH * DH / 4; e4 += NGT) {
            const int hbu_ = __builtin_amdgcn_readfirstlane(e4 >> 12);
            const int dv4 = e4 & 31, dk = (e4 >> 5) & 127, h = hbu_ & 7, b = (hbu_ >> 3) & 1, dir = hbu_ >> 4;
            const float* pw = PW + (dir * NH + h) * PWS;
            const float* c0 = CTXS + ((((size_t)(dir * BATCH + b) * NH + h) * 2 + 0) * DH) * DH + (size_t)dk * DH + dv4 * 4;
            f32x4 s = *(const f32x4*)c0 + *(const f32x4*)(c0 + (size_t)DH * DH);
            const float cd = pw[CHK];
            const int hbu = hbu_;
            const bf16* kbase = KVS + (size_t)hbu * NCHK * DH * DH; bf16* sbase = SPV + (size_t)hbu * NCHK * DH * DH; const unsigned boff = (unsigned)(dk * DH + dv4 * 4);
            v2u ta[16], tb[16];
#pragma unroll
            for (int j = 0; j < 16; ++j) { const int n = dir ? (NCHK - 1 - j) : j; ta[j] = __builtin_nontemporal_load((const GAS v2u*)(kbase + (size_t)n * DH * DH + boff)); }
#pragma unroll
            for (int bt = 0; bt < NCHK / 16; bt += 2) {
                if (bt + 1 < NCHK / 16) {
#pragma unroll
                    for (int j = 0; j < 16; ++j) { const int i = (bt + 1) * 16 + j, n = dir ? (NCHK - 1 - i) : i; tb[j] = __builtin_nontemporal_load((const GAS v2u*)(kbase + (size_t)n * DH * DH + boff)); } }
                asm volatile("" ::: "memory");
#pragma unroll
                for (int j = 0; j < 16; ++j) { const int i = bt * 16 + j, n = dir ? (NCHK - 1 - i) : i;
                    v2u w; w.x = pk2(s.x, s.y); w.y = pk2(s.z, s.w); *(GAS v2u*)(sbase + (size_t)n * DH * DH + boff) = w;
                    s = s * cd + (f32x4){bflo(ta[j].x), bfhi(ta[j].x), bflo(ta[j].y), bfhi(ta[j].y)}; }
                asm volatile("" ::: "memory");
                if (bt + 2 < NCHK / 16) {
#pragma unroll
                    for (int j = 0; j < 16; ++j) { const int i = (bt + 2) * 16 + j, n = dir ? (NCHK - 1 - i) : i; ta[j] = __builtin_nontemporal_load((const GAS v2u*)(kbase + (size_t)n * DH * DH + boff)); } }
                asm volatile("" ::: "memory");
#pragma unroll
                for (int j = 0; j < 16; ++j) { const int i = (bt + 1) * 16 + j, n = dir ? (NCHK - 1 - i) : i;
                    v2u w; w.x = pk2(s.x, s.y); w.y = pk2(s.z, s.w); *(GAS v2u*)(sbase + (size_t)n * DH * DH + boff) = w;
                    s = s * cd + (f32x4){bflo(tb[j].x), bfhi(tb[j].x), bflo(tb[j].y), bfhi(tb[j].y)}; }
                asm volatile("" ::: "memory");
            }
        }
      }
        if (BOTH(PH_SCAN)) GRID_BAR();
        TP_END(PH_SCAN);
    }

    if (IN(PH_RETOUT)) { TP_BEGIN(PH_RETOUT);
      for (int rep_ = 0; rep_ < REPS(PH_RETOUT); ++rep_) {
        __syncthreads();
        LAS unsigned char* Qi = lds; LAS unsigned char* Ki = lds + 32768; LAS unsigned char* Vi = lds + 65536; LAS unsigned char* Si = lds + 98304;
        LAS float* pwl = (LAS float*)(lds + 131072);
        v4u rq[4], rk[4], rv[4], rf[4], rb[4];
#define P5_PTRS(it_) const int b_ = (it_) >> 9, h_ = ((it_) >> 6) & 7, ch_ = (it_) & 63; const size_t tk_ = (size_t)b_ * SEQ + (size_t)ch_ * CHK; const bf16* qp_ = P + tk_ * PLD + h_ * DH; \
        const bf16* sfp_ = SPV + ((((size_t)(0 * BATCH + b_) * NH + h_) * NCHK + ch_) * DH) * DH; const bf16* sbp_ = SPV + ((((size_t)(1 * BATCH + b_) * NH + h_) * NCHK + ch_) * DH) * DH; \
        const bf16* gp_ = GS + (tk_ + 16 * wave + (lane & 15)) * RW + h_ * DH + 16 * ((lane >> 4) & 1) + 4 * ((lane >> 4) & 2); (void)qp_; (void)sfp_; (void)sbp_; (void)gp_;
#define P5_LOAD_QK() do { _Pragma("unroll") for (int i = 0; i < 4; ++i) { const int p = tid + NTHR * i, row = p >> 4, c16 = p & 15; \
            rq[i] = __builtin_nontemporal_load((const GAS v4u*)(qp_ + (size_t)row * PLD + c16 * 8)); rk[i] = __builtin_nontemporal_load((const GAS v4u*)(qp_ + (size_t)row * PLD + RW + c16 * 8)); } } while (0)
#define P5_LOAD_VFB() do { _Pragma("unroll") for (int i = 0; i < 4; ++i) { const int p = tid + NTHR * i, row = p >> 4, c16 = p & 15; \
            rv[i] = __builtin_nontemporal_load((const GAS v4u*)(qp_ + (size_t)row * PLD + 2 * RW + c16 * 8)); rf[i] = __builtin_nontemporal_load((const GAS v4u*)(sfp_ + (size_t)row * DH + c16 * 8)); rb[i] = __builtin_nontemporal_load((const GAS v4u*)(sbp_ + (size_t)row * DH + c16 * 8)); } } while (0)
#define P5_LOAD_G() do { _Pragma("unroll") for (int J = 0; J < 4; ++J) rg[J] = __builtin_nontemporal_load((const GAS v4u*)(gp_ + 32 * J)); } while (0)
        float npw = 0.f;
#define P5_LOAD_PW(h__) do { if (tid_pw < 2 * 129) npw = PW[((tid_pw / 129) * NH + (h__)) * PWS + (tid_pw % 129)]; } while (0)
        const int tid_pw = threadIdx.x;
        if (pre5) {
#pragma unroll
            for (int i = 0; i < 4; ++i) { rq[i] = pq_[i]; rk[i] = pk_[i]; }
            npw = ppw_; }
        else if (bx < BATCH * NH * NCHK) { P5_PTRS(bx) P5_LOAD_QK(); P5_LOAD_PW(h_); }
        for (int item = bx; item < BATCH * NH * NCHK; item += G) {
            const int b = item >> 9, h = (item >> 6) & 7, ch = item & 63;
            const size_t tok0 = (size_t)b * SEQ + (size_t)ch * CHK;
            const int nitem = item + G; const bool hasn = nitem < BATCH * NH * NCHK;
            TSEG_A(120);
            int tid_o = threadIdx.x; asm volatile("" : "+v"(tid_o));
            const int tid = tid_o, lane = tid_o & 63;
#pragma unroll
            for (int i = 0; i < 4; ++i) { const int p = tid + NTHR * i, row = p >> 4, c16 = p & 15; const unsigned o = off_b(row, c16);
                *(LAS v4u*)(Qi + o) = rq[i]; *(LAS v4u*)(Ki + o) = rk[i]; }
            const float pwv = npw;
            { P5_PTRS(item) P5_LOAD_VFB(); }
            if (tid < 2 * 129) pwl[(tid / 129) * 132 + (tid % 129)] = pwv;
            __syncthreads();
            TSEG_B(120); TSEG_A(121);
            const unsigned g4 = lane >> 4, fr = lane & 15; const int i_in = 16 * wave + (int)fr;
            bf16x8 qf[4];
#pragma unroll
            for (int ks = 0; ks < 4; ++ks) qf[ks] = row_frag(Qi, lane, wave, ks);
            f32x4 sc[8];
#pragma unroll
            for (int jt = 0; jt < 8; ++jt) { sc[jt] = (f32x4){0.f, 0.f, 0.f, 0.f};
#pragma unroll
                for (int ks = 0; ks < 4; ++ks) sc[jt] = __builtin_amdgcn_mfma_f32_16x16x32_bf16(row_frag(Ki, lane, jt, ks), qf[ks], sc[jt], 0, 0, 0); }
            __syncthreads();
            TSEG_B(121); TSEG_A(122);
#pragma unroll
            for (int i = 0; i < 4; ++i) { const int p = tid + NTHR * i, row = p >> 4, c16 = p & 15; const unsigned o = off_b(row, c16); *(LAS v4u*)(Vi + o) = rv[i]; *(LAS v4u*)(Si + 16 * p) = rf[i]; *(LAS v4u*)(Ki + 16 * p) = rb[i]; }
            if (hasn) { P5_PTRS(nitem) P5_LOAD_QK(); P5_LOAD_PW(h_); }
            __syncthreads();
            TSEG_B(122); TSEG_A(123);
            v4u rg[4]; { P5_PTRS(item) P5_LOAD_G(); }
            bf16x8 pf[4];
#pragma unroll
            for (int ks = 0; ks < 4; ++ks) {
                float pv[8];
#pragma unroll
                for (int hf = 0; hf < 2; ++hf)
#pragma unroll
                    for (int rg = 0; rg < 4; ++rg) { const int j = 16 * (2 * ks + hf) + 4 * (int)g4 + rg;
                        const float dm = (j <= i_in) ? pwl[i_in - j] : pwl[132 + (j - i_in)];
                        pv[4 * hf + rg] = sc[2 * ks + hf][rg] * dm; }
                v4u w; w.x = pk2(pv[0], pv[1]); w.y = pk2(pv[2], pv[3]); w.z = pk2(pv[4], pv[5]); w.w = pk2(pv[6], pv[7]);
                pf[ks] = __builtin_bit_cast(bf16x8, w);
            }
            f32x4 o[8];
#pragma unroll
            for (int nt = 0; nt < 8; ++nt) o[nt] = (f32x4){0.f, 0.f, 0.f, 0.f};
#define P5_PIPE(LOADFRAG, BOP) do { bf16x8 fa_[4], fb_[4]; \
                _Pragma("unroll") for (int ks = 0; ks < 4; ++ks) fa_[ks] = LOADFRAG(0, ks); \
                _Pragma("unroll") for (int np = 0; np < 4; ++np) { \
                    _Pragma("unroll") for (int ks = 0; ks < 4; ++ks) fb_[ks] = LOADFRAG(2 * np + 1, ks); \
                    __builtin_amdgcn_sched_barrier(0); \
                    _Pragma("unroll") for (int ks = 0; ks < 4; ++ks) o[2 * np] = __builtin_amdgcn_mfma_f32_16x16x32_bf16(fa_[ks], BOP[ks], o[2 * np], 0, 0, 0); \
                    __builtin_amdgcn_sched_barrier(0); \
                    if (np < 3) { _Pragma("unroll") for (int ks = 0; ks < 4; ++ks) fa_[ks] = LOADFRAG(2 * np + 2, ks); } \
                    __builtin_amdgcn_sched_barrier(0); \
                    _Pragma("unroll") for (int ks = 0; ks < 4; ++ks) o[2 * np + 1] = __builtin_amdgcn_mfma_f32_16x16x32_bf16(fb_[ks], BOP[ks], o[2 * np + 1], 0, 0, 0); \
                    __builtin_amdgcn_sched_barrier(0); } } while (0)
#define P5_FRAG_V(nt_, ks_) tr_frag(Vi, lane, 32 * (ks_) + 4 * g4, 32 * (ks_) + 16 + 4 * g4, (nt_))
            P5_PIPE(P5_FRAG_V, pf);
            {
                v4u qp[4];
#pragma unroll
                for (int ks = 0; ks < 4; ++ks) { const v2u lo = *(const LAS v2u*)(Qi + off_b((unsigned)i_in, 4u * ks + (g4 >> 1)) + 8u * (g4 & 1u)), hi = *(const LAS v2u*)(Qi + off_b((unsigned)i_in, 4u * ks + 2u + (g4 >> 1)) + 8u * (g4 & 1u));
                    qp[ks].x = lo.x; qp[ks].y = lo.y; qp[ks].z = hi.x; qp[ks].w = hi.y; }
                {
                    const float qd = pwl[i_in + 1]; bf16x8 qs[4];
#pragma unroll
                    for (int ks = 0; ks < 4; ++ks) qs[ks] = __builtin_bit_cast(bf16x8, scale_pk8(qp[ks], qd));
#pragma unroll
#define P5_FRAG_SF(nt_, ks_) (*(const LAS bf16x8*)(Si + (((ks_) * 8 + (nt_)) * 64 + (int)lane) * 16))
                    P5_PIPE(P5_FRAG_SF, qs);
                }
                {
                    const float qd = pwl[132 + (CHK - i_in)]; bf16x8 qs[4];
#pragma unroll
                    for (int ks = 0; ks < 4; ++ks) qs[ks] = __builtin_bit_cast(bf16x8, scale_pk8(qp[ks], qd));
#pragma unroll
#define P5_FRAG_SB(nt_, ks_) (*(const LAS bf16x8*)(Ki + (((ks_) * 8 + (nt_)) * 64 + (int)lane) * 16))
                    P5_PIPE(P5_FRAG_SB, qs);
                }
            }
            TSEG_B(123); TSEG_A(124);
            {
                float ss = 0.f;
#pragma unroll
                for (int nt = 0; nt < 8; ++nt) ss += (o[nt].x * o[nt].x + o[nt].y * o[nt].y) + (o[nt].z * o[nt].z + o[nt].w * o[nt].w);
                ss += __shfl_xor(ss, 16); ss += __shfl_xor(ss, 32);
                const float rstd = rsqrtf(ss * (1.f / DH) + EPS);
                bf16* op = CAT + (tok0 + i_in) * D + h * DH + 16 * (g4 & 1u) + 4 * (g4 & 2u);
#pragma unroll
                for (int J = 0; J < 4; ++J) { const v4u gq = rg[J];
                    f32x4 a = o[2 * J], c = o[2 * J + 1];
#pragma unroll
                    for (int e = 0; e < 4; ++e) { float ae = a[e], ce = c[e];
                        asm volatile("s_nop 1\n\tv_permlane16_swap_b32 %0, %1" : "+v"(ae), "+v"(ce)); a[e] = ae; c[e] = ce; }
                    v4u w; w.x = pk2(a.x * rstd * bflo(gq.x), a.y * rstd * bfhi(gq.x)); w.y = pk2(a.z * rstd * bflo(gq.y), a.w * rstd * bfhi(gq.y));
                    w.z = pk2(c.x * rstd * bflo(gq.z), c.y * rstd * bfhi(gq.z)); w.w = pk2(c.z * rstd * bflo(gq.w), c.w * rstd * bfhi(gq.w));
                    *(GAS v4u*)(op + 32 * J) = w; }
            }
            __syncthreads();
            TSEG_B(124);
        }
#undef P5_PTRS
#undef P5_LOAD_PW
#undef P5_PIPE
#undef P5_FRAG_V
#undef P5_FRAG_SF
#undef P5_FRAG_SB
#undef P5_LOAD_QK
#undef P5_LOAD_VFB
#undef P5_LOAD_G
      }
        if (BOTH(PH_RETOUT)) GRID_BAR();
        TP_END(PH_RETOUT);
    }

    if (IN(PH_GEMM_OUT)) { TP_BEGIN(PH_GEMM_OUT);
      {
        __syncthreads();
        pg8::Gemm g{CAT, WOUT_T, M, D, D}; pg8::StaticOrder S; S.init(M, D, G, bx);
        pg8::EpiResNorm E{x, D, MODF + 2 * D, NMOD, MUL2, XN, ROWSS};
        pg8::gemm_phase<pg8::EpiResNorm, pg8::StaticOrder, GP_ALIGN, GP_SP2>(lds, g, S, E);
        if (REPS(GEMM_REP_ID) == 2 && GEMM_REP_SEL == __LINE__) pg8::gemm_phase<pg8::EpiResNorm, pg8::StaticOrder, GP_ALIGN, GP_SP2>(lds, g, S, E);
      }
        if (BOTH(PH_GEMM_OUT)) GRID_BAR();
        TP_END(PH_GEMM_OUT);
    }

    if (IN(PH_GEMM_UP)) { TP_BEGIN(PH_GEMM_UP);
      {
        __syncthreads();
        pg8::Gemm g{XN, WUP_T, M, NUP, D}; pg8::StaticOrder S; S.init(M, NUP, G, bx);
        LAS float* rsl = (LAS float*)(lds + 131072);
        LAS int* pml = (LAS int*)(lds + 131072 + 8192);
        if (tid == 0) { int n = 0; pg8::Unit uu; for (int i = 0; S.next(i, uu); ++i) { bool f = false; for (int j = 0; j < n; ++j) f = f || (pml[j] == uu.pm); if (!f && n < 8) pml[n++] = uu.pm; } for (int j = n; j < 8; ++j) pml[j] = -1; }
        __syncthreads();
        for (int j = 0; j < 8; ++j) { const int pmj = pml[j];
            if (pmj >= 0 && tid < 256) { const int lr = 64 * (tid >> 7) + (tid & 63), lc = (tid >> 6) & 1;
                const size_t tok = (size_t)(pmj >> 5) * 8192 + (size_t)lr * 64 + 2 * (pmj & 31) + lc;
                const float* rp = ROWSS + tok * 32; float t = 0.f;
#pragma unroll
                for (int i = 0; i < 8; ++i) { const f32x4 q = *(const f32x4*)(rp + 4 * i); t += (q.x + q.y) + (q.z + q.w); }
                rsl[j * 256 + tid] = rsqrtf(t * (1.f / D) + EPS); } }
        __syncthreads();
        pg8::EpiGate E{ACT, DFF, BIAS2, NUP, args.in[IN_FCW], args.in[IN_FCB], DFF, rsl, pml};
        pg8::gemm_phase<pg8::EpiGate, pg8::StaticOrder, GP_ALIGN, GP_SP2>(lds, g, S, E);
      }
        if (BOTH(PH_GEMM_UP)) GRID_BAR();
        TP_END(PH_GEMM_UP);
    }

    if (IN(PH_GEMM_DN)) { TP_BEGIN(PH_GEMM_DN);
      {
        __syncthreads();
        pg8::Gemm g{ACT, WDN_T, M, D, DFF / 2}; pg8::StaticOrder S; S.init(M, D, G, bx);
        pg8::EpiRes E{XN, XN, D, MODF + 5 * D, NMOD, 1.f / 64.f, MUL2};
        pg8::gemm_phase<pg8::EpiRes, pg8::StaticOrder, GP_ALIGN, GP_SP2, true>(lds, g, S, E);
        if (REPS(GEMM_REP_ID) == 2 && GEMM_REP_SEL == __LINE__) pg8::gemm_phase<pg8::EpiRes, pg8::StaticOrder, GP_ALIGN, GP_SP2, true>(lds, g, S, E);
      }
        if (BOTH(PH_GEMM_DN)) GRID_BAR();
        TP_END(PH_GEMM_DN);
    }

    if (IN(PH_FNORM)) { TP_BEGIN(PH_FNORM);
        const float* gfin = args.in[IN_GF];
        f32x4 gfv[4][2];
#pragma unroll
        for (int j = 0; j < 4; ++j) { gfv[j][0] = *(const f32x4*)(gfin + 8 * (lane + 64 * j)); gfv[j][1] = *(const f32x4*)(gfin + 8 * (lane + 64 * j) + 4); }
        v4u q[4];
        if (gw < M) { const GAS v4u* xr = (const GAS v4u*)(XN + (size_t)gw * D) + lane;
#pragma unroll
            for (int j = 0; j < 4; ++j) q[j] = xr[64 * j]; }
        for (int m = gw; m < M; m += NGW) {
            float v[4][8]; float s = 0.f;
#pragma unroll
            for (int j = 0; j < 4; ++j) { v[j][0] = bflo(q[j].x); v[j][1] = bfhi(q[j].x); v[j][2] = bflo(q[j].y); v[j][3] = bfhi(q[j].y); v[j][4] = bflo(q[j].z); v[j][5] = bfhi(q[j].z); v[j][6] = bflo(q[j].w); v[j][7] = bfhi(q[j].w);
#pragma unroll
                for (int e = 0; e < 8; ++e) s += v[j][e] * v[j][e]; }
            if (m + NGW < M) { const GAS v4u* xr = (const GAS v4u*)(XN + (size_t)(m + NGW) * D) + lane;
#pragma unroll
                for (int j = 0; j < 4; ++j) q[j] = xr[64 * j]; }
            asm volatile("" ::: "memory");
            const float rstd = rsqrtf(wave_sum(s) * (1.f / D) + EPS);
            float* orow = out + (size_t)m * D;
#pragma unroll
            for (int j = 0; j < 4; ++j) { const int k0 = 8 * (lane + 64 * j); const f32x4 g0 = gfv[j][0], g1 = gfv[j][1];
                *(GAS f32x4*)(orow + k0) = (f32x4){v[j][0], v[j][1], v[j][2], v[j][3]} * rstd * g0; *(GAS f32x4*)(orow + k0 + 4) = (f32x4){v[j][4], v[j][5], v[j][6], v[j][7]} * rstd * g1; }
        }
    }
    if (TIME_PHASE == PH_FNORM) { VM_WAIT(); tp_b = __builtin_amdgcn_s_memrealtime(); }
    if (TIME_PHASE >= 0 && bx == 0 && tid == 0) { const unsigned long long t0 = __builtin_amdgcn_s_memrealtime(), span = (TIME_PHASE >= 120 ? tp_b : (tp_b - tp_a)) * 8ull; while (__builtin_amdgcn_s_memrealtime() - t0 < span) __builtin_amdgcn_s_sleep(8); }
#undef IN
#undef BOTH
}

extern "C" void kernel_launch(void* const* d_in, const int* in_sizes, int n_in, void* d_out, int out_size, void* d_ws, size_t ws_size, hipStream_t stream) {
    static int grid = 0;
    if (grid == 0) {
        if (n_in != 18 || in_sizes[0] != M * D || out_size != M * D || ws_size < WS_END) { fprintf(stderr, "kernel_launch: unexpected shapes/workspace (n_in %d, in0 %d, out %d, ws %zu, need %zu); nothing launched\n", n_in, n_in > 0 ? in_sizes[0] : -1, out_size, ws_size, (size_t)WS_END); grid = -1; return; }
        int dev = 0, cus = 0, per_cu = 0;
        if (hipGetDevice(&dev) != hipSuccess || hipDeviceGetAttribute(&cus, hipDeviceAttributeMultiprocessorCount, dev) != hipSuccess) { grid = -1; return; }
        if (hipFuncSetAttribute((const void*)fwd_kernel, hipFuncAttributeMaxDynamicSharedMemorySize, LDS_BYTES) != hipSuccess) { fprintf(stderr, "kernel_launch: hipFuncSetAttribute failed\n"); grid = -1; return; }
        if (hipOccupancyMaxActiveBlocksPerMultiprocessor(&per_cu, (const void*)fwd_kernel, NTHR, LDS_BYTES) != hipSuccess || per_cu < 1) { fprintf(stderr, "kernel_launch: occupancy query says %d\n", per_cu); per_cu = 1; }
        (void)hipGetLastError();
        grid = cus * (per_cu < 1 ? 1 : 1);
    }
    if (grid < 0) return;
    (void)hipMemsetAsync((char*)d_ws + WS_CTL + (size_t)CW_BAR * 4, 0, 65536 + 3 * NMOD * 4 - CW_BAR * 4, stream);
    Args a{};
    for (int i = 0; i < 18; ++i) a.in[i] = (const float*)d_in[i];
    a.out = (float*)d_out; a.ws = (unsigned char*)d_ws;
#if ONE_LAUNCH
    a.ph_lo = 0; a.ph_hi = NPH;
    void* kargs[] = {&a};
    hipError_t e = hipLaunchCooperativeKernel((const void*)fwd_kernel, dim3(grid), dim3(NTHR), kargs, LDS_BYTES, stream);
    if (e != hipSuccess) fprintf(stderr, "kernel_launch: cooperative launch failed: %s (grid %d)\n", hipGetErrorString(e), grid);
#else
    for (int p = 0; p < NPH; ++p) { a.ph_lo = p; a.ph_hi = p + 1; hipLaunchKernelGGL(fwd_kernel, dim3(grid), dim3(NTHR), LDS_BYTES, stream, a); }
#endif
}
```
